# Optimizing an MI355X kernel written in HIP

```python
import jax, jax.numpy as jnp
from jax import lax
import numpy as np

D_MODEL = 1024
BATCH = 4
SEQ = 4096
DEPTH = 1
DEC_BATCH = 128
DEC_SEQ = 8
PAST_LEN = 8192
PAGE_SIZE = 128

N_HEADS = 8
Q_LORA = 384
KV_LORA = 256
NOPE_DIM = 128
ROPE_DIM = 64
V_DIM = D_MODEL // N_HEADS
D_CONV = D_MODEL
CONV_W = 3
D_FF = 4 * D_MODEL
Q_BLOCK = 128
ROPE_THETA = 10000.0
EPS = 1e-6
ATTN_SCALE = (NOPE_DIM + ROPE_DIM) ** -0.5
IN_SPLITS = (Q_LORA, Q_LORA + KV_LORA, Q_LORA + KV_LORA + ROPE_DIM,
             Q_LORA + KV_LORA + ROPE_DIM + D_CONV,
             Q_LORA + KV_LORA + ROPE_DIM + 2 * D_CONV,
             Q_LORA + KV_LORA + ROPE_DIM + 3 * D_CONV)
D_IN = Q_LORA + KV_LORA + ROPE_DIM + 3 * D_CONV + 2 * D_MODEL

kernel_name = "hybrid_mla_shortconv_adaln_decoder_step"


def rmsnorm(x, g):
    xf = x.astype(jnp.float32)
    r = lax.rsqrt(jnp.mean(xf * xf, axis=-1, keepdims=True) + EPS)
    return (xf * r).astype(x.dtype) * g


def rope_angles(pos):
    inv = ROPE_THETA ** (-jnp.arange(0, ROPE_DIM, 2, dtype=jnp.float32) / ROPE_DIM)
    ang = pos.astype(jnp.float32)[:, None] * inv[None, :]
    return jnp.cos(ang), jnp.sin(ang)


def apply_rope(x, cos, sin):
    shape = (1, cos.shape[0]) + (1,) * (x.ndim - 3) + (cos.shape[1],)
    cos = cos.reshape(shape).astype(x.dtype)
    sin = sin.reshape(shape).astype(x.dtype)
    x1, x2 = jnp.split(x, 2, axis=-1)
    return jnp.concatenate([x1 * cos - x2 * sin, x2 * cos + x1 * sin], axis=-1)


def mla_attend(q_lat, q_rope, q_pos, ckv, krope, k_pos):
    s = jnp.einsum('bthc,bsc->bhts', q_lat, ckv) + jnp.einsum('bthr,bsr->bhts', q_rope, krope)
    s = s.astype(jnp.float32) * ATTN_SCALE
    mask = k_pos[None, :] <= q_pos[:, None]
    s = jnp.where(mask[None, None], s, -jnp.inf)
    p = jax.nn.softmax(s, axis=-1).astype(ckv.dtype)
    return jnp.einsum('bhts,bsc->bthc', p, ckv)


def prompt_attend(q_lat, q_rope, ckv, krope, pos):
    b, s = q_lat.shape[:2]
    nb = s // Q_BLOCK
    ql = q_lat.reshape(b, nb, Q_BLOCK, N_HEADS, KV_LORA).transpose(1, 0, 2, 3, 4)
    qr = q_rope.reshape(b, nb, Q_BLOCK, N_HEADS, ROPE_DIM).transpose(1, 0, 2, 3, 4)
    qp = pos.reshape(nb, Q_BLOCK)
    out = lax.map(lambda a: mla_attend(a[0], a[1], a[2], ckv, krope, pos), (ql, qr, qp))
    return out.transpose(1, 0, 2, 3, 4).reshape(b, s, N_HEADS, KV_LORA)


def short_conv(v, buf, conv_w):
    full = jnp.concatenate([buf, v], axis=1)
    t = v.shape[1]
    z = conv_w[0] * full[:, 0:t]
    for k in range(1, CONV_W):
        z = z + conv_w[k] * full[:, k:k + t]
    return z, full[:, full.shape[1] - (CONV_W - 1):]


def decoder_layer(x, c, pos, conv_buf, past_ckv, past_krope, past_pos, p):
    b, t, _ = x.shape
    mod = jnp.einsum('bd,de->be', jax.nn.silu(c), p['w_ada']) + p['b_ada']
    sh1, sc1, g1, sh2, sc2, g2 = [m[:, None, :] for m in jnp.split(mod, 6, axis=-1)]
    u = rmsnorm(x, p['g_attn']) * (1 + sc1) + sh1
    proj = jnp.einsum('btd,de->bte', u, p['w_in'])
    q_a, ckv, kr, b_g, c_g, xin, gates = jnp.split(proj, IN_SPLITS, axis=-1)
    q = jnp.einsum('btq,qe->bte', rmsnorm(q_a, p['g_q']), p['w_q_b'])
    q = q.reshape(b, t, N_HEADS, NOPE_DIM + ROPE_DIM)
    q_nope, q_rope = q[..., :NOPE_DIM], q[..., NOPE_DIM:]
    cos, sin = rope_angles(pos)
    q_rope = apply_rope(q_rope, cos, sin)
    ckv = rmsnorm(ckv, p['g_kv'])
    kr = apply_rope(kr, cos, sin)
    w_kvb = p['w_kv_b'].reshape(KV_LORA, N_HEADS, NOPE_DIM + V_DIM)
    w_uk, w_uv = w_kvb[..., :NOPE_DIM], w_kvb[..., NOPE_DIM:]
    q_lat = jnp.einsum('bthn,chn->bthc', q_nope, w_uk)
    if past_ckv is None:
        o_lat = prompt_attend(q_lat, q_rope, ckv, kr, pos)
    else:
        keys_ckv = jnp.concatenate([past_ckv, ckv], axis=1)
        keys_kr = jnp.concatenate([past_krope, kr], axis=1)
        k_pos = jnp.concatenate([past_pos, pos])
        o_lat = mla_attend(q_lat, q_rope, pos, keys_ckv, keys_kr, k_pos)
    attn = jnp.einsum('bthc,chv->bthv', o_lat, w_uv).reshape(b, t, N_HEADS * V_DIM)
    z, new_buf = short_conv(c_g * xin, conv_buf, p['conv_w'])
    conv_out = b_g * z
    g_a, g_b = jnp.split(jax.nn.sigmoid(gates), 2, axis=-1)
    merged = g_a * attn + g_b * conv_out
    x = x + g1 * jnp.einsum('btd,de->bte', merged, p['w_o'])
    u2 = rmsnorm(x, p['g_mlp']) * (1 + sc2) + sh2
    hdn = jnp.square(jax.nn.relu(jnp.einsum('btd,df->btf', u2, p['w_1'])))
    x = x + g2 * jnp.einsum('btf,fd->btd', hdn, p['w_2'])
    return x, ckv, kr, new_buf


def setup_inputs(seed: int = 0) -> dict:
    key = jax.random.key(seed)
    ks = jax.random.split(key, 24)
    n_pages = PAST_LEN // PAGE_SIZE
    n_used = DEC_BATCH * n_pages
    n_pool = (n_used * 5) // 4
    f32 = jnp.float32
    nrm = lambda k, s, sc: jax.random.normal(k, s, f32) * sc
    page_table = jax.random.permutation(ks[0], n_pool)[:n_used].reshape(DEC_BATCH, n_pages).astype(jnp.int32)
    return {
        "x_prompt": nrm(ks[1], (BATCH, SEQ, D_MODEL), 1.0),
        "x_sample": nrm(ks[2], (DEC_BATCH, DEC_SEQ, D_MODEL), 1.0),
        "cache_ckv": nrm(ks[3], (DEPTH, n_pool, PAGE_SIZE, KV_LORA), 1.0),
        "cache_krope": nrm(ks[4], (DEPTH, n_pool, PAGE_SIZE, ROPE_DIM), 1.0),
        "state_conv": nrm(ks[5], (DEPTH, DEC_BATCH, CONV_W - 1, D_CONV), 0.5),
        "page_table": page_table,
        "c_prompt": nrm(ks[6], (BATCH, D_MODEL), 1.0),
        "c_sample": nrm(ks[7], (DEC_BATCH, D_MODEL), 1.0),
        "w_ada": nrm(ks[8], (DEPTH, D_MODEL, 6 * D_MODEL), 0.5 * D_MODEL ** -0.5),
        "b_ada": nrm(ks[9], (DEPTH, 6 * D_MODEL), 0.02),
        "g_attn": 1.0 + nrm(ks[10], (DEPTH, D_MODEL), 0.02),
        "w_in": nrm(ks[11], (DEPTH, D_MODEL, D_IN), D_MODEL ** -0.5),
        "g_q": 1.0 + nrm(ks[12], (DEPTH, Q_LORA), 0.02),
        "w_q_b": nrm(ks[13], (DEPTH, Q_LORA, N_HEADS * (NOPE_DIM + ROPE_DIM)), Q_LORA ** -0.5),
        "g_kv": 1.0 + nrm(ks[14], (DEPTH, KV_LORA), 0.02),
        "w_kv_b": nrm(ks[15], (DEPTH, KV_LORA, N_HEADS * (NOPE_DIM + V_DIM)), KV_LORA ** -0.5),
        "conv_w": nrm(ks[16], (DEPTH, CONV_W, D_CONV), CONV_W ** -0.5),
        "w_o": nrm(ks[17], (DEPTH, D_MODEL, D_MODEL), D_MODEL ** -0.5),
        "g_mlp": 1.0 + nrm(ks[18], (DEPTH, D_MODEL), 0.02),
        "w_1": nrm(ks[19], (DEPTH, D_MODEL, D_FF), D_MODEL ** -0.5),
        "w_2": nrm(ks[20], (DEPTH, D_FF, D_MODEL), D_FF ** -0.5),
        "g_final": 1.0 + nrm(ks[21], (D_MODEL,), 0.02),
    }


def reference(x_prompt, x_sample, cache_ckv, cache_krope, state_conv, page_table, c_prompt, c_sample,
              w_ada, b_ada, g_attn, w_in, g_q, w_q_b, g_kv, w_kv_b, conv_w, w_o, g_mlp, w_1, w_2, g_final):
    seq = x_prompt.shape[1]
    dec_b, dec_t = x_sample.shape[:2]
    past_len = page_table.shape[1] * PAGE_SIZE
    pos_p = jnp.arange(seq, dtype=jnp.int32)
    pos_s = past_len + jnp.arange(dec_t, dtype=jnp.int32)
    past_pos = jnp.arange(past_len, dtype=jnp.int32)
    hp, hs = x_prompt, x_sample
    ckv_p, kr_p, cv_p, ckv_s, kr_s, cv_s = [], [], [], [], [], []
    for l in range(DEPTH):
        p = {"w_ada": w_ada[l], "b_ada": b_ada[l], "g_attn": g_attn[l], "w_in": w_in[l],
             "g_q": g_q[l], "w_q_b": w_q_b[l], "g_kv": g_kv[l], "w_kv_b": w_kv_b[l],
             "conv_w": conv_w[l], "w_o": w_o[l], "g_mlp": g_mlp[l], "w_1": w_1[l], "w_2": w_2[l]}
        buf0 = jnp.zeros((hp.shape[0], CONV_W - 1, D_CONV), hp.dtype)
        hp, a, bq, cq = decoder_layer(hp, c_prompt, pos_p, buf0, None, None, None, p)
        ckv_p.append(a); kr_p.append(bq); cv_p.append(cq)
        past_ckv = cache_ckv[l][page_table].reshape(dec_b, past_len, KV_LORA)
        past_kr = cache_krope[l][page_table].reshape(dec_b, past_len, ROPE_DIM)
        hs, a, bq, cq = decoder_layer(hs, c_sample, pos_s, state_conv[l], past_ckv, past_kr, past_pos, p)
        ckv_s.append(a); kr_s.append(bq); cv_s.append(cq)
    y_prompt = rmsnorm(hp, g_final)
    y_sample = rmsnorm(hs, g_final)
    return (y_prompt, y_sample, jnp.stack(ckv_p), jnp.stack(kr_p), jnp.stack(cv_p),
            jnp.stack(ckv_s), jnp.stack(kr_s), jnp.stack(cv_s))
```

```cpp
#include <hip/hip_runtime.h>
#include <cstdio>
#include <cstdint>
namespace pg8 {
#define PG8_LAS __attribute__((address_space(3)))
typedef unsigned short bf16_t;
typedef short bf16x8 __attribute__((ext_vector_type(8)));
typedef float f32x4 __attribute__((ext_vector_type(4)));
typedef unsigned u32x4 __attribute__((ext_vector_type(4)));
typedef unsigned u32x2 __attribute__((ext_vector_type(2)));
constexpr int BM = 256, BK = 64, HALF = 128, HTB = HALF * BK * 2  , STAGE_BYTES = 8 * HTB, NXCD = 8, WGM = 8;

__host__ __device__ __forceinline__ int lds_byte(int r, int c) { const int st = (r >> 4) * 2 + (c >> 5), rr = r & 15, cc = c & 31, ob = rr * 64 + cc * 2; return st * 1024 + (ob ^ (((ob >> 9) & 1) << 5)); }
__host__ __device__ __forceinline__ void stage_rc(int b, int& R, int& C) { const int st = b / 1024, sb = b % 1024, swz = sb ^ (((sb >> 9) & 1) << 5); R = (st >> 1) * 16 + swz / 64; C = (st & 1) * 32 + (swz % 64) / 2; }
__host__ __device__ __forceinline__ int perm32(int rho) { const int n = rho >> 4, i = rho & 15; return 8 * (i >> 2) + 4 * n + (i & 3); }

struct Unit { int pm, pn; };
struct Gemm { const bf16_t* A; const bf16_t* Bt; int M, N, K, lda, ldb, aoffn; };

struct StaticOrder {
    int nM, nN, nwg, G, c;
    __host__ __device__ void init(int M, int N, int G_, int c_) { nM = M / BM; nN = N / BM; nwg = nM * nN; G = G_; c = c_; }
    __host__ __device__ bool next(int i, Unit& u) const {
        const long L = (long)i * G + c; if (L >= nwg) return false;
        int wgid = (int)L; { const int q = nwg / NXCD, r = nwg % NXCD, xcd = wgid % NXCD, off = wgid / NXCD; wgid = (xcd < r ? xcd * (q + 1) : r * (q + 1) + (xcd - r) * q) + off; }
        const int nig = WGM * nN, gid = wgid / nig, fm = gid * WGM, gsz = (nM - fm) < WGM ? (nM - fm) : WGM;
        u.pm = fm + ((wgid % nig) % gsz); u.pn = (wgid % nig) / gsz; return true;
    }
    __device__ __forceinline__ void a_ready(const Unit&) const {}
    __device__ __forceinline__ void done(const Unit&) const {}
};
__device__ __forceinline__ unsigned cvt_pk_bf16(float lo, float hi) { unsigned r; asm volatile("v_cvt_pk_bf16_f32 %0, %1, %2" : "=v"(r) : "v"(lo), "v"(hi)); return r; }
template <class Epi, class Sched, bool ALIGN_EPI = false, bool SP2 = false>
__device__ __forceinline__ void gemm_phase(PG8_LAS unsigned char* lds, const Gemm g, const Sched& S, const Epi& E) {
    const int tid = threadIdx.x, wid = __builtin_amdgcn_readfirstlane(tid >> 6), lane = tid & 63, wr = wid >> 2, wc = wid & 3, fr = lane & 15, fq = lane >> 4;
    const int K = g.K, nt = K / BK;
    unsigned voffA[2], voffB[2];
#pragma unroll
    for (int i = 0; i < 2; ++i) { int R, C; stage_rc(tid * 16 + i * 8192, R, C); const int Rb = Epi::PERM ? ((R & ~31) + perm32(R & 31)) : R;
        voffA[i] = (unsigned)(R * g.lda + C) * 2u; voffB[i] = (unsigned)(Rb * g.ldb + C) * 2u; }
    const size_t kstep = (size_t)(BK * 2);
    const size_t hsA = (size_t)HALF * g.lda * 2, hsB = (size_t)HALF * g.ldb * 2;
    const size_t tsA = 2 * hsA, tsB = 2 * hsB;
    const unsigned ldsw = (unsigned)wid * 1024u;
    const int aoff = lds_byte(wr * 64 + fr, fq * 8), boff = lds_byte(wc * 32 + fr, fq * 8);
#define PG8_SA(b, h) (((b) * 2 + (h)) * HTB)
#define PG8_SB(b, h) ((4 + (b) * 2 + (h)) * HTB)
#define PG8_STAGE(bufoff, gbase, voff) do { _Pragma("unroll") for (int _i = 0; _i < 2; ++_i) \
        __builtin_amdgcn_global_load_lds((const unsigned*)((const char*)(gbase) + (voff)[_i]), (PG8_LAS unsigned*)(lds + (bufoff) + ldsw + _i * 8192), 16, 0, 0); } while (0)
#define PG8_LDA(dst, b, h) do { _Pragma("unroll") for (int m = 0; m < 4; ++m) _Pragma("unroll") for (int k = 0; k < 2; ++k) dst[m][k] = *(const PG8_LAS bf16x8*)(lds + PG8_SA(b, h) + aoff + m * 2048 + k * 1024); } while (0)
#define PG8_LDB(dst, b, h) do { _Pragma("unroll") for (int n = 0; n < 2; ++n) _Pragma("unroll") for (int k = 0; k < 2; ++k) dst[n][k] = *(const PG8_LAS bf16x8*)(lds + PG8_SB(b, h) + boff + n * 2048 + k * 1024); } while (0)
#define PG8_MMA(ai, bj, At, Bt) do { __builtin_amdgcn_s_setprio(1); _Pragma("unroll") for (int m = 0; m < 4; ++m) _Pragma("unroll") for (int n = 0; n < 2; ++n) _Pragma("unroll") for (int k = 0; k < 2; ++k) \
        acc[ai][bj][m][n] = __builtin_amdgcn_mfma_f32_16x16x32_bf16(Bt[n][k], At[m][k], acc[ai][bj][m][n], 0, 0, 0); __builtin_amdgcn_s_setprio(0); } while (0)
#define PG8_WAIT_V(n) asm volatile("s_waitcnt vmcnt(" #n ")" ::: "memory")
#define PG8_WAIT_L(n) asm volatile("s_waitcnt lgkmcnt(" #n ")" ::: "memory")
#define PG8_BAR __builtin_amdgcn_s_barrier()
#define PG8_SCHED __builtin_amdgcn_sched_barrier(0)
    Unit cur, nxt; int ui = 0;
    if (!S.next(0, cur)) return;
    f32x4 acc[2][2][4][2];
#pragma unroll
    for (int a = 0; a < 2; ++a)
#pragma unroll
        for (int b = 0; b < 2; ++b)
#pragma unroll
            for (int m = 0; m < 4; ++m)
#pragma unroll
                for (int n = 0; n < 2; ++n) acc[a][b][m][n] = (f32x4){0.f, 0.f, 0.f, 0.f};
    bf16x8 At[4][2], B0[2][2], B1[2][2];
    const char* cA = (const char*)g.A + (size_t)cur.pm * tsA + (size_t)cur.pn * g.aoffn; const char* cB = (const char*)g.Bt + (size_t)cur.pn * tsB;
    S.a_ready(cur);
    if constexpr (SP2) {
        PG8_STAGE(PG8_SB(0, 0), cB, voffB); PG8_STAGE(PG8_SB(0, 1), cB + hsB, voffB); PG8_STAGE(PG8_SA(0, 0), cA, voffA); PG8_STAGE(PG8_SA(0, 1), cA + hsA, voffA);
        if (wr == 1) PG8_BAR;
        PG8_WAIT_V(2); PG8_BAR;
        PG8_STAGE(PG8_SB(1, 0), cB + kstep, voffB); PG8_STAGE(PG8_SA(1, 0), cA + kstep, voffA); PG8_STAGE(PG8_SB(1, 1), cB + hsB + kstep, voffB);
        PG8_WAIT_V(6); PG8_BAR;
    } else {
        PG8_STAGE(PG8_SB(0, 0), cB, voffB); PG8_STAGE(PG8_SA(0, 0), cA, voffA); PG8_STAGE(PG8_SB(0, 1), cB + hsB, voffB); PG8_STAGE(PG8_SA(0, 1), cA + hsA, voffA);
        if (wr == 1) PG8_BAR;
        PG8_WAIT_V(4); PG8_BAR;
        PG8_STAGE(PG8_SB(1, 0), cB + kstep, voffB); PG8_STAGE(PG8_SA(1, 0), cA + kstep, voffA); PG8_STAGE(PG8_SB(1, 1), cB + hsB + kstep, voffB);
        PG8_WAIT_V(6); PG8_BAR;
    }
    for (;;) {
        const bool has_next = S.next(ui + 1, nxt);
        const char* nA = has_next ? (const char*)g.A + (size_t)nxt.pm * tsA + (size_t)nxt.pn * g.aoffn : cA; const char* nB = has_next ? (const char*)g.Bt + (size_t)nxt.pn * tsB : cB;
#pragma nounroll
        for (int t = 0; t < nt; t += 2) {
            const bool last = (t == nt - 2);
            const char* a1 = cA + (size_t)(t + 1) * kstep;
            const char* a2 = last ? nA : cA + (size_t)(t + 2) * kstep; const char* b2 = last ? nB : cB + (size_t)(t + 2) * kstep;
            const char* a3 = a2 + kstep; const char* b3 = b2 + kstep;
            if (last && has_next) S.a_ready(nxt);
            if constexpr (SP2) {
            PG8_LDB(B0, 0, 0); PG8_LDB(B1, 0, 1); PG8_SCHED; PG8_LDA(At, 0, 0); PG8_STAGE(PG8_SA(1, 1), a1 + hsA, voffA);
            PG8_WAIT_V(8); PG8_WAIT_L(0); PG8_BAR; PG8_MMA(0, 0, At, B0); PG8_MMA(0, 1, At, B1); PG8_BAR; PG8_SCHED;
            PG8_LDA(At, 0, 1); PG8_STAGE(PG8_SB(0, 0), b2, voffB); PG8_STAGE(PG8_SB(0, 1), b2 + hsB, voffB); PG8_STAGE(PG8_SA(0, 0), a2, voffA);
            PG8_WAIT_V(8); PG8_WAIT_L(0); PG8_BAR; PG8_MMA(1, 0, At, B0); PG8_MMA(1, 1, At, B1); PG8_BAR; PG8_SCHED;
            PG8_LDB(B0, 1, 0); PG8_LDB(B1, 1, 1); PG8_SCHED; PG8_LDA(At, 1, 0); PG8_STAGE(PG8_SA(0, 1), a2 + hsA, voffA);
            PG8_WAIT_V(8); PG8_WAIT_L(0); PG8_BAR; PG8_MMA(0, 0, At, B0); PG8_MMA(0, 1, At, B1); PG8_BAR; PG8_SCHED;
            PG8_LDA(At, 1, 1); PG8_STAGE(PG8_SB(1, 0), b3, voffB); PG8_STAGE(PG8_SB(1, 1), b3 + hsB, voffB); PG8_STAGE(PG8_SA(1, 0), a3, voffA);
            PG8_WAIT_V(8); PG8_WAIT_L(0); PG8_BAR; PG8_MMA(1, 0, At, B0); PG8_MMA(1, 1, At, B1); PG8_BAR; PG8_SCHED;
            } else {
            PG8_LDB(B0, 0, 0); PG8_SCHED; PG8_LDA(At, 0, 0); PG8_STAGE(PG8_SA(1, 1), a1 + hsA, voffA);
            PG8_WAIT_L(8); PG8_BAR; PG8_WAIT_L(0); PG8_MMA(0, 0, At, B0); PG8_BAR; PG8_SCHED;
            PG8_LDB(B1, 0, 1); PG8_STAGE(PG8_SB(0, 0), b2, voffB);
            PG8_BAR; PG8_WAIT_L(0); PG8_MMA(0, 1, At, B1); PG8_BAR;
            PG8_LDA(At, 0, 1); PG8_STAGE(PG8_SA(0, 0), a2, voffA);
            PG8_BAR; PG8_WAIT_L(0); PG8_MMA(1, 0, At, B0); PG8_BAR; PG8_SCHED;
            PG8_STAGE(PG8_SB(0, 1), b2 + hsB, voffB);
            PG8_WAIT_V(6); PG8_BAR; PG8_MMA(1, 1, At, B1); PG8_BAR;
            PG8_LDB(B0, 1, 0); PG8_SCHED; PG8_LDA(At, 1, 0); PG8_STAGE(PG8_SA(0, 1), a2 + hsA, voffA);
            PG8_WAIT_L(8); PG8_BAR; PG8_WAIT_L(0); PG8_MMA(0, 0, At, B0); PG8_BAR; PG8_SCHED;
            PG8_LDB(B1, 1, 1); PG8_STAGE(PG8_SB(1, 0), b3, voffB);
            PG8_BAR; PG8_WAIT_L(0); PG8_MMA(0, 1, At, B1); PG8_BAR;
            PG8_LDA(At, 1, 1); PG8_STAGE(PG8_SA(1, 0), a3, voffA);
            PG8_BAR; PG8_WAIT_L(0); PG8_MMA(1, 0, At, B0); PG8_BAR; PG8_SCHED;
            PG8_STAGE(PG8_SB(1, 1), b3 + hsB, voffB);
            PG8_WAIT_V(6); PG8_BAR; PG8_MMA(1, 1, At, B1); PG8_BAR;
            }
        }
        if constexpr (ALIGN_EPI) { if (wr == 0) PG8_BAR; }
        if constexpr (!Epi::AFTER_DRAIN) { E(acc, cur, wr, wc, fr, fq); S.done(cur); }
        if (!has_next) break;
#pragma unroll
        for (int a = 0; a < 2; ++a)
#pragma unroll
            for (int b = 0; b < 2; ++b)
#pragma unroll
                for (int m = 0; m < 4; ++m)
#pragma unroll
                    for (int n = 0; n < 2; ++n) acc[a][b][m][n] = (f32x4){0.f, 0.f, 0.f, 0.f};
        cur = nxt; cA = nA; cB = nB; ++ui;
        if constexpr (ALIGN_EPI) { if (wr == 1) PG8_BAR; }
    }
    PG8_WAIT_V(0);
    if constexpr (!ALIGN_EPI) { if (wr == 0) PG8_BAR; }
    PG8_BAR;
    if constexpr (Epi::AFTER_DRAIN) { E.fused(acc, cur, wr, wc, fr, fq, lds, wid, lane); S.done(cur); }
#undef PG8_SA
#undef PG8_SB
#undef PG8_STAGE
#undef PG8_LDA
#undef PG8_LDB
#undef PG8_MMA
#undef PG8_WAIT_V
#undef PG8_WAIT_L
#undef PG8_BAR
#undef PG8_SCHED
}}

constexpr int NWAVES = 8;
#ifndef MK_PER_PHASE
#define MK_PER_PHASE 0
#endif
constexpr int N_PHASES = 15;

constexpr int D = 1024, NB = 4, SEQ = 4096, DB = 128, DSEQ = 8, PAST = 8192, PAGE = 128, NPAGES = 64;
constexpr int NH = 8, QLORA = 384, KVL = 256, NOPE = 128, ROPE = 64, VD = 128, FF = 4096;
constexpr int MP = NB * SEQ, MS = DB * DSEQ, M = MP + MS;
constexpr int NSEQ = NB + DB;
constexpr int DIN = 5824, NIN = 5888;
constexpr int NSM = 768, NBIG = 5120, NQ = 1536;
constexpr int NPOS = SEQ + DSEQ;
constexpr float EPS = 1e-6f;
constexpr float QSCALE = 0.07216878364870322f * 1.4426950408889634f;

constexpr size_t MiB = 1u << 20;
constexpr size_t WS_CTL = 0, CTL_ZERO_BYTES = 1 * MiB;
constexpr size_t WS_MOD = 1 * MiB, WS_TAB = 5 * MiB, WS_WIN = 8 * MiB, WS_WQB = 20 * MiB, WS_WKVB = 22 * MiB, WS_WUK = 23 * MiB, WS_WO = 24 * MiB, WS_W1 = 26 * MiB, WS_W2 = 34 * MiB;
constexpr size_t WS_U = 42 * MiB, WS_SM = 76 * MiB, WS_BIG = 128 * MiB, WS_QA = 298 * MiB, WS_CKVN = 311 * MiB, WS_QB = 320 * MiB, WS_KP = 371 * MiB, WS_VP = 419 * MiB;
constexpr size_t WS_QL = 451 * MiB, WS_KNEW = 456 * MiB, WS_OLAT = 457 * MiB, WS_ATT = 461 * MiB, WS_MERGED = 495 * MiB, WS_X1 = 529 * MiB, WS_HDN = 597 * MiB, WS_PART = 733 * MiB, WS_END = 800 * MiB;
static_assert(WS_MOD + (size_t)NSEQ * 6 * D * 4 <= WS_TAB && WS_TAB + (size_t)NPOS * 32 * 8 <= WS_WIN && WS_WIN + (size_t)NIN * D * 2 <= WS_WQB && WS_WQB + (size_t)NQ * QLORA * 2 <= WS_WKVB, "ws map 1");
static_assert(WS_WKVB + (size_t)2048 * 256 * 2 <= WS_WUK && WS_WUK + (size_t)2048 * 256 * 2 <= WS_WO && WS_WO + (size_t)D * D * 2 <= WS_W1 && WS_W1 + (size_t)FF * D * 2 <= WS_W2 && WS_W2 + (size_t)FF * D * 2 <= WS_U, "ws map 2");
static_assert(WS_U + (size_t)M * D * 2 <= WS_SM && WS_SM + (size_t)M * NSM * 4 <= WS_BIG && WS_BIG + (size_t)M * NBIG * 2 <= WS_QA && WS_QA + (size_t)M * QLORA * 2 <= WS_CKVN && WS_CKVN + (size_t)M * KVL * 2 <= WS_QB, "ws map 3");
static_assert(WS_QB + (size_t)M * NQ * 2 <= WS_KP && WS_KP + (size_t)MP * NH * 192 * 2 <= WS_VP && WS_VP + (size_t)MP * NH * 128 * 2 <= WS_QL && WS_QL + (size_t)MS * NH * 320 * 2 <= WS_KNEW && WS_KNEW + (size_t)MS * 320 * 2 <= WS_OLAT, "ws map 4");
static_assert(WS_OLAT + (size_t)MS * NH * 256 * 2 <= WS_ATT && WS_ATT + (size_t)M * D * 2 <= WS_MERGED && WS_MERGED + (size_t)M * D * 2 <= WS_X1 && WS_X1 + (size_t)M * D * 4 <= WS_HDN && WS_HDN + (size_t)M * FF * 2 <= WS_PART, "ws map 5");
constexpr size_t O_Y = 0, O_CKVP = (size_t)M * D, O_KRP = O_CKVP + (size_t)MP * KVL, O_CVP = O_KRP + (size_t)MP * ROPE, O_CKVS = O_CVP + (size_t)NB * 2 * D, O_KRS = O_CKVS + (size_t)MS * KVL, O_CVS = O_KRS + (size_t)MS * ROPE, O_END = O_CVS + (size_t)DB * 2 * D;
static_assert(O_END == 23666688, "d_out size");
constexpr int CW_TMO = 0, CW_CODE = 1, CW_BAR = 4096;
constexpr int RING_OFF = 0, RING_BYTES = 131072;
constexpr int LDSCTL_OFF = RING_BYTES, MISC_OFF = LDSCTL_OFF + 320;
constexpr int LDS_BYTES = 147456;
static_assert(MISC_OFF + 128 <= LDS_BYTES, "LDS map");

#define GAS __attribute__((address_space(1)))
#define LAS __attribute__((address_space(3)))
typedef unsigned short bf16;
typedef unsigned v4u __attribute__((ext_vector_type(4)));
typedef unsigned v2u __attribute__((ext_vector_type(2)));
typedef float f32x4 __attribute__((ext_vector_type(4)));
typedef float f32x2 __attribute__((ext_vector_type(2)));
typedef float f32x16 __attribute__((ext_vector_type(16)));
typedef short bf16x8 __attribute__((ext_vector_type(8)));
typedef GAS unsigned gu32;
#define RLX_AGENT __ATOMIC_RELAXED, __HIP_MEMORY_SCOPE_AGENT
#define LDS_WAIT() asm volatile("s_waitcnt lgkmcnt(0)" ::: "memory")
#define VM_WAIT() asm volatile("s_waitcnt vmcnt(0)" ::: "memory")
__device__ __forceinline__ unsigned f2bf(float f) { unsigned u = __builtin_bit_cast(unsigned, f); return (u + 0x7fffu + ((u >> 16) & 1u)) >> 16; }
__device__ __forceinline__ unsigned pk2(float lo, float hi) { return f2bf(lo) | (f2bf(hi) << 16); }
__device__ __forceinline__ float bf2f(unsigned short b) { return __builtin_bit_cast(float, (unsigned)b << 16); }
__device__ __forceinline__ float bflo(unsigned w) { return __builtin_bit_cast(float, w << 16); }
__device__ __forceinline__ float bfhi(unsigned w) { return __builtin_bit_cast(float, w & 0xffff0000u); }
#define XB_TMO      128
#define XB_XCNT(j)  (256  + 64 * (j))
#define XB_XSUB(j)  (1280 + 64 * (j))
#define XB_XGEN(j)  (2304 + 64 * (j))
#define XB_TOP      3328
#define XB_TOPGEN   3392
#define XCD_BAR_WORDS 3456
#define XB_SPIN_CAP (1u << 18)

__device__ __forceinline__ unsigned xb_ld(unsigned* p)              { return __hip_atomic_load(p, __ATOMIC_RELAXED, __HIP_MEMORY_SCOPE_AGENT); }
__device__ __forceinline__ unsigned xb_add(unsigned* p, unsigned v) { return __hip_atomic_fetch_add(p, v, __ATOMIC_RELAXED, __HIP_MEMORY_SCOPE_AGENT); }
__device__ __forceinline__ unsigned xb_xcc_id() { return (unsigned)__builtin_amdgcn_s_getreg((3 << 11) | 20) & 0xFu; }
#define XB_SPIN(cond, bar) do { unsigned _sp = 0; while (cond) { __builtin_amdgcn_s_sleep(1); \
    if ((++_sp & 255u) == 0u) { if (xb_ld(&(bar)[XB_TMO])) break; if (_sp > XB_SPIN_CAP) { atomicAdd(&(bar)[XB_TMO], 1u); break; } } } } while (0)

struct XcdBarrier {
    unsigned* bar; unsigned x;
    volatile LAS unsigned* st;
};

__device__ __forceinline__ XcdBarrier xcd_barrier_post(unsigned* bar, volatile LAS unsigned* st) {
    XcdBarrier b; b.bar = bar; b.x = xb_xcc_id(); b.st = st;
    if (threadIdx.x == 0) (void)xb_add(&bar[XB_XCNT(b.x)], 1u);
    return b;
}
__device__ __forceinline__ void xcd_barrier_complete(unsigned* bar, unsigned x, unsigned& nloc, unsigned& nx) {
    const unsigned G = gridDim.x * gridDim.y * gridDim.z;
    unsigned sum, cnt, mine, sp = 0u;
    for (;;) {
        sum = 0u; cnt = 0u; mine = 0u;
#pragma unroll
        for (unsigned j = 0; j < 16; ++j) { const unsigned c = xb_ld(&bar[XB_XCNT(j)]); sum += c; cnt += (c > 0u) ? 1u : 0u; mine = (j == x) ? c : mine; }
        if (sum == G) break;
        __builtin_amdgcn_s_sleep(1);
        if ((++sp & 255u) == 0u) { if (xb_ld(&bar[XB_TMO])) break; if (sp > XB_SPIN_CAP) { atomicAdd(&bar[XB_TMO], 1u); break; } }
    }
    nloc = mine > 0u ? mine : 1u; nx = cnt > 0u ? cnt : 1u;
}

__device__ __forceinline__ void xcd_barrier(const XcdBarrier& b) {
    asm volatile("s_waitcnt vmcnt(0)" ::: "memory");
    __syncthreads();
    if (threadIdx.x == 0) {
        unsigned* bar = b.bar;
        __builtin_amdgcn_s_waitcnt(0);
        unsigned nloc = b.st[0], nx = b.st[1];
        if (nloc == 0u) { xcd_barrier_complete(bar, b.x, nloc, nx); b.st[0] = nloc; b.st[1] = nx; }
        const unsigned old = xb_add(&bar[XB_XSUB(b.x)], 1u);
        const unsigned gen = old / nloc;
        if (old + 1u == (gen + 1u) * nloc) {
            __builtin_amdgcn_fence(__ATOMIC_RELEASE, "agent");
            asm volatile("s_waitcnt vmcnt(0)" ::: "memory");
            const unsigned og = xb_add(&bar[XB_TOP], 1u);
            const unsigned tg = og / nx;
            if (og + 1u == (tg + 1u) * nx) xb_add(&bar[XB_TOPGEN], 1u);
            else XB_SPIN(xb_ld(&bar[XB_TOPGEN]) == tg, bar);
            __builtin_amdgcn_fence(__ATOMIC_ACQUIRE, "agent");
            xb_add(&bar[XB_XGEN(b.x)], 1u);
            asm volatile("s_waitcnt vmcnt(0)" ::: "memory");
        } else {
            XB_SPIN(xb_ld(&bar[XB_XGEN(b.x)]) == gen, bar);
            __builtin_amdgcn_fence(__ATOMIC_ACQUIRE, "agent");
            asm volatile("s_waitcnt vmcnt(0)" ::: "memory");
        }
    }
    __syncthreads();
}
struct Frame {
    LAS unsigned char* lds; volatile LAS unsigned* MISC; gu32* ctl;
    int tid, lane, wave, G, gw, NGW;
    const float *x_p, *x_s, *cache_ckv, *cache_kr, *state_conv; const int* page_table;
    const float *c_p, *c_s, *w_ada, *b_ada, *g_attn, *w_in, *g_q, *w_q_b, *g_kv, *w_kv_b, *conv_w, *w_o, *g_mlp, *w_1, *w_2, *g_final;
    float* out; unsigned char* ws;
};
__device__ const double ROPE_INV[32] = {1.0, 0.7498942093324559, 0.5623413251903491, 0.4216965034285822, 0.31622776601683794, 0.23713737056616552, 0.1778279410038923, 0.1333521432163324,
    0.1, 0.07498942093324558, 0.05623413251903491, 0.042169650342858224, 0.03162277660168379, 0.023713737056616554, 0.01778279410038923, 0.01333521432163324,
    0.01, 0.007498942093324558, 0.005623413251903491, 0.004216965034285823, 0.0031622776601683794, 0.0023713737056616554, 0.0017782794100389228, 0.001333521432163324,
    0.001, 0.0007498942093324559, 0.0005623413251903491, 0.00042169650342858224, 0.00031622776601683794, 0.00023713737056616554, 0.00017782794100389227, 0.0001333521432163324};

__device__ __forceinline__ float wave_sum(float v) {
#pragma unroll
    for (int o = 1; o < 64; o <<= 1) v += __shfl_xor(v, o);
    return v;
}
__device__ __forceinline__ float wave_max(float v) {
#pragma unroll
    for (int o = 1; o < 64; o <<= 1) v = fmaxf(v, __shfl_xor(v, o));
    return v;
}
__device__ __forceinline__ float silu_f(float x) { return x / (1.f + __expf(-x)); }
__device__ __forceinline__ float sigmoid_f(float x) { return 1.f / (1.f + __expf(-x)); }
__device__ __forceinline__ int seq_of_row(int row) { return row < MP ? (row >> 12) : NB + ((row - MP) >> 3); }
__device__ __forceinline__ int pidx_of_row(int row) { return row < MP ? (row & (SEQ - 1)) : SEQ + ((row - MP) & (DSEQ - 1)); }
__device__ __forceinline__ void store8bf(bf16* p, f32x4 a, f32x4 b) {
    v4u w; w.x = pg8::cvt_pk_bf16(a[0], a[1]); w.y = pg8::cvt_pk_bf16(a[2], a[3]); w.z = pg8::cvt_pk_bf16(b[0], b[1]); w.w = pg8::cvt_pk_bf16(b[2], b[3]);
    *(v4u*)p = w;
}
__device__ __forceinline__ void store4bf(bf16* p, f32x4 a) { v2u w; w.x = pg8::cvt_pk_bf16(a[0], a[1]); w.y = pg8::cvt_pk_bf16(a[2], a[3]); *(v2u*)p = w; }

template <int MODE> struct Epi {
    static constexpr bool PERM = true, AFTER_DRAIN = false;
    unsigned char* ws; const float* x_p; const float* x_s; float* out;
    __device__ __forceinline__ void operator()(const pg8::f32x4 (&acc)[2][2][4][2], const pg8::Unit& u, int wr, int wc, int fr, int fq) const {
        const int rowb = u.pm * 256 + wr * 64 + fr, cw = wc * 32 + 8 * fq;
#pragma unroll
        for (int ai = 0; ai < 2; ++ai)
#pragma unroll
            for (int m = 0; m < 4; ++m) {
                const int row = rowb + ai * 128 + m * 16;
#pragma unroll
                for (int bj = 0; bj < 2; ++bj) {
                    const f32x4 v0 = acc[ai][bj][m][0], v1 = acc[ai][bj][m][1];
                    const int col = u.pn * 256 + bj * 128 + cw;
                    if constexpr (MODE == 1) {
                        if (u.pn < 3) { float* p = (float*)(ws + WS_SM) + (size_t)row * NSM + col; *(f32x4*)p = v0; *(f32x4*)(p + 4) = v1; }
                        else { store8bf((bf16*)(ws + WS_BIG) + (size_t)row * NBIG + (col - NSM), v0, v1); }
                    } else if constexpr (MODE == 2) {
                        bf16* qb = (bf16*)(ws + WS_QB) + (size_t)row * NQ;
                        if (u.pn < 4) { store8bf(qb + col, v0 * QSCALE, v1 * QSCALE); }
                        else {
                            const int r = col - 1024, h = r >> 6, q4 = ((r & 63) >> 3) * 4;
                            const float* tb = (const float*)(ws + WS_TAB) + ((size_t)pidx_of_row(row) * 32 + q4) * 2;
                            const f32x4 t01 = *(const f32x4*)tb, t23 = *(const f32x4*)(tb + 4);
                            f32x4 cs = {t01[0], t01[2], t23[0], t23[2]}, sn = {t01[1], t01[3], t23[1], t23[3]};
                            const f32x4 o1 = (v0 * cs - v1 * sn) * QSCALE, o2 = (v1 * cs + v0 * sn) * QSCALE;
                            store4bf(qb + 1024 + h * 64 + q4, o1); store4bf(qb + 1024 + h * 64 + 32 + q4, o2);
                            if (row >= MP) { bf16* ql = (bf16*)(ws + WS_QL) + ((size_t)(row - MP) * NH + h) * 320 + 256; store4bf(ql + q4, o1); store4bf(ql + 32 + q4, o2); }
                        }
                    } else if constexpr (MODE == 3) {
                        const size_t tok = (size_t)((row >> 12) * NH + u.pn) * SEQ + (row & (SEQ - 1));
                        if (bj == 0) store8bf((bf16*)(ws + WS_KP) + tok * 192 + cw, v0, v1);
                        else         store8bf((bf16*)(ws + WS_VP) + tok * 128 + cw, v0, v1);
                    } else if constexpr (MODE == 4) {
                        store8bf((bf16*)(ws + WS_QL) + ((size_t)row * NH + u.pn) * 320 + bj * 128 + cw, v0, v1);
                    } else if constexpr (MODE == 5) {
                        if (bj == 1) store8bf((bf16*)(ws + WS_ATT) + (size_t)(MP + row) * D + u.pn * 128 + cw, v0, v1);
                    } else if constexpr (MODE == 6 || MODE == 8) {
                        const float* g = (const float*)(ws + WS_MOD) + (size_t)seq_of_row(row) * (6 * D) + (MODE == 6 ? 2 : 5) * D + col;
                        const float* xr = (MODE == 6) ? ((row < MP ? x_p + (size_t)row * D : x_s + (size_t)(row - MP) * D) + col) : ((const float*)(ws + WS_X1) + (size_t)row * D + col);
                        float* o = (MODE == 6) ? ((float*)(ws + WS_X1) + (size_t)row * D + col) : (out + O_Y + (size_t)row * D + col);
                        const f32x4 g0 = *(const f32x4*)g, g1 = *(const f32x4*)(g + 4), x0 = *(const f32x4*)xr, x1 = *(const f32x4*)(xr + 4);
                        *(f32x4*)o = x0 + g0 * v0; *(f32x4*)(o + 4) = x1 + g1 * v1;
                    } else if constexpr (MODE == 7) {
                        f32x4 a = v0, b = v1;
#pragma unroll
                        for (int e = 0; e < 4; ++e) { a[e] = fmaxf(a[e], 0.f); a[e] *= a[e]; b[e] = fmaxf(b[e], 0.f); b[e] *= b[e]; }
                        store8bf((bf16*)(ws + WS_HDN) + (size_t)row * FF + col, a, b);
                    }
                }
                asm volatile("" ::: "memory");
            }
    }
};

template <int MAP> __device__ __forceinline__ int wt_row(int n) {
    if constexpr (MAP == 0) return n;
    else if constexpr (MAP == 1) return n < 704 ? n : n + 64;
    else { const int h = n / 192, j = n - h * 192;
        if (j < 128) return h * 128 + j;
        const int i = j - 128, x2 = i >> 5, idx = i & 31;
        return 1024 + h * 64 + 8 * (idx >> 2) + 4 * x2 + (idx & 3); }
}
template <int MAP> __device__ __forceinline__ void transpose_item(const float* W, int K, int N, bf16* WT, const float* kscale, LAS float* scr, int item, int lane) {
    const int nblk = N / 32, kb = item / nblk, nb = item % nblk, k0 = 64 * kb, n0 = 32 * nb;
#pragma unroll 8
    for (int i = 0; i < 32; ++i) { const int kk = 2 * i + (lane >> 5); scr[kk * 33 + (lane & 31)] = W[(size_t)(k0 + kk) * N + n0 + (lane & 31)]; }
    LDS_WAIT(); asm volatile("" ::: "memory");
    const int c = lane & 7;
    float ks[8];
#pragma unroll
    for (int e = 0; e < 8; ++e) ks[e] = kscale ? kscale[k0 + 8 * c + e] : 1.f;
#pragma unroll
    for (int j = 0; j < 4; ++j) { const int n = (lane >> 3) + 8 * j; const LAS float* s = scr + (8 * c) * 33 + n;
        v4u o; o.x = pk2(s[0 * 33] * ks[0], s[1 * 33] * ks[1]); o.y = pk2(s[2 * 33] * ks[2], s[3 * 33] * ks[3]); o.z = pk2(s[4 * 33] * ks[4], s[5 * 33] * ks[5]); o.w = pk2(s[6 * 33] * ks[6], s[7 * 33] * ks[7]);
        *(GAS v4u*)(WT + (size_t)wt_row<MAP>(n0 + n) * K + k0 + 8 * c) = o; }
    LDS_WAIT(); asm volatile("" ::: "memory");
}
__device__ __forceinline__ int crow32(int r, int hi) { return (r & 3) + 8 * (r >> 2) + 4 * hi; }
__device__ __forceinline__ bf16x8 pack8f(const float* a) {
    v4u w; w.x = pg8::cvt_pk_bf16(a[0], a[1]); w.y = pg8::cvt_pk_bf16(a[2], a[3]); w.z = pg8::cvt_pk_bf16(a[4], a[5]); w.w = pg8::cvt_pk_bf16(a[6], a[7]);
    return __builtin_bit_cast(bf16x8, w);
}
__device__ __forceinline__ void adaln_task(Frame& F, int et) {
    const int e0 = et * 32, r = F.lane & 31, h = F.lane >> 5, w = F.wave;
    f32x16 acc[5];
#pragma unroll
    for (int st = 0; st < 5; ++st)
#pragma unroll
        for (int i = 0; i < 16; ++i) acc[st][i] = 0.f;
    for (int ks = 0; ks < 8; ++ks) {
        const int k0 = w * 128 + ks * 16 + 8 * h;
        float a[8];
#pragma unroll
        for (int j = 0; j < 8; ++j) a[j] = F.w_ada[(size_t)(k0 + j) * (6 * D) + e0 + r];
        const bf16x8 af = pack8f(a);
#pragma unroll
        for (int st = 0; st < 5; ++st) {
            int s = 32 * st + r; s = s < NSEQ ? s : NSEQ - 1;
            const float* cp = (s < NB ? F.c_p + (size_t)s * D : F.c_s + (size_t)(s - NB) * D) + k0;
            const f32x4 c0 = *(const f32x4*)cp, c1 = *(const f32x4*)(cp + 4);
            float b[8] = {silu_f(c0[0]), silu_f(c0[1]), silu_f(c0[2]), silu_f(c0[3]), silu_f(c1[0]), silu_f(c1[1]), silu_f(c1[2]), silu_f(c1[3])};
            acc[st] = __builtin_amdgcn_mfma_f32_32x32x16_bf16(af, pack8f(b), acc[st], 0, 0, 0);
        }
    }
    LAS float* red = (LAS float*)F.lds;
    float* mod = (float*)(F.ws + WS_MOD);
#pragma unroll
    for (int st = 0; st < 5; ++st) {
#pragma unroll
        for (int i = 0; i < 16; ++i) red[(w * 16 + i) * 64 + F.lane] = acc[st][i];
        __syncthreads();
#pragma unroll
        for (int q = 0; q < 2; ++q) {
            const int idx = F.tid + 512 * q, reg = idx >> 6, lo = idx & 63;
            float sum = 0.f;
#pragma unroll
            for (int ww = 0; ww < 8; ++ww) sum += red[ww * 1024 + idx];
            const int s = 32 * st + (lo & 31), e = e0 + crow32(reg, lo >> 5);
            if (s < NSEQ) mod[(size_t)s * (6 * D) + e] = sum + F.b_ada[e];
        }
        __syncthreads();
    }
}
__device__ __forceinline__ void p0_prologue(Frame& F) {
    for (int et = blockIdx.x; et < (6 * D) / 32; et += F.G) adaln_task(F, et);
    __syncthreads();
    LAS float* scr = (LAS float*)(F.lds + RING_OFF + F.wave * 16384);
    constexpr int I_IN = (D / 64) * (DIN / 32), I_QB = (QLORA / 64) * (NQ / 32), I_KVB = (KVL / 64) * (2048 / 32), I_O = (D / 64) * (D / 32), I_1 = (D / 64) * (FF / 32), I_2 = (FF / 64) * (D / 32);
    constexpr int NITEMS = I_IN + I_QB + I_KVB + I_O + I_1 + I_2;
    for (int it = F.gw; it < NITEMS; it += F.NGW) {
        int r = it;
        if (r < I_IN) { transpose_item<1>(F.w_in, D, DIN, (bf16*)(F.ws + WS_WIN), nullptr, scr, r, F.lane); continue; } r -= I_IN;
        if (r < I_QB) { transpose_item<2>(F.w_q_b, QLORA, NQ, (bf16*)(F.ws + WS_WQB), F.g_q, scr, r, F.lane); continue; } r -= I_QB;
        if (r < I_KVB) { transpose_item<0>(F.w_kv_b, KVL, 2048, (bf16*)(F.ws + WS_WKVB), nullptr, scr, r, F.lane); continue; } r -= I_KVB;
        if (r < I_O) { transpose_item<0>(F.w_o, D, D, (bf16*)(F.ws + WS_WO), nullptr, scr, r, F.lane); continue; } r -= I_O;
        if (r < I_1) { transpose_item<0>(F.w_1, D, FF, (bf16*)(F.ws + WS_W1), nullptr, scr, r, F.lane); continue; } r -= I_1;
        transpose_item<0>(F.w_2, FF, D, (bf16*)(F.ws + WS_W2), nullptr, scr, r, F.lane);
    }
    const int gt = F.gw * 64 + F.lane, NGT = F.NGW * 64;
    for (int i = gt; i < 64 * D / 8; i += NGT) *(v4u*)((bf16*)(F.ws + WS_WIN) + (size_t)704 * D + (size_t)i * 8) = (v4u){0u, 0u, 0u, 0u};
    for (int i = gt; i < 2048 * 256 / 8; i += NGT) {
        const int row = i >> 5, k8 = (i & 31) * 8, hh = row >> 8, c = row & 255; v4u o = {0u, 0u, 0u, 0u};
        if (k8 < 128) { const float* s = F.w_kv_b + (size_t)c * 2048 + hh * 256 + k8; const f32x4 a = *(const f32x4*)s, b = *(const f32x4*)(s + 4);
            o.x = pk2(a[0], a[1]); o.y = pk2(a[2], a[3]); o.z = pk2(b[0], b[1]); o.w = pk2(b[2], b[3]); }
        *(v4u*)((bf16*)(F.ws + WS_WUK) + (size_t)row * 256 + k8) = o;
    }
    for (int i = gt; i < NPOS * 32; i += NGT) {
        const int p = i >> 5, fi = i & 31; const double pos = (double)(p < SEQ ? p : p + (PAST - SEQ));
        const double rev = pos * ROPE_INV[fi] * 0.15915494309189535; const float fr = (float)(rev - __builtin_rint(rev));
        f32x2 cs; cs.x = __builtin_amdgcn_cosf(fr); cs.y = __builtin_amdgcn_sinf(fr);
        *((f32x2*)(F.ws + WS_TAB) + i) = cs;
    }
}
__device__ __forceinline__ void norm_mod_row(Frame& F, const float* src, const float* g, const float* sc, const float* sh, bf16* dst) {
    f32x4 v[4]; float s = 0.f;
#pragma unroll
    for (int j = 0; j < 4; ++j) { v[j] = *((const f32x4*)src + F.lane + 64 * j); s += (v[j].x * v[j].x + v[j].y * v[j].y) + (v[j].z * v[j].z + v[j].w * v[j].w); }
    const float r = 1.f / sqrtf(wave_sum(s) * (1.f / D) + EPS);
#pragma unroll
    for (int j = 0; j < 4; ++j) { const int c4 = F.lane + 64 * j; const f32x4 gg = *((const f32x4*)g + c4), ss = *((const f32x4*)sc + c4), hh = *((const f32x4*)sh + c4);
        const f32x4 o = (v[j] * r) * gg * (ss + 1.f) + hh; store4bf(dst + c4 * 4, o); }
}
__device__ __forceinline__ void small_row(Frame& F, int m) {
    const float* sm = (const float*)(F.ws + WS_SM) + (size_t)m * NSM;
    const int l = F.lane; const bool samp = m >= MP; const int ms = m - MP;
    const f32x4 qa = *((const f32x4*)sm + l); const f32x2 qb = *((const f32x2*)(sm + 256) + l);
    float s = (qa.x * qa.x + qa.y * qa.y) + (qa.z * qa.z + qa.w * qa.w) + (qb.x * qb.x + qb.y * qb.y);
    const float rq = 1.f / sqrtf(wave_sum(s) * (1.f / QLORA) + EPS);
    bf16* qo = (bf16*)(F.ws + WS_QA) + (size_t)m * QLORA;
    store4bf(qo + 4 * l, qa * rq); *(unsigned*)(qo + 256 + 2 * l) = pg8::cvt_pk_bf16(qb.x * rq, qb.y * rq);
    const f32x4 kv = *((const f32x4*)(sm + 384) + l);
    s = (kv.x * kv.x + kv.y * kv.y) + (kv.z * kv.z + kv.w * kv.w);
    const float rk = 1.f / sqrtf(wave_sum(s) * (1.f / KVL) + EPS);
    const f32x4 kn = (kv * rk) * *((const f32x4*)F.g_kv + l);
    float* ock = samp ? F.out + O_CKVS + (size_t)ms * KVL : F.out + O_CKVP + (size_t)m * KVL;
    *((f32x4*)ock + l) = kn;
    store4bf((bf16*)(F.ws + WS_CKVN) + (size_t)m * KVL + 4 * l, kn);
    if (samp) store4bf((bf16*)(F.ws + WS_KNEW) + (size_t)ms * 320 + 4 * l, kn);
    if (l < 32) {
        const float x1 = sm[640 + l], x2 = sm[672 + l];
        const f32x2 cs = *((const f32x2*)(F.ws + WS_TAB) + (size_t)pidx_of_row(m) * 32 + l);
        const float o1 = x1 * cs.x - x2 * cs.y, o2 = x2 * cs.x + x1 * cs.y;
        float* okr = samp ? F.out + O_KRS + (size_t)ms * ROPE : F.out + O_KRP + (size_t)m * ROPE;
        okr[l] = o1; okr[32 + l] = o2;
        const bf16 b1 = (bf16)f2bf(o1), b2 = (bf16)f2bf(o2);
        if (samp) { bf16* kn2 = (bf16*)(F.ws + WS_KNEW) + (size_t)ms * 320 + 256; kn2[l] = b1; kn2[32 + l] = b2; }
        else { const int b = m >> 12, t = m & (SEQ - 1);
#pragma unroll
            for (int hh = 0; hh < NH; ++hh) { bf16* kp = (bf16*)(F.ws + WS_KP) + ((size_t)(b * NH + hh) * SEQ + t) * 192 + 128; kp[l] = b1; kp[32 + l] = b2; } }
    }
    const int t = samp ? (ms & (DSEQ - 1)) : (m & (SEQ - 1)), T = samp ? DSEQ : SEQ;
    if (t >= T - 2) {
        const bf16* big = (const bf16*)(F.ws + WS_BIG) + (size_t)m * NBIG;
        float* oc = (samp ? F.out + O_CVS + (size_t)(ms >> 3) * 2 * D : F.out + O_CVP + (size_t)(m >> 12) * 2 * D) + (size_t)(t - (T - 2)) * D;
#pragma unroll
        for (int j = 0; j < 2; ++j) { const int c8 = (l + 64 * j) * 8;
            const v4u cg = *(const v4u*)(big + 1024 + c8), xi = *(const v4u*)(big + 2048 + c8);
            f32x4 a = {bflo(cg.x) * bflo(xi.x), bfhi(cg.x) * bfhi(xi.x), bflo(cg.y) * bflo(xi.y), bfhi(cg.y) * bfhi(xi.y)};
            f32x4 b = {bflo(cg.z) * bflo(xi.z), bfhi(cg.z) * bfhi(xi.z), bflo(cg.w) * bflo(xi.w), bfhi(cg.w) * bfhi(xi.w)};
            *(f32x4*)(oc + c8) = a; *(f32x4*)(oc + c8 + 4) = b; }
    }
}
__device__ __forceinline__ void naive_attn_prompt_row(Frame& F, int rid) {
    const int h = rid & 7, m = rid >> 3, b = m >> 12, t = m & (SEQ - 1), l = F.lane;
    LAS float* qs = (LAS float*)(F.lds + F.wave * 8192); LAS float* sc = qs + 320;
    const bf16* qb = (const bf16*)(F.ws + WS_QB) + (size_t)m * NQ;
    qs[l] = bf2f(qb[h * 128 + l]); qs[64 + l] = bf2f(qb[h * 128 + 64 + l]); qs[128 + l] = bf2f(qb[1024 + h * 64 + l]);
    LDS_WAIT(); asm volatile("" ::: "memory");
    const bf16* K = (const bf16*)(F.ws + WS_KP) + (size_t)(b * NH + h) * SEQ * 192; const bf16* V = (const bf16*)(F.ws + WS_VP) + (size_t)(b * NH + h) * SEQ * 128;
    const int nk = t + 1; float mx = -1e30f, lsum = 0.f, o0 = 0.f, o1 = 0.f;
    for (int c0 = 0; c0 < nk; c0 += 1024) {
        const int cn = (nk - c0) < 1024 ? (nk - c0) : 1024; float cm = -1e30f;
        for (int i = l; i < cn; i += 64) { const bf16* kr = K + (size_t)(c0 + i) * 192; float s = 0.f;
#pragma unroll 4
            for (int d8 = 0; d8 < 24; ++d8) { const v4u kk = *(const v4u*)(kr + d8 * 8); const f32x4 qa = *(const LAS f32x4*)(qs + d8 * 8), qc = *(const LAS f32x4*)(qs + d8 * 8 + 4);
                s += bflo(kk.x) * qa.x + bfhi(kk.x) * qa.y + bflo(kk.y) * qa.z + bfhi(kk.y) * qa.w + bflo(kk.z) * qc.x + bfhi(kk.z) * qc.y + bflo(kk.w) * qc.z + bfhi(kk.w) * qc.w; }
            sc[i] = s; cm = fmaxf(cm, s); }
        cm = wave_max(cm); const float mn = fmaxf(mx, cm), alpha = exp2f(mx - mn); mx = mn; o0 *= alpha; o1 *= alpha; lsum *= alpha;
        float ps = 0.f;
        for (int i = l; i < cn; i += 64) { const float p = exp2f(sc[i] - mn); sc[i] = p; ps += p; }
        lsum += wave_sum(ps);
        LDS_WAIT(); asm volatile("" ::: "memory");
        for (int i = 0; i < cn; ++i) { const float p = sc[i]; const unsigned vv = *(const unsigned*)(V + (size_t)(c0 + i) * 128 + 2 * l); o0 += p * bflo(vv); o1 += p * bfhi(vv); }
        LDS_WAIT(); asm volatile("" ::: "memory");
    }
    const float inv = 1.f / lsum;
    *(unsigned*)((bf16*)(F.ws + WS_ATT) + (size_t)m * D + h * 128 + 2 * l) = pg8::cvt_pk_bf16(o0 * inv, o1 * inv);
}
__device__ __forceinline__ void naive_attn_decode_row(Frame& F, int rid) {
    const int h = rid & 7, sm = rid >> 3, sb = sm >> 3, t = sm & 7, l = F.lane;
    LAS float* qs = (LAS float*)(F.lds + F.wave * 8192); LAS float* sc = qs + 320;
    const bf16* ql = (const bf16*)(F.ws + WS_QL) + ((size_t)sm * NH + h) * 320;
#pragma unroll
    for (int j = 0; j < 5; ++j) qs[l + 64 * j] = bf2f(ql[l + 64 * j]);
    LDS_WAIT(); asm volatile("" ::: "memory");
    const int* pt = F.page_table + sb * NPAGES; const bf16* knew = (const bf16*)(F.ws + WS_KNEW) + (size_t)sb * DSEQ * 320;
    const int nk = PAST + t + 1; float mx = -1e30f, lsum = 0.f; f32x4 o = {0.f, 0.f, 0.f, 0.f};
    for (int c0 = 0; c0 < nk; c0 += 1024) {
        const int cn = (nk - c0) < 1024 ? (nk - c0) : 1024; float cm = -1e30f;
        for (int i = l; i < cn; i += 64) { const int j = c0 + i; float s = 0.f;
            if (j < PAST) { const size_t prow = (size_t)pt[j >> 7] * PAGE + (j & 127); const float* ck = F.cache_ckv + prow * KVL; const float* kr = F.cache_kr + prow * ROPE;
#pragma unroll 4
                for (int d4 = 0; d4 < 64; ++d4) { const f32x4 kk = *(const f32x4*)(ck + d4 * 4); const f32x4 qq = *(const LAS f32x4*)(qs + d4 * 4); s += kk.x * qq.x + kk.y * qq.y + kk.z * qq.z + kk.w * qq.w; }
#pragma unroll 4
                for (int d4 = 0; d4 < 16; ++d4) { const f32x4 kk = *(const f32x4*)(kr + d4 * 4); const f32x4 qq = *(const LAS f32x4*)(qs + 256 + d4 * 4); s += kk.x * qq.x + kk.y * qq.y + kk.z * qq.z + kk.w * qq.w; }
            } else { const bf16* kn = knew + (size_t)(j - PAST) * 320;
#pragma unroll 4
                for (int d8 = 0; d8 < 40; ++d8) { const v4u kk = *(const v4u*)(kn + d8 * 8); const f32x4 qa = *(const LAS f32x4*)(qs + d8 * 8), qc = *(const LAS f32x4*)(qs + d8 * 8 + 4);
                    s += bflo(kk.x) * qa.x + bfhi(kk.x) * qa.y + bflo(kk.y) * qa.z + bfhi(kk.y) * qa.w + bflo(kk.z) * qc.x + bfhi(kk.z) * qc.y + bflo(kk.w) * qc.z + bfhi(kk.w) * qc.w; }
            }
            sc[i] = s; cm = fmaxf(cm, s); }
        cm = wave_max(cm); const float mn = fmaxf(mx, cm), alpha = exp2f(mx - mn); mx = mn; o = o * alpha; lsum *= alpha;
        float ps = 0.f;
        for (int i = l; i < cn; i += 64) { const float p = exp2f(sc[i] - mn); sc[i] = p; ps += p; }
        lsum += wave_sum(ps);
        LDS_WAIT(); asm volatile("" ::: "memory");
        for (int i = 0; i < cn; ++i) { const int j = c0 + i; const float p = sc[i]; f32x4 vv;
            if (j < PAST) { const size_t prow = (size_t)pt[j >> 7] * PAGE + (j & 127); vv = *((const f32x4*)(F.cache_ckv + prow * KVL) + l); }
            else { const v2u w = *((const v2u*)(knew + (size_t)(j - PAST) * 320) + l); vv = (f32x4){bflo(w.x), bfhi(w.x), bflo(w.y), bfhi(w.y)}; }
            o = o + vv * p; }
        LDS_WAIT(); asm volatile("" ::: "memory");
    }
    const float inv = 1.f / lsum;
    store4bf((bf16*)(F.ws + WS_OLAT) + ((size_t)sm * NH + h) * 256 + 4 * l, o * inv);
}
__device__ __forceinline__ void merged_row(Frame& F, int m) {
    const bool samp = m >= MP; const int ms = m - MP, l = F.lane;
    const int t = samp ? (ms & (DSEQ - 1)) : (m & (SEQ - 1));
    const bf16* big = (const bf16*)(F.ws + WS_BIG) + (size_t)m * NBIG;
    const bf16* att = (const bf16*)(F.ws + WS_ATT) + (size_t)m * D; bf16* mo = (bf16*)(F.ws + WS_MERGED) + (size_t)m * D;
    const float* sc0 = F.state_conv + (size_t)(samp ? (ms >> 3) : 0) * 2 * D;
#pragma unroll
    for (int j = 0; j < 2; ++j) {
        const int c8 = (l + 64 * j) * 8;
        const v4u bg = *(const v4u*)(big + c8), cg = *(const v4u*)(big + 1024 + c8), xi = *(const v4u*)(big + 2048 + c8), ga = *(const v4u*)(big + 3072 + c8), gb = *(const v4u*)(big + 4096 + c8), at = *(const v4u*)(att + c8);
        v4u cg1 = {0u, 0u, 0u, 0u}, xi1 = cg1, cg2 = cg1, xi2 = cg1;
        if (t >= 1) { cg1 = *(const v4u*)(big - NBIG + 1024 + c8); xi1 = *(const v4u*)(big - NBIG + 2048 + c8); }
        if (t >= 2) { cg2 = *(const v4u*)(big - 2 * NBIG + 1024 + c8); xi2 = *(const v4u*)(big - 2 * NBIG + 2048 + c8); }
        float res[8];
#pragma unroll
        for (int e = 0; e < 8; ++e) {
            const unsigned wb = ((const unsigned*)&bg)[e >> 1], wc = ((const unsigned*)&cg)[e >> 1], wx = ((const unsigned*)&xi)[e >> 1], wa = ((const unsigned*)&ga)[e >> 1], wg = ((const unsigned*)&gb)[e >> 1], wt = ((const unsigned*)&at)[e >> 1];
            const unsigned wc1 = ((const unsigned*)&cg1)[e >> 1], wx1 = ((const unsigned*)&xi1)[e >> 1], wc2 = ((const unsigned*)&cg2)[e >> 1], wx2 = ((const unsigned*)&xi2)[e >> 1];
#define SEL(w) ((e & 1) ? bfhi(w) : bflo(w))
            const int col = c8 + e;
            const float v0 = SEL(wc) * SEL(wx);
            float v1 = SEL(wc1) * SEL(wx1), v2 = SEL(wc2) * SEL(wx2);
            if (samp) { if (t == 0) { v1 = sc0[D + col]; v2 = sc0[col]; } else if (t == 1) { v2 = sc0[D + col]; } }
            const float z = F.conv_w[col] * v2 + F.conv_w[D + col] * v1 + F.conv_w[2 * D + col] * v0;
            res[e] = sigmoid_f(SEL(wa)) * SEL(wt) + sigmoid_f(SEL(wg)) * (SEL(wb) * z);
#undef SEL
        }
        v4u o; o.x = pg8::cvt_pk_bf16(res[0], res[1]); o.y = pg8::cvt_pk_bf16(res[2], res[3]); o.z = pg8::cvt_pk_bf16(res[4], res[5]); o.w = pg8::cvt_pk_bf16(res[6], res[7]);
        *(v4u*)(mo + c8) = o;
    }
}
__device__ __forceinline__ void final_row(Frame& F, int m) {
    float* y = F.out + O_Y + (size_t)m * D; f32x4 v[4]; float s = 0.f;
#pragma unroll
    for (int j = 0; j < 4; ++j) { v[j] = *((const f32x4*)y + F.lane + 64 * j); s += (v[j].x * v[j].x + v[j].y * v[j].y) + (v[j].z * v[j].z + v[j].w * v[j].w); }
    const float r = 1.f / sqrtf(wave_sum(s) * (1.f / D) + EPS);
#pragma unroll
    for (int j = 0; j < 4; ++j) *((f32x4*)y + F.lane + 64 * j) = (v[j] * r) * *((const f32x4*)F.g_final + F.lane + 64 * j);
}

struct Args { const void* in[22]; float* out; unsigned char* ws; int ph_lo, ph_hi; };
__global__ void __launch_bounds__(NWAVES * 64, 2) mk_fwd(Args args) {
    extern __shared__ __attribute__((aligned(16))) unsigned char lds[];
    Frame F;
    F.lds = (LAS unsigned char*)lds;
    F.MISC = (volatile LAS unsigned*)(F.lds + MISC_OFF);
    F.tid = threadIdx.x; F.lane = F.tid & 63; F.wave = __builtin_amdgcn_readfirstlane(F.tid >> 6);
    F.G = gridDim.x; F.gw = blockIdx.x * NWAVES + F.wave; F.NGW = F.G * NWAVES;
    F.ws = args.ws; F.out = args.out; F.ctl = (gu32*)(args.ws + WS_CTL);
    F.x_p = (const float*)args.in[0]; F.x_s = (const float*)args.in[1]; F.cache_ckv = (const float*)args.in[2]; F.cache_kr = (const float*)args.in[3]; F.state_conv = (const float*)args.in[4];
    F.page_table = (const int*)args.in[5]; F.c_p = (const float*)args.in[6]; F.c_s = (const float*)args.in[7]; F.w_ada = (const float*)args.in[8]; F.b_ada = (const float*)args.in[9];
    F.g_attn = (const float*)args.in[10]; F.w_in = (const float*)args.in[11]; F.g_q = (const float*)args.in[12]; F.w_q_b = (const float*)args.in[13]; F.g_kv = (const float*)args.in[14];
    F.w_kv_b = (const float*)args.in[15]; F.conv_w = (const float*)args.in[16]; F.w_o = (const float*)args.in[17]; F.g_mlp = (const float*)args.in[18]; F.w_1 = (const float*)args.in[19];
    F.w_2 = (const float*)args.in[20]; F.g_final = (const float*)args.in[21];
    for (int u = F.tid; u < (LDS_BYTES - LDSCTL_OFF) / 4; u += NWAVES * 64) ((LAS unsigned*)(F.lds + LDSCTL_OFF))[u] = 0u;
    __syncthreads();
    XcdBarrier bar; bar.bar = (unsigned*)(F.ctl + CW_BAR); bar.x = 0; bar.st = nullptr;
    if (!MK_PER_PHASE) bar = xcd_barrier_post((unsigned*)(F.ctl + CW_BAR), F.MISC + 8);
#define GRID_BAR() do { if (MK_PER_PHASE) { if (F.tid == 0) __hip_atomic_store(F.ctl + CW_TMO, 0xBADBA0u, RLX_AGENT); } else { xcd_barrier(bar); } } while (0)
    const int lo = args.ph_lo, hi = args.ph_hi;
#ifndef PH_MASK
#define PH_MASK 0xFFFFFFFFu
#endif
#define IN(k) (((PH_MASK >> (k)) & 1u) && lo <= (k) && (k) < hi)
#define BOTH(k) (IN(k) && IN((k) + 1))
    const pg8::bf16_t* U = (const pg8::bf16_t*)(F.ws + WS_U);
    float* mod = (float*)(F.ws + WS_MOD);

    if (IN(0)) { p0_prologue(F); if (BOTH(0)) GRID_BAR(); }
    if (IN(1)) {
        for (int m = F.gw; m < M; m += F.NGW) { const float* mr = mod + (size_t)seq_of_row(m) * (6 * D);
            norm_mod_row(F, m < MP ? F.x_p + (size_t)m * D : F.x_s + (size_t)(m - MP) * D, F.g_attn, mr + D, mr, (bf16*)(F.ws + WS_U) + (size_t)m * D); }
        if (BOTH(1)) GRID_BAR();
    }
    if (IN(2)) {
        pg8::Gemm g{U, (const pg8::bf16_t*)(F.ws + WS_WIN), M, NIN, D, D, D, 0}; pg8::StaticOrder S; S.init(M, NIN, F.G, (int)blockIdx.x);
        Epi<1> E{F.ws, F.x_p, F.x_s, F.out};
        pg8::gemm_phase<Epi<1>, pg8::StaticOrder, true, true>(F.lds + RING_OFF, g, S, E);
        if (BOTH(2)) GRID_BAR();
    }
    if (IN(3)) { for (int m = F.gw; m < M; m += F.NGW) small_row(F, m); if (BOTH(3)) GRID_BAR(); }
    if (IN(4)) {
        { pg8::Gemm g{(const pg8::bf16_t*)(F.ws + WS_QA), (const pg8::bf16_t*)(F.ws + WS_WQB), M, NQ, QLORA, QLORA, QLORA, 0}; pg8::StaticOrder S; S.init(M, NQ, F.G, (int)blockIdx.x);
          Epi<2> E{F.ws, F.x_p, F.x_s, F.out};
          pg8::gemm_phase<Epi<2>, pg8::StaticOrder, true, true>(F.lds + RING_OFF, g, S, E); }
        __syncthreads();
        { pg8::Gemm g{(const pg8::bf16_t*)(F.ws + WS_CKVN), (const pg8::bf16_t*)(F.ws + WS_WKVB), MP, 2048, KVL, KVL, KVL, 0}; pg8::StaticOrder S; S.init(MP, 2048, F.G, (int)blockIdx.x);
          Epi<3> E{F.ws, F.x_p, F.x_s, F.out};
          pg8::gemm_phase<Epi<3>, pg8::StaticOrder, true, true>(F.lds + RING_OFF, g, S, E); }
        if (BOTH(4)) GRID_BAR();
    }
    if (IN(5)) {
        pg8::Gemm g{(const pg8::bf16_t*)(F.ws + WS_QB) + (size_t)MP * NQ, (const pg8::bf16_t*)(F.ws + WS_WUK), MS, 2048, 256, NQ, 256, 128 * 2}; pg8::StaticOrder S; S.init(MS, 2048, F.G, (int)blockIdx.x);
        Epi<4> E{F.ws, F.x_p, F.x_s, F.out};
        pg8::gemm_phase<Epi<4>, pg8::StaticOrder, true, true>(F.lds + RING_OFF, g, S, E);
        if (BOTH(5)) GRID_BAR();
    }
    if (IN(6)) {
        for (int r = F.gw; r < MP * NH; r += F.NGW) naive_attn_prompt_row(F, r);
        for (int r = F.gw; r < MS * NH; r += F.NGW) naive_attn_decode_row(F, r);
        if (BOTH(6)) GRID_BAR();
    }
    if (IN(7)) {
        pg8::Gemm g{(const pg8::bf16_t*)(F.ws + WS_OLAT), (const pg8::bf16_t*)(F.ws + WS_WKVB), MS, 2048, 256, 2048, 256, 256 * 2}; pg8::StaticOrder S; S.init(MS, 2048, F.G, (int)blockIdx.x);
        Epi<5> E{F.ws, F.x_p, F.x_s, F.out};
        pg8::gemm_phase<Epi<5>, pg8::StaticOrder, true, true>(F.lds + RING_OFF, g, S, E);
        if (BOTH(7)) GRID_BAR();
    }
    if (IN(8)) { for (int m = F.gw; m < M; m += F.NGW) merged_row(F, m); if (BOTH(8)) GRID_BAR(); }
    if (IN(9)) {
        pg8::Gemm g{(const pg8::bf16_t*)(F.ws + WS_MERGED), (const pg8::bf16_t*)(F.ws + WS_WO), M, D, D, D, D, 0}; pg8::StaticOrder S; S.init(M, D, F.G, (int)blockIdx.x);
        Epi<6> E{F.ws, F.x_p, F.x_s, F.out};
        pg8::gemm_phase<Epi<6>, pg8::StaticOrder, true, true>(F.lds + RING_OFF, g, S, E);
        if (BOTH(9)) GRID_BAR();
    }
    if (IN(10)) {
        for (int m = F.gw; m < M; m += F.NGW) { const float* mr = mod + (size_t)seq_of_row(m) * (6 * D);
            norm_mod_row(F, (const float*)(F.ws + WS_X1) + (size_t)m * D, F.g_mlp, mr + 4 * D, mr + 3 * D, (bf16*)(F.ws + WS_U) + (size_t)m * D); }
        if (BOTH(10)) GRID_BAR();
    }
    if (IN(11)) {
        pg8::Gemm g{U, (const pg8::bf16_t*)(F.ws + WS_W1), M, FF, D, D, D, 0}; pg8::StaticOrder S; S.init(M, FF, F.G, (int)blockIdx.x);
        Epi<7> E{F.ws, F.x_p, F.x_s, F.out};
        pg8::gemm_phase<Epi<7>, pg8::StaticOrder, true, true>(F.lds + RING_OFF, g, S, E);
        if (BOTH(11)) GRID_BAR();
    }
    if (IN(12)) {
        pg8::Gemm g{(const pg8::bf16_t*)(F.ws + WS_HDN), (const pg8::bf16_t*)(F.ws + WS_W2), M, D, FF, FF, FF, 0}; pg8::StaticOrder S; S.init(M, D, F.G, (int)blockIdx.x);
        Epi<8> E{F.ws, F.x_p, F.x_s, F.out};
        pg8::gemm_phase<Epi<8>, pg8::StaticOrder, true, true>(F.lds + RING_OFF, g, S, E);
        if (BOTH(12)) GRID_BAR();
    }
    if (IN(13)) { for (int m = F.gw; m < M; m += F.NGW) final_row(F, m); }
#undef IN
#undef BOTH
}

extern "C" void kernel_launch(void* const* d_in, const int* in_sizes, int n_in, void* d_out, int out_size, void* d_ws, size_t ws_size, hipStream_t stream) {
    static int grid = 0;
    if (grid == 0) {
        if (n_in != 22 || out_size != (int)O_END || ws_size < WS_END) { fprintf(stderr, "kernel_launch: unexpected shapes (n_in %d, out %d, ws %zu); nothing launched\n", n_in, out_size, ws_size); grid = -1; return; }
        int dev = 0, cus = 0, per_cu = 0;
        if (hipGetDevice(&dev) != hipSuccess || hipDeviceGetAttribute(&cus, hipDeviceAttributeMultiprocessorCount, dev) != hipSuccess) { grid = -1; return; }
        if (hipFuncSetAttribute((const void*)mk_fwd, hipFuncAttributeMaxDynamicSharedMemorySize, LDS_BYTES) != hipSuccess) { fprintf(stderr, "kernel_launch: hipFuncSetAttribute failed\n"); grid = -1; return; }
        if (hipOccupancyMaxActiveBlocksPerMultiprocessor(&per_cu, (const void*)mk_fwd, NWAVES * 64, LDS_BYTES) != hipSuccess || per_cu < 1) fprintf(stderr, "kernel_launch: note: occupancy query says %d\n", per_cu);
        (void)hipGetLastError();
        grid = cus;
    }
    if (grid < 0) return;
    if (hipMemsetAsync((char*)d_ws + WS_CTL, 0, CTL_ZERO_BYTES, stream) != hipSuccess) return;
    Args a{};
    for (int i = 0; i < 22; ++i) a.in[i] = d_in[i];
    a.out = (float*)d_out; a.ws = (unsigned char*)d_ws;
#if MK_PER_PHASE
    for (int p = 0; p < 14; ++p) { a.ph_lo = p; a.ph_hi = p + 1; hipLaunchKernelGGL(mk_fwd, dim3(grid), dim3(NWAVES * 64), LDS_BYTES, stream, a); }
#else
    a.ph_lo = 0; a.ph_hi = 14; hipLaunchKernelGGL(mk_fwd, dim3(grid), dim3(NWAVES * 64), LDS_BYTES, stream, a);
#endif
}
```

```cpp
#include <hip/hip_runtime.h>
#include <cstdio>
#include <cstdint>
namespace pg8 {
#define PG8_LAS __attribute__((address_space(3)))
typedef unsigned short bf16_t;
typedef short bf16x8 __attribute__((ext_vector_type(8)));
typedef float f32x4 __attribute__((ext_vector_type(4)));
typedef unsigned u32x4 __attribute__((ext_vector_type(4)));
typedef unsigned u32x2 __attribute__((ext_vector_type(2)));
constexpr int BM = 256, BK = 64, HALF = 128, HTB = HALF * BK * 2  , STAGE_BYTES = 8 * HTB, NXCD = 8, WGM = 8;

__host__ __device__ __forceinline__ int lds_byte(int r, int c) { const int st = (r >> 4) * 2 + (c >> 5), rr = r & 15, cc = c & 31, ob = rr * 64 + cc * 2; return st * 1024 + (ob ^ (((ob >> 9) & 1) << 5)); }
__host__ __device__ __forceinline__ void stage_rc(int b, int& R, int& C) { const int st = b / 1024, sb = b % 1024, swz = sb ^ (((sb >> 9) & 1) << 5); R = (st >> 1) * 16 + swz / 64; C = (st & 1) * 32 + (swz % 64) / 2; }
__host__ __device__ __forceinline__ int perm32(int rho) { const int n = rho >> 4, i = rho & 15; return 8 * (i >> 2) + 4 * n + (i & 3); }

struct Unit { int pm, pn; };
struct Gemm { const bf16_t* A; const bf16_t* Bt; int M, N, K, lda, ldb, aoffn; };

struct StaticOrder {
    int nM, nN, nwg, G, c;
    __host__ __device__ void init(int M, int N, int G_, int c_) { nM = M / BM; nN = N / BM; nwg = nM * nN; G = G_; c = c_; }
    __host__ __device__ bool next(int i, Unit& u) const {
        const long L = (long)i * G + c; if (L >= nwg) return false;
        int wgid = (int)L; { const int q = nwg / NXCD, r = nwg % NXCD, xcd = wgid % NXCD, off = wgid / NXCD; wgid = (xcd < r ? xcd * (q + 1) : r * (q + 1) + (xcd - r) * q) + off; }
        const int nig = WGM * nN, gid = wgid / nig, fm = gid * WGM, gsz = (nM - fm) < WGM ? (nM - fm) : WGM;
        u.pm = fm + ((wgid % nig) % gsz); u.pn = (wgid % nig) / gsz; return true;
    }
    __device__ __forceinline__ void a_ready(const Unit&) const {}
    __device__ __forceinline__ void done(const Unit&) const {}
};
__device__ __forceinline__ unsigned cvt_pk_bf16(float lo, float hi) { unsigned r; asm volatile("v_cvt_pk_bf16_f32 %0, %1, %2" : "=v"(r) : "v"(lo), "v"(hi)); return r; }
template <class Epi, class Sched, bool ALIGN_EPI = false, bool SP2 = false>
__device__ __forceinline__ void gemm_phase(PG8_LAS unsigned char* lds, const Gemm g, const Sched& S, const Epi& E) {
    const int tid = threadIdx.x, wid = __builtin_amdgcn_readfirstlane(tid >> 6), lane = tid & 63, wr = wid >> 2, wc = wid & 3, fr = lane & 15, fq = lane >> 4;
    const int K = g.K, nt = K / BK;
    unsigned voffA[2], voffB[2];
#pragma unroll
    for (int i = 0; i < 2; ++i) { int R, C; stage_rc(tid * 16 + i * 8192, R, C); const int Rb = Epi::PERM ? ((R & ~31) + perm32(R & 31)) : R;
        voffA[i] = (unsigned)(R * g.lda + C) * 2u; voffB[i] = (unsigned)(Rb * g.ldb + C) * 2u; }
    const size_t kstep = (size_t)(BK * 2);
    const size_t hsA = (size_t)HALF * g.lda * 2, hsB = (size_t)HALF * g.ldb * 2;
    const size_t tsA = 2 * hsA, tsB = 2 * hsB;
    const unsigned ldsw = (unsigned)wid * 1024u;
    const int aoff = lds_byte(wr * 64 + fr, fq * 8), boff = lds_byte(wc * 32 + fr, fq * 8);
#define PG8_SA(b, h) (((b) * 2 + (h)) * HTB)
#define PG8_SB(b, h) ((4 + (b) * 2 + (h)) * HTB)
#define PG8_STAGE(bufoff, gbase, voff) do { _Pragma("unroll") for (int _i = 0; _i < 2; ++_i) \
        __builtin_amdgcn_global_load_lds((const unsigned*)((const char*)(gbase) + (voff)[_i]), (PG8_LAS unsigned*)(lds + (bufoff) + ldsw + _i * 8192), 16, 0, 0); } while (0)
#define PG8_LDA(dst, b, h) do { _Pragma("unroll") for (int m = 0; m < 4; ++m) _Pragma("unroll") for (int k = 0; k < 2; ++k) dst[m][k] = *(const PG8_LAS bf16x8*)(lds + PG8_SA(b, h) + aoff + m * 2048 + k * 1024); } while (0)
#define PG8_LDB(dst, b, h) do { _Pragma("unroll") for (int n = 0; n < 2; ++n) _Pragma("unroll") for (int k = 0; k < 2; ++k) dst[n][k] = *(const PG8_LAS bf16x8*)(lds + PG8_SB(b, h) + boff + n * 2048 + k * 1024); } while (0)
#define PG8_MMA(ai, bj, At, Bt) do { __builtin_amdgcn_s_setprio(1); _Pragma("unroll") for (int m = 0; m < 4; ++m) _Pragma("unroll") for (int n = 0; n < 2; ++n) _Pragma("unroll") for (int k = 0; k < 2; ++k) \
        acc[ai][bj][m][n] = __builtin_amdgcn_mfma_f32_16x16x32_bf16(Bt[n][k], At[m][k], acc[ai][bj][m][n], 0, 0, 0); __builtin_amdgcn_s_setprio(0); } while (0)
#define PG8_WAIT_V(n) asm volatile("s_waitcnt vmcnt(" #n ")" ::: "memory")
#define PG8_WAIT_L(n) asm volatile("s_waitcnt lgkmcnt(" #n ")" ::: "memory")
#define PG8_BAR __builtin_amdgcn_s_barrier()
#define PG8_SCHED __builtin_amdgcn_sched_barrier(0)
    Unit cur, nxt; int ui = 0;
    if (!S.next(0, cur)) return;
    f32x4 acc[2][2][4][2];
#pragma unroll
    for (int a = 0; a < 2; ++a)
#pragma unroll
        for (int b = 0; b < 2; ++b)
#pragma unroll
            for (int m = 0; m < 4; ++m)
#pragma unroll
                for (int n = 0; n < 2; ++n) acc[a][b][m][n] = (f32x4){0.f, 0.f, 0.f, 0.f};
    bf16x8 At[4][2], B0[2][2], B1[2][2];
    const char* cA = (const char*)g.A + (size_t)cur.pm * tsA + (size_t)cur.pn * g.aoffn; const char* cB = (const char*)g.Bt + (size_t)cur.pn * tsB;
    S.a_ready(cur);
    if constexpr (SP2) {
        PG8_STAGE(PG8_SB(0, 0), cB, voffB); PG8_STAGE(PG8_SB(0, 1), cB + hsB, voffB); PG8_STAGE(PG8_SA(0, 0), cA, voffA); PG8_STAGE(PG8_SA(0, 1), cA + hsA, voffA);
        if (wr == 1) PG8_BAR;
        PG8_WAIT_V(2); PG8_BAR;
        PG8_STAGE(PG8_SB(1, 0), cB + kstep, voffB); PG8_STAGE(PG8_SA(1, 0), cA + kstep, voffA); PG8_STAGE(PG8_SB(1, 1), cB + hsB + kstep, voffB);
        PG8_WAIT_V(6); PG8_BAR;
    } else {
        PG8_STAGE(PG8_SB(0, 0), cB, voffB); PG8_STAGE(PG8_SA(0, 0), cA, voffA); PG8_STAGE(PG8_SB(0, 1), cB + hsB, voffB); PG8_STAGE(PG8_SA(0, 1), cA + hsA, voffA);
        if (wr == 1) PG8_BAR;
        PG8_WAIT_V(4); PG8_BAR;
        PG8_STAGE(PG8_SB(1, 0), cB + kstep, voffB); PG8_STAGE(PG8_SA(1, 0), cA + kstep, voffA); PG8_STAGE(PG8_SB(1, 1), cB + hsB + kstep, voffB);
        PG8_WAIT_V(6); PG8_BAR;
    }
    for (;;) {
        const bool has_next = S.next(ui + 1, nxt);
        const char* nA = has_next ? (const char*)g.A + (size_t)nxt.pm * tsA + (size_t)nxt.pn * g.aoffn : cA; const char* nB = has_next ? (const char*)g.Bt + (size_t)nxt.pn * tsB : cB;
#pragma nounroll
        for (int t = 0; t < nt; t += 2) {
            const bool last = (t == nt - 2);
            const char* a1 = cA + (size_t)(t + 1) * kstep;
            const char* a2 = last ? nA : cA + (size_t)(t + 2) * kstep; const char* b2 = last ? nB : cB + (size_t)(t + 2) * kstep;
            const char* a3 = a2 + kstep; const char* b3 = b2 + kstep;
            if (last && has_next) S.a_ready(nxt);
            if constexpr (SP2) {
            PG8_LDB(B0, 0, 0); PG8_LDB(B1, 0, 1); PG8_SCHED; PG8_LDA(At, 0, 0); PG8_STAGE(PG8_SA(1, 1), a1 + hsA, voffA);
            PG8_WAIT_V(8); PG8_WAIT_L(0); PG8_BAR; PG8_MMA(0, 0, At, B0); PG8_MMA(0, 1, At, B1); PG8_BAR; PG8_SCHED;
            PG8_LDA(At, 0, 1); PG8_STAGE(PG8_SB(0, 0), b2, voffB); PG8_STAGE(PG8_SB(0, 1), b2 + hsB, voffB); PG8_STAGE(PG8_SA(0, 0), a2, voffA);
            PG8_WAIT_V(8); PG8_WAIT_L(0); PG8_BAR; PG8_MMA(1, 0, At, B0); PG8_MMA(1, 1, At, B1); PG8_BAR; PG8_SCHED;
            PG8_LDB(B0, 1, 0); PG8_LDB(B1, 1, 1); PG8_SCHED; PG8_LDA(At, 1, 0); PG8_STAGE(PG8_SA(0, 1), a2 + hsA, voffA);
            PG8_WAIT_V(8); PG8_WAIT_L(0); PG8_BAR; PG8_MMA(0, 0, At, B0); PG8_MMA(0, 1, At, B1); PG8_BAR; PG8_SCHED;
            PG8_LDA(At, 1, 1); PG8_STAGE(PG8_SB(1, 0), b3, voffB); PG8_STAGE(PG8_SB(1, 1), b3 + hsB, voffB); PG8_STAGE(PG8_SA(1, 0), a3, voffA);
            PG8_WAIT_V(8); PG8_WAIT_L(0); PG8_BAR; PG8_MMA(1, 0, At, B0); PG8_MMA(1, 1, At, B1); PG8_BAR; PG8_SCHED;
            } else {
            PG8_LDB(B0, 0, 0); PG8_SCHED; PG8_LDA(At, 0, 0); PG8_STAGE(PG8_SA(1, 1), a1 + hsA, voffA);
            PG8_WAIT_L(8); PG8_BAR; PG8_WAIT_L(0); PG8_MMA(0, 0, At, B0); PG8_BAR; PG8_SCHED;
            PG8_LDB(B1, 0, 1); PG8_STAGE(PG8_SB(0, 0), b2, voffB);
            PG8_BAR; PG8_WAIT_L(0); PG8_MMA(0, 1, At, B1); PG8_BAR;
            PG8_LDA(At, 0, 1); PG8_STAGE(PG8_SA(0, 0), a2, voffA);
            PG8_BAR; PG8_WAIT_L(0); PG8_MMA(1, 0, At, B0); PG8_BAR; PG8_SCHED;
            PG8_STAGE(PG8_SB(0, 1), b2 + hsB, voffB);
            PG8_WAIT_V(6); PG8_BAR; PG8_MMA(1, 1, At, B1); PG8_BAR;
            PG8_LDB(B0, 1, 0); PG8_SCHED; PG8_LDA(At, 1, 0); PG8_STAGE(PG8_SA(0, 1), a2 + hsA, voffA);
            PG8_WAIT_L(8); PG8_BAR; PG8_WAIT_L(0); PG8_MMA(0, 0, At, B0); PG8_BAR; PG8_SCHED;
            PG8_LDB(B1, 1, 1); PG8_STAGE(PG8_SB(1, 0), b3, voffB);
            PG8_BAR; PG8_WAIT_L(0); PG8_MMA(0, 1, At, B1); PG8_BAR;
            PG8_LDA(At, 1, 1); PG8_STAGE(PG8_SA(1, 0), a3, voffA);
            PG8_BAR; PG8_WAIT_L(0); PG8_MMA(1, 0, At, B0); PG8_BAR; PG8_SCHED;
            PG8_STAGE(PG8_SB(1, 1), b3 + hsB, voffB);
            PG8_WAIT_V(6); PG8_BAR; PG8_MMA(1, 1, At, B1); PG8_BAR;
            }
        }
        if constexpr (ALIGN_EPI) { if (wr == 0) PG8_BAR; }
        if constexpr (!Epi::AFTER_DRAIN) { E(acc, cur, wr, wc, fr, fq); S.done(cur); }
        if (!has_next) break;
#pragma unroll
        for (int a = 0; a < 2; ++a)
#pragma unroll
            for (int b = 0; b < 2; ++b)
#pragma unroll
                for (int m = 0; m < 4; ++m)
#pragma unroll
                    for (int n = 0; n < 2; ++n) acc[a][b][m][n] = (f32x4){0.f, 0.f, 0.f, 0.f};
        cur = nxt; cA = nA; cB = nB; ++ui;
        if constexpr (ALIGN_EPI) { if (wr == 1) PG8_BAR; }
    }
    PG8_WAIT_V(0);
    if constexpr (!ALIGN_EPI) { if (wr == 0) PG8_BAR; }
    PG8_BAR;
    if constexpr (Epi::AFTER_DRAIN) { E.fused(acc, cur, wr, wc, fr, fq, lds, wid, lane); S.done(cur); }
#undef PG8_SA
#undef PG8_SB
#undef PG8_STAGE
#undef PG8_LDA
#undef PG8_LDB
#undef PG8_MMA
#undef PG8_WAIT_V
#undef PG8_WAIT_L
#undef PG8_BAR
#undef PG8_SCHED
}}

constexpr int NWAVES = 8;
#ifndef MK_PER_PHASE
#define MK_PER_PHASE 0
#endif
constexpr int N_PHASES = 15;

constexpr int D = 1024, NB = 4, SEQ = 4096, DB = 128, DSEQ = 8, PAST = 8192, PAGE = 128, NPAGES = 64;
constexpr int NH = 8, QLORA = 384, KVL = 256, NOPE = 128, ROPE = 64, VD = 128, FF = 4096;
constexpr int MP = NB * SEQ, MS = DB * DSEQ, M = MP + MS;
constexpr int NSEQ = NB + DB;
constexpr int DIN = 5824, NIN = 5888;
constexpr int NSM = 768, NBIG = 5120, NQ = 1536;
constexpr int NPOS = SEQ + DSEQ;
constexpr float EPS = 1e-6f;
constexpr float QSCALE = 0.07216878364870322f * 1.4426950408889634f;

constexpr size_t MiB = 1u << 20;
constexpr size_t WS_CTL = 0, CTL_ZERO_BYTES = 1 * MiB;
constexpr size_t WS_MOD = 1 * MiB, WS_TAB = 5 * MiB, WS_WIN = 8 * MiB, WS_WQB = 20 * MiB, WS_WKVB = 22 * MiB, WS_WUK = 23 * MiB, WS_WO = 24 * MiB, WS_W1 = 26 * MiB, WS_W2 = 34 * MiB;
constexpr size_t WS_U = 42 * MiB, WS_SM = 76 * MiB, WS_BIG = 128 * MiB, WS_QA = 298 * MiB, WS_CKVN = 311 * MiB, WS_QB = 320 * MiB, WS_KP = 371 * MiB, WS_VP = 419 * MiB;
constexpr size_t WS_QL = 451 * MiB, WS_KNEW = 456 * MiB, WS_OLAT = 457 * MiB, WS_ATT = 461 * MiB, WS_MERGED = 495 * MiB, WS_X1 = 529 * MiB, WS_HDN = 597 * MiB, WS_PART = 733 * MiB, WS_ML = 766 * MiB, WS_END = 800 * MiB;
static_assert(WS_MOD + (size_t)NSEQ * 6 * D * 4 <= WS_TAB && WS_TAB + (size_t)NPOS * 32 * 8 <= WS_WIN && WS_WIN + (size_t)NIN * D * 2 <= WS_WQB && WS_WQB + (size_t)NQ * QLORA * 2 <= WS_WKVB, "ws map 1");
static_assert(WS_WKVB + (size_t)2048 * 256 * 2 <= WS_WUK && WS_WUK + (size_t)2048 * 256 * 2 <= WS_WO && WS_WO + (size_t)D * D * 2 <= WS_W1 && WS_W1 + (size_t)FF * D * 2 <= WS_W2 && WS_W2 + (size_t)FF * D * 2 <= WS_U, "ws map 2");
static_assert(WS_U + (size_t)M * D * 2 <= WS_SM && WS_SM + (size_t)M * NSM * 4 <= WS_BIG && WS_BIG + (size_t)M * NBIG * 2 <= WS_QA && WS_QA + (size_t)M * QLORA * 2 <= WS_CKVN && WS_CKVN + (size_t)M * KVL * 2 <= WS_QB, "ws map 3");
static_assert(WS_QB + (size_t)M * NQ * 2 <= WS_KP && WS_KP + (size_t)MP * NH * 192 * 2 <= WS_VP && WS_VP + (size_t)MP * NH * 128 * 2 <= WS_QL && WS_QL + (size_t)MS * NH * 320 * 2 <= WS_KNEW && WS_KNEW + (size_t)MS * 320 * 2 <= WS_OLAT, "ws map 4");
static_assert(WS_OLAT + (size_t)MS * NH * 256 * 2 <= WS_ATT && WS_ATT + (size_t)M * D * 2 <= WS_MERGED && WS_MERGED + (size_t)M * D * 2 <= WS_X1 && WS_X1 + (size_t)M * D * 4 <= WS_HDN && WS_HDN + (size_t)M * FF * 2 <= WS_PART, "ws map 5");
constexpr size_t O_Y = 0, O_CKVP = (size_t)M * D, O_KRP = O_CKVP + (size_t)MP * KVL, O_CVP = O_KRP + (size_t)MP * ROPE, O_CKVS = O_CVP + (size_t)NB * 2 * D, O_KRS = O_CKVS + (size_t)MS * KVL, O_CVS = O_KRS + (size_t)MS * ROPE, O_END = O_CVS + (size_t)DB * 2 * D;
static_assert(O_END == 23666688, "d_out size");
constexpr int CW_TMO = 0, CW_CODE = 1, CW_BAR = 4096;
constexpr int RING_OFF = 0, RING_BYTES = 131072;
constexpr int LDSCTL_OFF = RING_BYTES, MISC_OFF = LDSCTL_OFF + 320;
constexpr int LDS_BYTES = 147456;
static_assert(MISC_OFF + 128 <= LDS_BYTES, "LDS map");

#define GAS __attribute__((address_space(1)))
#define LAS __attribute__((address_space(3)))
typedef unsigned short bf16;
typedef unsigned v4u __attribute__((ext_vector_type(4)));
typedef unsigned v2u __attribute__((ext_vector_type(2)));
typedef float f32x4 __attribute__((ext_vector_type(4)));
typedef float f32x2 __attribute__((ext_vector_type(2)));
typedef float f32x16 __attribute__((ext_vector_type(16)));
typedef short bf16x8 __attribute__((ext_vector_type(8)));
typedef GAS unsigned gu32;
#define RLX_AGENT __ATOMIC_RELAXED, __HIP_MEMORY_SCOPE_AGENT
#define LDS_WAIT() asm volatile("s_waitcnt lgkmcnt(0)" ::: "memory")
#define VM_WAIT() asm volatile("s_waitcnt vmcnt(0)" ::: "memory")
__device__ __forceinline__ unsigned f2bf(float f) { unsigned u = __builtin_bit_cast(unsigned, f); return (u + 0x7fffu + ((u >> 16) & 1u)) >> 16; }
__device__ __forceinline__ unsigned pk2(float lo, float hi) { return f2bf(lo) | (f2bf(hi) << 16); }
__device__ __forceinline__ float bf2f(unsigned short b) { return __builtin_bit_cast(float, (unsigned)b << 16); }
__device__ __forceinline__ float bflo(unsigned w) { return __builtin_bit_cast(float, w << 16); }
__device__ __forceinline__ float bfhi(unsigned w) { return __builtin_bit_cast(float, w & 0xffff0000u); }
#define XB_TMO      128
#define XB_XCNT(j)  (256  + 64 * (j))
#define XB_XSUB(j)  (1280 + 64 * (j))
#define XB_XGEN(j)  (2304 + 64 * (j))
#define XB_TOP      3328
#define XB_TOPGEN   3392
#define XCD_BAR_WORDS 3456
#define XB_SPIN_CAP (1u << 18)

__device__ __forceinline__ unsigned xb_ld(unsigned* p)              { return __hip_atomic_load(p, __ATOMIC_RELAXED, __HIP_MEMORY_SCOPE_AGENT); }
__device__ __forceinline__ unsigned xb_add(unsigned* p, unsigned v) { return __hip_atomic_fetch_add(p, v, __ATOMIC_RELAXED, __HIP_MEMORY_SCOPE_AGENT); }
__device__ __forceinline__ unsigned xb_xcc_id() { return (unsigned)__builtin_amdgcn_s_getreg((3 << 11) | 20) & 0xFu; }
#define XB_SPIN(cond, bar) do { unsigned _sp = 0; while (cond) { __builtin_amdgcn_s_sleep(1); \
    if ((++_sp & 255u) == 0u) { if (xb_ld(&(bar)[XB_TMO])) break; if (_sp > XB_SPIN_CAP) { atomicAdd(&(bar)[XB_TMO], 1u); break; } } } } while (0)

struct XcdBarrier {
    unsigned* bar; unsigned x;
    volatile LAS unsigned* st;
};

__device__ __forceinline__ XcdBarrier xcd_barrier_post(unsigned* bar, volatile LAS unsigned* st) {
    XcdBarrier b; b.bar = bar; b.x = xb_xcc_id(); b.st = st;
    if (threadIdx.x == 0) (void)xb_add(&bar[XB_XCNT(b.x)], 1u);
    return b;
}
__device__ __forceinline__ void xcd_barrier_complete(unsigned* bar, unsigned x, unsigned& nloc, unsigned& nx) {
    const unsigned G = gridDim.x * gridDim.y * gridDim.z;
    unsigned sum, cnt, mine, sp = 0u;
    for (;;) {
        sum = 0u; cnt = 0u; mine = 0u;
#pragma unroll
        for (unsigned j = 0; j < 16; ++j) { const unsigned c = xb_ld(&bar[XB_XCNT(j)]); sum += c; cnt += (c > 0u) ? 1u : 0u; mine = (j == x) ? c : mine; }
        if (sum == G) break;
        __builtin_amdgcn_s_sleep(1);
        if ((++sp & 255u) == 0u) { if (xb_ld(&bar[XB_TMO])) break; if (sp > XB_SPIN_CAP) { atomicAdd(&bar[XB_TMO], 1u); break; } }
    }
    nloc = mine > 0u ? mine : 1u; nx = cnt > 0u ? cnt : 1u;
}

__device__ __forceinline__ void xcd_barrier(const XcdBarrier& b) {
    asm volatile("s_waitcnt vmcnt(0)" ::: "memory");
    __syncthreads();
    if (threadIdx.x == 0) {
        unsigned* bar = b.bar;
        __builtin_amdgcn_s_waitcnt(0);
        unsigned nloc = b.st[0], nx = b.st[1];
        if (nloc == 0u) { xcd_barrier_complete(bar, b.x, nloc, nx); b.st[0] = nloc; b.st[1] = nx; }
        const unsigned old = xb_add(&bar[XB_XSUB(b.x)], 1u);
        const unsigned gen = old / nloc;
        if (old + 1u == (gen + 1u) * nloc) {
            __builtin_amdgcn_fence(__ATOMIC_RELEASE, "agent");
            asm volatile("s_waitcnt vmcnt(0)" ::: "memory");
            const unsigned og = xb_add(&bar[XB_TOP], 1u);
            const unsigned tg = og / nx;
            if (og + 1u == (tg + 1u) * nx) xb_add(&bar[XB_TOPGEN], 1u);
            else XB_SPIN(xb_ld(&bar[XB_TOPGEN]) == tg, bar);
            __builtin_amdgcn_fence(__ATOMIC_ACQUIRE, "agent");
            xb_add(&bar[XB_XGEN(b.x)], 1u);
            asm volatile("s_waitcnt vmcnt(0)" ::: "memory");
        } else {
            XB_SPIN(xb_ld(&bar[XB_XGEN(b.x)]) == gen, bar);
            __builtin_amdgcn_fence(__ATOMIC_ACQUIRE, "agent");
            asm volatile("s_waitcnt vmcnt(0)" ::: "memory");
        }
    }
    __syncthreads();
}
struct Frame {
    LAS unsigned char* lds; volatile LAS unsigned* MISC; gu32* ctl;
    int tid, lane, wave, G, gw, NGW;
    const float *x_p, *x_s, *cache_ckv, *cache_kr, *state_conv; const int* page_table;
    const float *c_p, *c_s, *w_ada, *b_ada, *g_attn, *w_in, *g_q, *w_q_b, *g_kv, *w_kv_b, *conv_w, *w_o, *g_mlp, *w_1, *w_2, *g_final;
    float* out; unsigned char* ws;
};
__device__ const double ROPE_INV[32] = {1.0, 0.7498942093324559, 0.5623413251903491, 0.4216965034285822, 0.31622776601683794, 0.23713737056616552, 0.1778279410038923, 0.1333521432163324,
    0.1, 0.07498942093324558, 0.05623413251903491, 0.042169650342858224, 0.03162277660168379, 0.023713737056616554, 0.01778279410038923, 0.01333521432163324,
    0.01, 0.007498942093324558, 0.005623413251903491, 0.004216965034285823, 0.0031622776601683794, 0.0023713737056616554, 0.0017782794100389228, 0.001333521432163324,
    0.001, 0.0007498942093324559, 0.0005623413251903491, 0.00042169650342858224, 0.00031622776601683794, 0.00023713737056616554, 0.00017782794100389227, 0.0001333521432163324};

__device__ __forceinline__ float wave_sum(float v) {
#pragma unroll
    for (int o = 1; o < 64; o <<= 1) v += __shfl_xor(v, o);
    return v;
}
__device__ __forceinline__ float wave_max(float v) {
#pragma unroll
    for (int o = 1; o < 64; o <<= 1) v = fmaxf(v, __shfl_xor(v, o));
    return v;
}
__device__ __forceinline__ float silu_f(float x) { return x / (1.f + __expf(-x)); }
__device__ __forceinline__ float sigmoid_f(float x) { return 1.f / (1.f + __expf(-x)); }
__device__ __forceinline__ int seq_of_row(int row) { return row < MP ? (row >> 12) : NB + ((row - MP) >> 3); }
__device__ __forceinline__ int pidx_of_row(int row) { return row < MP ? (row & (SEQ - 1)) : SEQ + ((row - MP) & (DSEQ - 1)); }
__device__ __forceinline__ void store8bf(bf16* p, f32x4 a, f32x4 b) {
    v4u w; w.x = pg8::cvt_pk_bf16(a[0], a[1]); w.y = pg8::cvt_pk_bf16(a[2], a[3]); w.z = pg8::cvt_pk_bf16(b[0], b[1]); w.w = pg8::cvt_pk_bf16(b[2], b[3]);
    *(v4u*)p = w;
}
__device__ __forceinline__ void store4bf(bf16* p, f32x4 a) { v2u w; w.x = pg8::cvt_pk_bf16(a[0], a[1]); w.y = pg8::cvt_pk_bf16(a[2], a[3]); *(v2u*)p = w; }

template <int MODE> struct Epi {
    static constexpr bool PERM = true, AFTER_DRAIN = false;
    unsigned char* ws; const float* x_p; const float* x_s; float* out;
    __device__ __forceinline__ void operator()(const pg8::f32x4 (&acc)[2][2][4][2], const pg8::Unit& u, int wr, int wc, int fr, int fq) const {
        const int rowb = u.pm * 256 + wr * 64 + fr, cw = wc * 32 + 8 * fq;
#pragma unroll
        for (int ai = 0; ai < 2; ++ai)
#pragma unroll
            for (int m = 0; m < 4; ++m) {
                const int row = rowb + ai * 128 + m * 16;
#pragma unroll
                for (int bj = 0; bj < 2; ++bj) {
                    const f32x4 v0 = acc[ai][bj][m][0], v1 = acc[ai][bj][m][1];
                    const int col = u.pn * 256 + bj * 128 + cw;
                    if constexpr (MODE == 1) {
                        if (u.pn < 3) { float* p = (float*)(ws + WS_SM) + (size_t)row * NSM + col; *(f32x4*)p = v0; *(f32x4*)(p + 4) = v1; }
                        else { store8bf((bf16*)(ws + WS_BIG) + (size_t)row * NBIG + (col - NSM), v0, v1); }
                    } else if constexpr (MODE == 2) {
                        bf16* qb = (bf16*)(ws + WS_QB) + (size_t)row * NQ;
                        if (u.pn < 4) { store8bf(qb + col, v0 * QSCALE, v1 * QSCALE); }
                        else {
                            const int r = col - 1024, h = r >> 6, q4 = ((r & 63) >> 3) * 4;
                            const float* tb = (const float*)(ws + WS_TAB) + ((size_t)pidx_of_row(row) * 32 + q4) * 2;
                            const f32x4 t01 = *(const f32x4*)tb, t23 = *(const f32x4*)(tb + 4);
                            f32x4 cs = {t01[0], t01[2], t23[0], t23[2]}, sn = {t01[1], t01[3], t23[1], t23[3]};
                            const f32x4 o1 = (v0 * cs - v1 * sn) * QSCALE, o2 = (v1 * cs + v0 * sn) * QSCALE;
                            store4bf(qb + 1024 + h * 64 + q4, o1); store4bf(qb + 1024 + h * 64 + 32 + q4, o2);
                            if (row >= MP) { bf16* ql = (bf16*)(ws + WS_QL) + ((size_t)(row - MP) * NH + h) * 320 + 256; store4bf(ql + q4, o1); store4bf(ql + 32 + q4, o2); }
                        }
                    } else if constexpr (MODE == 3) {
                        const size_t tok = (size_t)((row >> 12) * NH + u.pn) * SEQ + (row & (SEQ - 1));
                        if (bj == 0) store8bf((bf16*)(ws + WS_KP) + tok * 192 + cw, v0, v1);
                        else         store8bf((bf16*)(ws + WS_VP) + tok * 128 + cw, v0, v1);
                    } else if constexpr (MODE == 4) {
                        store8bf((bf16*)(ws + WS_QL) + ((size_t)row * NH + u.pn) * 320 + bj * 128 + cw, v0, v1);
                    } else if constexpr (MODE == 5) {
                        if (bj == 1) store8bf((bf16*)(ws + WS_ATT) + (size_t)(MP + row) * D + u.pn * 128 + cw, v0, v1);
                    } else if constexpr (MODE == 6 || MODE == 8) {
                        const float* g = (const float*)(ws + WS_MOD) + (size_t)seq_of_row(row) * (6 * D) + (MODE == 6 ? 2 : 5) * D + col;
                        const float* xr = (MODE == 6) ? ((row < MP ? x_p + (size_t)row * D : x_s + (size_t)(row - MP) * D) + col) : ((const float*)(ws + WS_X1) + (size_t)row * D + col);
                        float* o = (MODE == 6) ? ((float*)(ws + WS_X1) + (size_t)row * D + col) : (out + O_Y + (size_t)row * D + col);
                        const f32x4 g0 = *(const f32x4*)g, g1 = *(const f32x4*)(g + 4), x0 = *(const f32x4*)xr, x1 = *(const f32x4*)(xr + 4);
                        *(f32x4*)o = x0 + g0 * v0; *(f32x4*)(o + 4) = x1 + g1 * v1;
                    } else if constexpr (MODE == 7) {
                        f32x4 a = v0, b = v1;
#pragma unroll
                        for (int e = 0; e < 4; ++e) { a[e] = fmaxf(a[e], 0.f); a[e] *= a[e]; b[e] = fmaxf(b[e], 0.f); b[e] *= b[e]; }
                        store8bf((bf16*)(ws + WS_HDN) + (size_t)row * FF + col, a, b);
                    }
                }
                asm volatile("" ::: "memory");
            }
    }
};

template <int MAP> __device__ __forceinline__ int wt_row(int n) {
    if constexpr (MAP == 0) return n;
    else if constexpr (MAP == 1) return n < 704 ? n : n + 64;
    else { const int h = n / 192, j = n - h * 192;
        if (j < 128) return h * 128 + j;
        const int i = j - 128, x2 = i >> 5, idx = i & 31;
        return 1024 + h * 64 + 8 * (idx >> 2) + 4 * x2 + (idx & 3); }
}
template <int MAP> __device__ __forceinline__ void transpose_item(const float* W, int K, int N, bf16* WT, const float* kscale, LAS float* scr, int item, int lane) {
    const int nblk = N / 32, kb = item / nblk, nb = item % nblk, k0 = 64 * kb, n0 = 32 * nb;
#pragma unroll 8
    for (int i = 0; i < 32; ++i) { const int kk = 2 * i + (lane >> 5); scr[kk * 33 + (lane & 31)] = W[(size_t)(k0 + kk) * N + n0 + (lane & 31)]; }
    LDS_WAIT(); asm volatile("" ::: "memory");
    const int c = lane & 7;
    float ks[8];
#pragma unroll
    for (int e = 0; e < 8; ++e) ks[e] = kscale ? kscale[k0 + 8 * c + e] : 1.f;
#pragma unroll
    for (int j = 0; j < 4; ++j) { const int n = (lane >> 3) + 8 * j; const LAS float* s = scr + (8 * c) * 33 + n;
        v4u o; o.x = pk2(s[0 * 33] * ks[0], s[1 * 33] * ks[1]); o.y = pk2(s[2 * 33] * ks[2], s[3 * 33] * ks[3]); o.z = pk2(s[4 * 33] * ks[4], s[5 * 33] * ks[5]); o.w = pk2(s[6 * 33] * ks[6], s[7 * 33] * ks[7]);
        *(GAS v4u*)(WT + (size_t)wt_row<MAP>(n0 + n) * K + k0 + 8 * c) = o; }
    LDS_WAIT(); asm volatile("" ::: "memory");
}
__device__ __forceinline__ int crow32(int r, int hi) { return (r & 3) + 8 * (r >> 2) + 4 * hi; }
__device__ __forceinline__ bf16x8 pack8f(const float* a) {
    v4u w; w.x = pg8::cvt_pk_bf16(a[0], a[1]); w.y = pg8::cvt_pk_bf16(a[2], a[3]); w.z = pg8::cvt_pk_bf16(a[4], a[5]); w.w = pg8::cvt_pk_bf16(a[6], a[7]);
    return __builtin_bit_cast(bf16x8, w);
}
__device__ __forceinline__ void adaln_task(Frame& F, int et) {
    const int e0 = et * 32, r = F.lane & 31, h = F.lane >> 5, w = F.wave;
    f32x16 acc[5];
#pragma unroll
    for (int st = 0; st < 5; ++st)
#pragma unroll
        for (int i = 0; i < 16; ++i) acc[st][i] = 0.f;
    for (int ks = 0; ks < 8; ++ks) {
        const int k0 = w * 128 + ks * 16 + 8 * h;
        float a[8];
#pragma unroll
        for (int j = 0; j < 8; ++j) a[j] = F.w_ada[(size_t)(k0 + j) * (6 * D) + e0 + r];
        const bf16x8 af = pack8f(a);
#pragma unroll
        for (int st = 0; st < 5; ++st) {
            int s = 32 * st + r; s = s < NSEQ ? s : NSEQ - 1;
            const float* cp = (s < NB ? F.c_p + (size_t)s * D : F.c_s + (size_t)(s - NB) * D) + k0;
            const f32x4 c0 = *(const f32x4*)cp, c1 = *(const f32x4*)(cp + 4);
            float b[8] = {silu_f(c0[0]), silu_f(c0[1]), silu_f(c0[2]), silu_f(c0[3]), silu_f(c1[0]), silu_f(c1[1]), silu_f(c1[2]), silu_f(c1[3])};
            acc[st] = __builtin_amdgcn_mfma_f32_32x32x16_bf16(af, pack8f(b), acc[st], 0, 0, 0);
        }
    }
    LAS float* red = (LAS float*)F.lds;
    float* mod = (float*)(F.ws + WS_MOD);
#pragma unroll
    for (int st = 0; st < 5; ++st) {
#pragma unroll
        for (int i = 0; i < 16; ++i) red[(w * 16 + i) * 64 + F.lane] = acc[st][i];
        __syncthreads();
#pragma unroll
        for (int q = 0; q < 2; ++q) {
            const int idx = F.tid + 512 * q, reg = idx >> 6, lo = idx & 63;
            float sum = 0.f;
#pragma unroll
            for (int ww = 0; ww < 8; ++ww) sum += red[ww * 1024 + idx];
            const int s = 32 * st + (lo & 31), e = e0 + crow32(reg, lo >> 5);
            if (s < NSEQ) mod[(size_t)s * (6 * D) + e] = sum + F.b_ada[e];
        }
        __syncthreads();
    }
}
__device__ __forceinline__ void p0_prologue(Frame& F) {
    for (int et = blockIdx.x; et < (6 * D) / 32; et += F.G) adaln_task(F, et);
    __syncthreads();
    LAS float* scr = (LAS float*)(F.lds + RING_OFF + F.wave * 16384);
    constexpr int I_IN = (D / 64) * (DIN / 32), I_QB = (QLORA / 64) * (NQ / 32), I_KVB = (KVL / 64) * (2048 / 32), I_O = (D / 64) * (D / 32), I_1 = (D / 64) * (FF / 32), I_2 = (FF / 64) * (D / 32);
    constexpr int NITEMS = I_IN + I_QB + I_KVB + I_O + I_1 + I_2;
    for (int it = F.gw; it < NITEMS; it += F.NGW) {
        int r = it;
        if (r < I_IN) { transpose_item<1>(F.w_in, D, DIN, (bf16*)(F.ws + WS_WIN), nullptr, scr, r, F.lane); continue; } r -= I_IN;
        if (r < I_QB) { transpose_item<2>(F.w_q_b, QLORA, NQ, (bf16*)(F.ws + WS_WQB), F.g_q, scr, r, F.lane); continue; } r -= I_QB;
        if (r < I_KVB) { transpose_item<0>(F.w_kv_b, KVL, 2048, (bf16*)(F.ws + WS_WKVB), nullptr, scr, r, F.lane); continue; } r -= I_KVB;
        if (r < I_O) { transpose_item<0>(F.w_o, D, D, (bf16*)(F.ws + WS_WO), nullptr, scr, r, F.lane); continue; } r -= I_O;
        if (r < I_1) { transpose_item<0>(F.w_1, D, FF, (bf16*)(F.ws + WS_W1), nullptr, scr, r, F.lane); continue; } r -= I_1;
        transpose_item<0>(F.w_2, FF, D, (bf16*)(F.ws + WS_W2), nullptr, scr, r, F.lane);
    }
    const int gt = F.gw * 64 + F.lane, NGT = F.NGW * 64;
    for (int i = gt; i < 64 * D / 8; i += NGT) *(v4u*)((bf16*)(F.ws + WS_WIN) + (size_t)704 * D + (size_t)i * 8) = (v4u){0u, 0u, 0u, 0u};
    for (int i = gt; i < 2048 * 256 / 8; i += NGT) {
        const int row = i >> 5, k8 = (i & 31) * 8, hh = row >> 8, c = row & 255; v4u o = {0u, 0u, 0u, 0u};
        if (k8 < 128) { const float* s = F.w_kv_b + (size_t)c * 2048 + hh * 256 + k8; const f32x4 a = *(const f32x4*)s, b = *(const f32x4*)(s + 4);
            o.x = pk2(a[0], a[1]); o.y = pk2(a[2], a[3]); o.z = pk2(b[0], b[1]); o.w = pk2(b[2], b[3]); }
        *(v4u*)((bf16*)(F.ws + WS_WUK) + (size_t)row * 256 + k8) = o;
    }
    for (int i = gt; i < NPOS * 32; i += NGT) {
        const int p = i >> 5, fi = i & 31; const double pos = (double)(p < SEQ ? p : p + (PAST - SEQ));
        const double rev = pos * ROPE_INV[fi] * 0.15915494309189535; const float fr = (float)(rev - __builtin_rint(rev));
        f32x2 cs; cs.x = __builtin_amdgcn_cosf(fr); cs.y = __builtin_amdgcn_sinf(fr);
        *((f32x2*)(F.ws + WS_TAB) + i) = cs;
    }
}
__device__ __forceinline__ void norm_mod_row(Frame& F, const float* src, const float* g, const float* sc, const float* sh, bf16* dst) {
    f32x4 v[4]; float s = 0.f;
#pragma unroll
    for (int j = 0; j < 4; ++j) { v[j] = *((const f32x4*)src + F.lane + 64 * j); s += (v[j].x * v[j].x + v[j].y * v[j].y) + (v[j].z * v[j].z + v[j].w * v[j].w); }
    const float r = 1.f / sqrtf(wave_sum(s) * (1.f / D) + EPS);
#pragma unroll
    for (int j = 0; j < 4; ++j) { const int c4 = F.lane + 64 * j; const f32x4 gg = *((const f32x4*)g + c4), ss = *((const f32x4*)sc + c4), hh = *((const f32x4*)sh + c4);
        const f32x4 o = (v[j] * r) * gg * (ss + 1.f) + hh; store4bf(dst + c4 * 4, o); }
}
__device__ __forceinline__ void small_row(Frame& F, int m) {
    const float* sm = (const float*)(F.ws + WS_SM) + (size_t)m * NSM;
    const int l = F.lane; const bool samp = m >= MP; const int ms = m - MP;
    const f32x4 qa = *((const f32x4*)sm + l); const f32x2 qb = *((const f32x2*)(sm + 256) + l);
    float s = (qa.x * qa.x + qa.y * qa.y) + (qa.z * qa.z + qa.w * qa.w) + (qb.x * qb.x + qb.y * qb.y);
    const float rq = 1.f / sqrtf(wave_sum(s) * (1.f / QLORA) + EPS);
    bf16* qo = (bf16*)(F.ws + WS_QA) + (size_t)m * QLORA;
    store4bf(qo + 4 * l, qa * rq); *(unsigned*)(qo + 256 + 2 * l) = pg8::cvt_pk_bf16(qb.x * rq, qb.y * rq);
    const f32x4 kv = *((const f32x4*)(sm + 384) + l);
    s = (kv.x * kv.x + kv.y * kv.y) + (kv.z * kv.z + kv.w * kv.w);
    const float rk = 1.f / sqrtf(wave_sum(s) * (1.f / KVL) + EPS);
    const f32x4 kn = (kv * rk) * *((const f32x4*)F.g_kv + l);
    float* ock = samp ? F.out + O_CKVS + (size_t)ms * KVL : F.out + O_CKVP + (size_t)m * KVL;
    *((f32x4*)ock + l) = kn;
    store4bf((bf16*)(F.ws + WS_CKVN) + (size_t)m * KVL + 4 * l, kn);
    if (samp) store4bf((bf16*)(F.ws + WS_KNEW) + (size_t)ms * 320 + 4 * l, kn);
    if (l < 32) {
        const float x1 = sm[640 + l], x2 = sm[672 + l];
        const f32x2 cs = *((const f32x2*)(F.ws + WS_TAB) + (size_t)pidx_of_row(m) * 32 + l);
        const float o1 = x1 * cs.x - x2 * cs.y, o2 = x2 * cs.x + x1 * cs.y;
        float* okr = samp ? F.out + O_KRS + (size_t)ms * ROPE : F.out + O_KRP + (size_t)m * ROPE;
        okr[l] = o1; okr[32 + l] = o2;
        const bf16 b1 = (bf16)f2bf(o1), b2 = (bf16)f2bf(o2);
        if (samp) { bf16* kn2 = (bf16*)(F.ws + WS_KNEW) + (size_t)ms * 320 + 256; kn2[l] = b1; kn2[32 + l] = b2; }
        else { const int b = m >> 12, t = m & (SEQ - 1);
#pragma unroll
            for (int hh = 0; hh < NH; ++hh) { bf16* kp = (bf16*)(F.ws + WS_KP) + ((size_t)(b * NH + hh) * SEQ + t) * 192 + 128; kp[l] = b1; kp[32 + l] = b2; } }
    }
    const int t = samp ? (ms & (DSEQ - 1)) : (m & (SEQ - 1)), T = samp ? DSEQ : SEQ;
    if (t >= T - 2) {
        const bf16* big = (const bf16*)(F.ws + WS_BIG) + (size_t)m * NBIG;
        float* oc = (samp ? F.out + O_CVS + (size_t)(ms >> 3) * 2 * D : F.out + O_CVP + (size_t)(m >> 12) * 2 * D) + (size_t)(t - (T - 2)) * D;
#pragma unroll
        for (int j = 0; j < 2; ++j) { const int c8 = (l + 64 * j) * 8;
            const v4u cg = *(const v4u*)(big + 1024 + c8), xi = *(const v4u*)(big + 2048 + c8);
            f32x4 a = {bflo(cg.x) * bflo(xi.x), bfhi(cg.x) * bfhi(xi.x), bflo(cg.y) * bflo(xi.y), bfhi(cg.y) * bfhi(xi.y)};
            f32x4 b = {bflo(cg.z) * bflo(xi.z), bfhi(cg.z) * bfhi(xi.z), bflo(cg.w) * bflo(xi.w), bfhi(cg.w) * bfhi(xi.w)};
            *(f32x4*)(oc + c8) = a; *(f32x4*)(oc + c8 + 4) = b; }
    }
}
__device__ __forceinline__ void naive_attn_prompt_row(Frame& F, int rid) {
    const int h = rid & 7, m = rid >> 3, b = m >> 12, t = m & (SEQ - 1), l = F.lane;
    LAS float* qs = (LAS float*)(F.lds + F.wave * 8192); LAS float* sc = qs + 320;
    const bf16* qb = (const bf16*)(F.ws + WS_QB) + (size_t)m * NQ;
    qs[l] = bf2f(qb[h * 128 + l]); qs[64 + l] = bf2f(qb[h * 128 + 64 + l]); qs[128 + l] = bf2f(qb[1024 + h * 64 + l]);
    LDS_WAIT(); asm volatile("" ::: "memory");
    const bf16* K = (const bf16*)(F.ws + WS_KP) + (size_t)(b * NH + h) * SEQ * 192; const bf16* V = (const bf16*)(F.ws + WS_VP) + (size_t)(b * NH + h) * SEQ * 128;
    const int nk = t + 1; float mx = -1e30f, lsum = 0.f, o0 = 0.f, o1 = 0.f;
    for (int c0 = 0; c0 < nk; c0 += 1024) {
        const int cn = (nk - c0) < 1024 ? (nk - c0) : 1024; float cm = -1e30f;
        for (int i = l; i < cn; i += 64) { const bf16* kr = K + (size_t)(c0 + i) * 192; float s = 0.f;
#pragma unroll 4
            for (int d8 = 0; d8 < 24; ++d8) { const v4u kk = *(const v4u*)(kr + d8 * 8); const f32x4 qa = *(const LAS f32x4*)(qs + d8 * 8), qc = *(const LAS f32x4*)(qs + d8 * 8 + 4);
                s += bflo(kk.x) * qa.x + bfhi(kk.x) * qa.y + bflo(kk.y) * qa.z + bfhi(kk.y) * qa.w + bflo(kk.z) * qc.x + bfhi(kk.z) * qc.y + bflo(kk.w) * qc.z + bfhi(kk.w) * qc.w; }
            sc[i] = s; cm = fmaxf(cm, s); }
        cm = wave_max(cm); const float mn = fmaxf(mx, cm), alpha = exp2f(mx - mn); mx = mn; o0 *= alpha; o1 *= alpha; lsum *= alpha;
        float ps = 0.f;
        for (int i = l; i < cn; i += 64) { const float p = exp2f(sc[i] - mn); sc[i] = p; ps += p; }
        lsum += wave_sum(ps);
        LDS_WAIT(); asm volatile("" ::: "memory");
        for (int i = 0; i < cn; ++i) { const float p = sc[i]; const unsigned vv = *(const unsigned*)(V + (size_t)(c0 + i) * 128 + 2 * l); o0 += p * bflo(vv); o1 += p * bfhi(vv); }
        LDS_WAIT(); asm volatile("" ::: "memory");
    }
    const float inv = 1.f / lsum;
    *(unsigned*)((bf16*)(F.ws + WS_ATT) + (size_t)m * D + h * 128 + 2 * l) = pg8::cvt_pk_bf16(o0 * inv, o1 * inv);
}
__device__ __forceinline__ void naive_attn_decode_row(Frame& F, int rid) {
    const int h = rid & 7, sm = rid >> 3, sb = sm >> 3, t = sm & 7, l = F.lane;
    LAS float* qs = (LAS float*)(F.lds + F.wave * 8192); LAS float* sc = qs + 320;
    const bf16* ql = (const bf16*)(F.ws + WS_QL) + ((size_t)sm * NH + h) * 320;
#pragma unroll
    for (int j = 0; j < 5; ++j) qs[l + 64 * j] = bf2f(ql[l + 64 * j]);
    LDS_WAIT(); asm volatile("" ::: "memory");
    const int* pt = F.page_table + sb * NPAGES; const bf16* knew = (const bf16*)(F.ws + WS_KNEW) + (size_t)sb * DSEQ * 320;
    const int nk = PAST + t + 1; float mx = -1e30f, lsum = 0.f; f32x4 o = {0.f, 0.f, 0.f, 0.f};
    for (int c0 = 0; c0 < nk; c0 += 1024) {
        const int cn = (nk - c0) < 1024 ? (nk - c0) : 1024; float cm = -1e30f;
        for (int i = l; i < cn; i += 64) { const int j = c0 + i; float s = 0.f;
            if (j < PAST) { const size_t prow = (size_t)pt[j >> 7] * PAGE + (j & 127); const float* ck = F.cache_ckv + prow * KVL; const float* kr = F.cache_kr + prow * ROPE;
#pragma unroll 4
                for (int d4 = 0; d4 < 64; ++d4) { const f32x4 kk = *(const f32x4*)(ck + d4 * 4); const f32x4 qq = *(const LAS f32x4*)(qs + d4 * 4); s += kk.x * qq.x + kk.y * qq.y + kk.z * qq.z + kk.w * qq.w; }
#pragma unroll 4
                for (int d4 = 0; d4 < 16; ++d4) { const f32x4 kk = *(const f32x4*)(kr + d4 * 4); const f32x4 qq = *(const LAS f32x4*)(qs + 256 + d4 * 4); s += kk.x * qq.x + kk.y * qq.y + kk.z * qq.z + kk.w * qq.w; }
            } else { const bf16* kn = knew + (size_t)(j - PAST) * 320;
#pragma unroll 4
                for (int d8 = 0; d8 < 40; ++d8) { const v4u kk = *(const v4u*)(kn + d8 * 8); const f32x4 qa = *(const LAS f32x4*)(qs + d8 * 8), qc = *(const LAS f32x4*)(qs + d8 * 8 + 4);
                    s += bflo(kk.x) * qa.x + bfhi(kk.x) * qa.y + bflo(kk.y) * qa.z + bfhi(kk.y) * qa.w + bflo(kk.z) * qc.x + bfhi(kk.z) * qc.y + bflo(kk.w) * qc.z + bfhi(kk.w) * qc.w; }
            }
            sc[i] = s; cm = fmaxf(cm, s); }
        cm = wave_max(cm); const float mn = fmaxf(mx, cm), alpha = exp2f(mx - mn); mx = mn; o = o * alpha; lsum *= alpha;
        float ps = 0.f;
        for (int i = l; i < cn; i += 64) { const float p = exp2f(sc[i] - mn); sc[i] = p; ps += p; }
        lsum += wave_sum(ps);
        LDS_WAIT(); asm volatile("" ::: "memory");
        for (int i = 0; i < cn; ++i) { const int j = c0 + i; const float p = sc[i]; f32x4 vv;
            if (j < PAST) { const size_t prow = (size_t)pt[j >> 7] * PAGE + (j & 127); vv = *((const f32x4*)(F.cache_ckv + prow * KVL) + l); }
            else { const v2u w = *((const v2u*)(knew + (size_t)(j - PAST) * 320) + l); vv = (f32x4){bflo(w.x), bfhi(w.x), bflo(w.y), bfhi(w.y)}; }
            o = o + vv * p; }
        LDS_WAIT(); asm volatile("" ::: "memory");
    }
    const float inv = 1.f / lsum;
    store4bf((bf16*)(F.ws + WS_OLAT) + ((size_t)sm * NH + h) * 256 + 4 * l, o * inv);
}
__device__ __forceinline__ void merged_row(Frame& F, int m) {
    const bool samp = m >= MP; const int ms = m - MP, l = F.lane;
    const int t = samp ? (ms & (DSEQ - 1)) : (m & (SEQ - 1));
    const bf16* big = (const bf16*)(F.ws + WS_BIG) + (size_t)m * NBIG;
    const bf16* att = (const bf16*)(F.ws + WS_ATT) + (size_t)m * D; bf16* mo = (bf16*)(F.ws + WS_MERGED) + (size_t)m * D;
    const float* sc0 = F.state_conv + (size_t)(samp ? (ms >> 3) : 0) * 2 * D;
#pragma unroll
    for (int j = 0; j < 2; ++j) {
        const int c8 = (l + 64 * j) * 8;
        const v4u bg = *(const v4u*)(big + c8), cg = *(const v4u*)(big + 1024 + c8), xi = *(const v4u*)(big + 2048 + c8), ga = *(const v4u*)(big + 3072 + c8), gb = *(const v4u*)(big + 4096 + c8), at = *(const v4u*)(att + c8);
        v4u cg1 = {0u, 0u, 0u, 0u}, xi1 = cg1, cg2 = cg1, xi2 = cg1;
        if (t >= 1) { cg1 = *(const v4u*)(big - NBIG + 1024 + c8); xi1 = *(const v4u*)(big - NBIG + 2048 + c8); }
        if (t >= 2) { cg2 = *(const v4u*)(big - 2 * NBIG + 1024 + c8); xi2 = *(const v4u*)(big - 2 * NBIG + 2048 + c8); }
        float res[8];
#pragma unroll
        for (int e = 0; e < 8; ++e) {
            const unsigned wb = ((const unsigned*)&bg)[e >> 1], wc = ((const unsigned*)&cg)[e >> 1], wx = ((const unsigned*)&xi)[e >> 1], wa = ((const unsigned*)&ga)[e >> 1], wg = ((const unsigned*)&gb)[e >> 1], wt = ((const unsigned*)&at)[e >> 1];
            const unsigned wc1 = ((const unsigned*)&cg1)[e >> 1], wx1 = ((const unsigned*)&xi1)[e >> 1], wc2 = ((const unsigned*)&cg2)[e >> 1], wx2 = ((const unsigned*)&xi2)[e >> 1];
#define SEL(w) ((e & 1) ? bfhi(w) : bflo(w))
            const int col = c8 + e;
            const float v0 = SEL(wc) * SEL(wx);
            float v1 = SEL(wc1) * SEL(wx1), v2 = SEL(wc2) * SEL(wx2);
            if (samp) { if (t == 0) { v1 = sc0[D + col]; v2 = sc0[col]; } else if (t == 1) { v2 = sc0[D + col]; } }
            const float z = F.conv_w[col] * v2 + F.conv_w[D + col] * v1 + F.conv_w[2 * D + col] * v0;
            res[e] = sigmoid_f(SEL(wa)) * SEL(wt) + sigmoid_f(SEL(wg)) * (SEL(wb) * z);
#undef SEL
        }
        v4u o; o.x = pg8::cvt_pk_bf16(res[0], res[1]); o.y = pg8::cvt_pk_bf16(res[2], res[3]); o.z = pg8::cvt_pk_bf16(res[4], res[5]); o.w = pg8::cvt_pk_bf16(res[6], res[7]);
        *(v4u*)(mo + c8) = o;
    }
}
__device__ __forceinline__ void final_row(Frame& F, int m) {
    float* y = F.out + O_Y + (size_t)m * D; f32x4 v[4]; float s = 0.f;
#pragma unroll
    for (int j = 0; j < 4; ++j) { v[j] = *((const f32x4*)y + F.lane + 64 * j); s += (v[j].x * v[j].x + v[j].y * v[j].y) + (v[j].z * v[j].z + v[j].w * v[j].w); }
    const float r = 1.f / sqrtf(wave_sum(s) * (1.f / D) + EPS);
#pragma unroll
    for (int j = 0; j < 4; ++j) *((f32x4*)y + F.lane + 64 * j) = (v[j] * r) * *((const f32x4*)F.g_final + F.lane + 64 * j);
}
#define SBAR() __builtin_amdgcn_sched_barrier(0)
typedef short s16x4 __attribute__((ext_vector_type(4)));
typedef LAS s16x4* lds_s16x4p;
__device__ __forceinline__ unsigned cvtpk(float lo, float hi) { return pg8::cvt_pk_bf16(lo, hi); }
__device__ __forceinline__ bf16x8 ld_lds8(LAS unsigned char* p) { return *(const LAS bf16x8*)p; }
__device__ __forceinline__ s16x4 tr_rd(LAS unsigned char* p) { return __builtin_bit_cast(s16x4, __builtin_amdgcn_ds_read_tr16_b64_v4i16((LAS s16x4*)p)); }
__device__ __forceinline__ unsigned off_b(unsigned row, unsigned ch) { return 256u * row + 16u * (ch ^ (((row & 3) << 2) | ((row >> 2) & 3))); }
__device__ __forceinline__ unsigned off_r(unsigned row, unsigned ch) { return 128u * row + 16u * (ch ^ ((row >> 1) & 7)); }
__device__ __forceinline__ unsigned tr_addr(unsigned lane, unsigned rowbase, unsigned c, unsigned ks, unsigned t) {
    const unsigned h = lane >> 5, blk = (lane >> 4) & 1, q = (lane & 15) >> 2, p = lane & 3;
    return off_b(rowbase + 16 * ks + 8 * h + 4 * t + q, 4 * c + 2 * blk + (p >> 1)) + 8 * (p & 1);
}
constexpr float THR2 = 11.5f;
#define PK4(P, B_, OUT) do { unsigned a0 = cvtpk(P[B_+0], P[B_+1]), a1 = cvtpk(P[B_+2], P[B_+3]);                          \
        unsigned b0 = cvtpk(P[B_+4], P[B_+5]), b1 = cvtpk(P[B_+6], P[B_+7]);                                             \
        auto r0 = __builtin_amdgcn_permlane32_swap(a0, b0, false, false); auto r1 = __builtin_amdgcn_permlane32_swap(a1, b1, false, false); \
        v4u w = {r0[0], r1[0], r0[1], r1[1]}; OUT = __builtin_bit_cast(bf16x8, w); } while (0)
__device__ __forceinline__ float swap_max(float v) { auto rr = __builtin_amdgcn_permlane32_swap(__float_as_uint(v), __float_as_uint(v), false, false); return fmaxf(__uint_as_float(rr[0]), __uint_as_float(rr[1])); }
__device__ __forceinline__ float swap_sum(float v) { auto rr = __builtin_amdgcn_permlane32_swap(__float_as_uint(v), __float_as_uint(v), false, false); return __uint_as_float(rr[0]) + __uint_as_float(rr[1]); }
__device__ __forceinline__ void softmax64(f32x16& p0, f32x16& p1, float& m_reg, float& l_reg, float& alpha, bf16x8& pa0, bf16x8& pa1, bf16x8& pa2, bf16x8& pa3) {
    float pmax = p0[0];
#pragma unroll
    for (int r = 1; r < 16; ++r) pmax = fmaxf(pmax, p0[r]);
#pragma unroll
    for (int r = 0; r < 16; ++r) pmax = fmaxf(pmax, p1[r]);
    pmax = swap_max(pmax);
    float mn;
    if (__all(pmax - m_reg <= THR2)) { mn = m_reg; alpha = 1.f; } else { mn = fmaxf(m_reg, pmax); alpha = __builtin_amdgcn_exp2f(m_reg - mn); m_reg = mn; }
    float ps = 0.f;
#pragma unroll
    for (int r = 0; r < 16; ++r) { p0[r] = __builtin_amdgcn_exp2f(p0[r] - mn); ps += p0[r]; }
#pragma unroll
    for (int r = 0; r < 16; ++r) { p1[r] = __builtin_amdgcn_exp2f(p1[r] - mn); ps += p1[r]; }
    l_reg = l_reg * alpha + swap_sum(ps);
    PK4(p0, 0, pa0); PK4(p0, 8, pa1); PK4(p1, 0, pa2); PK4(p1, 8, pa3);
}
__device__ __forceinline__ void softmax32(f32x16& p0, float& m_reg, float& l_reg, float& alpha, bf16x8& pa0, bf16x8& pa1) {
    float pmax = p0[0];
#pragma unroll
    for (int r = 1; r < 16; ++r) pmax = fmaxf(pmax, p0[r]);
    pmax = swap_max(pmax);
    float mn;
    if (__all(pmax - m_reg <= THR2)) { mn = m_reg; alpha = 1.f; } else { mn = fmaxf(m_reg, pmax); alpha = __builtin_amdgcn_exp2f(m_reg - mn); m_reg = mn; }
    float ps = 0.f;
#pragma unroll
    for (int r = 0; r < 16; ++r) { p0[r] = __builtin_amdgcn_exp2f(p0[r] - mn); ps += p0[r]; }
    l_reg = l_reg * alpha + swap_sum(ps);
    PK4(p0, 0, pa0); PK4(p0, 8, pa1);
}
constexpr int PA_V = 0, PA_VB = 16384, PA_K = 2 * PA_VB, PA_KB = 24576, PA_SCR = PA_K + 2 * PA_KB;
__device__ __forceinline__ int pv_st(int k, int c) { const int kk = (k & ~0xC) | ((k & 4) << 1) | ((k & 8) >> 1); return ((kk >> 3) * 4 + (c >> 5)) * 512 + ((kk & 7) * 32 + (c & 31)) * 2; }
__device__ __forceinline__ int pv_rd_base(int lane) { return ((lane & 3) << 3) | (((lane >> 2) & 3) << 6) | (((lane >> 4) & 1) << 5) | (((lane >> 5) & 1) << 8); }
template <int VB> __device__ __forceinline__ void pa_pv_tile(f32x16* o, unsigned vb0, bf16x8 pa0, bf16x8 pa1, bf16x8 pa2, bf16x8 pa3) {
#define TRRD(dst, off) asm volatile("ds_read_b64_tr_b16 %0, %1 offset:%2" : "=&v"(dst) : "v"(vb0), "i"(off) : "memory")
#define PV_D0(d0) do { s16x4 l0, l1, l2, l3, h0, h1, h2, h3; constexpr int b_ = PA_V + VB * PA_VB + (d0) * 512;   \
        TRRD(l0, b_); TRRD(h0, b_ + 2048); TRRD(l1, b_ + 4096); TRRD(h1, b_ + 6144); TRRD(l2, b_ + 8192); TRRD(h2, b_ + 10240); TRRD(l3, b_ + 12288); TRRD(h3, b_ + 14336); \
        asm volatile("s_waitcnt lgkmcnt(0)" ::: "memory"); SBAR();   \
        o[d0] = __builtin_amdgcn_mfma_f32_32x32x16_bf16(pa0, (bf16x8){l0[0], l0[1], l0[2], l0[3], h0[0], h0[1], h0[2], h0[3]}, o[d0], 0, 0, 0);   \
        o[d0] = __builtin_amdgcn_mfma_f32_32x32x16_bf16(pa1, (bf16x8){l1[0], l1[1], l1[2], l1[3], h1[0], h1[1], h1[2], h1[3]}, o[d0], 0, 0, 0);   \
        o[d0] = __builtin_amdgcn_mfma_f32_32x32x16_bf16(pa2, (bf16x8){l2[0], l2[1], l2[2], l2[3], h2[0], h2[1], h2[2], h2[3]}, o[d0], 0, 0, 0);   \
        o[d0] = __builtin_amdgcn_mfma_f32_32x32x16_bf16(pa3, (bf16x8){l3[0], l3[1], l3[2], l3[3], h3[0], h3[1], h3[2], h3[3]}, o[d0], 0, 0, 0); } while (0)
    PV_D0(0); PV_D0(1); PV_D0(2); PV_D0(3);
#undef PV_D0
#undef TRRD
}
__device__ __forceinline__ void attn_prompt_block(Frame& F, int b, int h, int qb) {
    unsigned z_ = 0u; asm volatile("" : "+v"(z_)); const int lane = (int)__builtin_amdgcn_mbcnt_hi(~0u, __builtin_amdgcn_mbcnt_lo(~0u, z_));
    const int wid = F.wave, tid = wid * 64 + lane, r32 = lane & 31, hi = lane >> 5;
    LAS unsigned char* L = F.lds;
    const bf16* Kg = (const bf16*)(F.ws + WS_KP) + (size_t)(b * NH + h) * SEQ * 192;
    const bf16* Vg = (const bf16*)(F.ws + WS_VP) + (size_t)(b * NH + h) * SEQ * 128;
    const int row0 = b * SEQ + qb * 256 + wid * 32;
    const int qpos = qb * 256 + wid * 32 + r32;
    const int qlo = qb * 256 + wid * 32;
    const int NT = 4 * (qb + 1);
    bf16x8 qr[12];
    { const bf16* qp = (const bf16*)(F.ws + WS_QB) + (size_t)(row0 + r32) * NQ;
#pragma unroll
      for (int d0 = 0; d0 < 12; ++d0) qr[d0] = *(const bf16x8*)(qp + (d0 < 8 ? h * 128 + 16 * d0 + 8 * hi : 1024 + h * 64 + 16 * (d0 - 8) + 8 * hi)); }
    unsigned kso[3], vso[2];
#pragma unroll
    for (int i = 0; i < 3; ++i) { const unsigned p = (unsigned)(wid * 3 + i) * 64 + lane, row = p / 24, chp = p - row * 24, ch = chp ^ ((row >> 1) & 7); kso[i] = row * 192 + ch * 8; }
#pragma unroll
    for (int i = 0; i < 2; ++i) { const unsigned B_ = ((unsigned)(wid * 2 + i) * 64 + lane) * 16, st = B_ >> 9, wi = B_ & 511, kk = (st >> 2) * 8 + (wi >> 6), c = (st & 3) * 32 + ((wi & 63) >> 1);
        const unsigned k = (kk & ~0xCu) | ((kk & 4) << 1) | ((kk & 8) >> 1); vso[i] = k * 128 + c; }
#define PA_STAGE(t, bf) do { const bf16* kt = Kg + (size_t)(t) * 64 * 192; const bf16* vt = Vg + (size_t)(t) * 64 * 128;   \
        _Pragma("unroll") for (int i = 0; i < 3; ++i) __builtin_amdgcn_global_load_lds((const unsigned*)(kt + kso[i]), (LAS unsigned*)(L + PA_K + (bf) * PA_KB + (wid * 3 + i) * 1024), 16, 0, 0);   \
        _Pragma("unroll") for (int i = 0; i < 2; ++i) __builtin_amdgcn_global_load_lds((const unsigned*)(vt + vso[i]), (LAS unsigned*)(L + PA_V + (bf) * PA_VB + (wid * 2 + i) * 1024), 16, 0, 0); } while (0)
    LAS float* al_l = (LAS float*)(L + PA_SCR + wid * 256); LAS float* li_l = al_l + 32;
    const unsigned vb0 = (unsigned)pv_rd_base(lane);
    const int fx = (r32 >> 1) & 7;
    int kb4[4];
#pragma unroll
    for (int dd = 0; dd < 4; ++dd) kb4[dd] = r32 * 384 + (((2 * dd + hi) ^ fx) << 4);
    float m_reg = -1e30f, l_reg = 0.f; f32x16 o[4];
#pragma unroll
    for (int d = 0; d < 4; ++d)
#pragma unroll
        for (int r = 0; r < 16; ++r) o[d][r] = 0.f;
    PA_STAGE(0, 0); VM_WAIT();
    __syncthreads();
#define PA_STEP(t, KB) do {                                                                                                     \
        if ((t) + 1 < NT) PA_STAGE((t) + 1, (KB) ^ 1);                                                                          \
        f32x16 p0, p1;                                                                                                          \
        _Pragma("unroll") for (int r = 0; r < 16; ++r) { p0[r] = 0.f; p1[r] = 0.f; }                                            \
        _Pragma("unroll") for (int g_ = 0; g_ < 6; ++g_) { bf16x8 kf[4];                                                        \
            _Pragma("unroll") for (int dd = 0; dd < 2; ++dd) { const int d0 = 2 * g_ + dd; LAS unsigned char* a = L + PA_K + (KB) * PA_KB + kb4[d0 & 3] + (d0 >> 2) * 128; kf[2 * dd] = ld_lds8(a); kf[2 * dd + 1] = ld_lds8(a + 32 * 384); }   \
            SBAR();                                                                                                             \
            _Pragma("unroll") for (int dd = 0; dd < 2; ++dd) {                                                                  \
                p0 = __builtin_amdgcn_mfma_f32_32x32x16_bf16(kf[2 * dd], qr[2 * g_ + dd], p0, 0, 0, 0);                          \
                p1 = __builtin_amdgcn_mfma_f32_32x32x16_bf16(kf[2 * dd + 1], qr[2 * g_ + dd], p1, 0, 0, 0); }                    \
            SBAR(); }                                                                                                           \
        const int kb_ = (t) * 64;                                                                                               \
        if (kb_ + 63 > qlo) { const float NEG = -__builtin_inff();                                                              \
            _Pragma("unroll") for (int r = 0; r < 16; ++r) { const int key = kb_ + crow32(r, hi); if (key > qpos) p0[r] = NEG; if (key + 32 > qpos) p1[r] = NEG; } }   \
        float alpha; bf16x8 pa0, pa1, pa2, pa3;                                                                                 \
        softmax64(p0, p1, m_reg, l_reg, alpha, pa0, pa1, pa2, pa3);                                                             \
        if (__any(alpha < 1.f)) { if (hi == 0) al_l[r32] = alpha; LDS_WAIT();                                                    \
            _Pragma("unroll") for (int r = 0; r < 16; ++r) { const float a_ = al_l[crow32(r, hi)];                              \
                _Pragma("unroll") for (int d_ = 0; d_ < 4; ++d_) o[d_][r] *= a_; } }                                            \
        pa_pv_tile<KB>(o, vb0, pa0, pa1, pa2, pa3);                                                                             \
        VM_WAIT();                                                                                                              \
        __syncthreads(); } while (0)
    for (int t = 0; t < NT; t += 2) { PA_STEP(t, 0); PA_STEP(t + 1, 1); }
#undef PA_STEP
#undef PA_STAGE
    if (hi == 0) li_l[r32] = l_reg;
    LDS_WAIT();
    { unsigned eo = (unsigned)(4 * hi * D + r32);
      asm volatile("" : "+v"(eo));
      bf16* Ow = (bf16*)(F.ws + WS_ATT) + (size_t)row0 * D + h * 128;
#pragma unroll
      for (int r = 0; r < 16; ++r) { const int orow = crow32(r, hi); const float rl = __builtin_amdgcn_rcpf(li_l[orow]);
#pragma unroll
        for (int d0 = 0; d0 < 4; ++d0) { const float v = o[d0][r] * rl; const float vn = __shfl_xor(v, 1);
            if ((r32 & 1) == 0) *(unsigned*)(Ow + eo + ((r & 3) + 8 * (r >> 2)) * D + d0 * 32) = cvtpk(v, vn); } } }
    __syncthreads();
}
constexpr int DA_Q = 0, DA_IMG = 40960, DA_K = DA_IMG, DA_SCR = 3 * DA_IMG, DA_L1 = 16384, DA_R = 32768;
__device__ __forceinline__ void attn_decode_unit(Frame& F, int sb, int sp) {
    unsigned z_ = 0u; asm volatile("" : "+v"(z_)); const int lane = (int)__builtin_amdgcn_mbcnt_hi(~0u, __builtin_amdgcn_mbcnt_lo(~0u, z_));
    const int wid = F.wave, tid = wid * 64 + lane, r32 = lane & 31, hi = lane >> 5;
    const int kh = wid & 1, qh = (wid >> 1) & 1, dh = wid >> 2;
    LAS unsigned char* L = F.lds;
    const int* pt = F.page_table + sb * NPAGES + sp * 32;
    { const bf16* ql = (const bf16*)(F.ws + WS_QL) + (size_t)sb * 64 * 320;
#pragma unroll
      for (int i = 0; i < 5; ++i) { const int id = tid + 512 * i, row = id / 40, ch = id - row * 40; const bf16x8 v = *(const bf16x8*)(ql + (size_t)row * 320 + ch * 8);
          const unsigned o_ = ch < 16 ? off_b(row, ch) : (ch < 32 ? DA_L1 + off_b(row, ch - 16) : DA_R + off_r(row, ch - 32));
          *(LAS bf16x8*)(L + DA_Q + o_) = v; } }
    f32x4 sc_[8], sr_[2];
#define DA_SLOAD(t) do { const size_t prow = (size_t)pt[(t) >> 1] * PAGE + ((t) & 1) * 64;                                      \
        _Pragma("unroll") for (int i = 0; i < 8; ++i) { const int id = tid + 512 * i; sc_[i] = *(const f32x4*)(F.cache_ckv + (prow + (id >> 6)) * KVL + (id & 63) * 4); }   \
        _Pragma("unroll") for (int i = 0; i < 2; ++i) { const int id = tid + 512 * i; sr_[i] = *(const f32x4*)(F.cache_kr + (prow + (id >> 4)) * ROPE + (id & 15) * 4); } } while (0)
#define DA_SWRITE(bf) do { LAS unsigned char* Kb = L + DA_K + (bf) * DA_IMG;                                                    \
        _Pragma("unroll") for (int i = 0; i < 8; ++i) { const int id = tid + 512 * i, row = id >> 6, c4 = id & 63;              \
            v2u w; w.x = cvtpk(sc_[i][0], sc_[i][1]); w.y = cvtpk(sc_[i][2], sc_[i][3]);                                        \
            *(LAS v2u*)(Kb + (c4 >> 5) * DA_L1 + off_b(row, (c4 & 31) >> 1) + 8 * (c4 & 1)) = w; }                              \
        _Pragma("unroll") for (int i = 0; i < 2; ++i) { const int id = tid + 512 * i, row = id >> 4, c4 = id & 15;              \
            v2u w; w.x = cvtpk(sr_[i][0], sr_[i][1]); w.y = cvtpk(sr_[i][2], sr_[i][3]);                                        \
            *(LAS v2u*)(Kb + DA_R + off_r(row, c4 >> 1) + 8 * (c4 & 1)) = w; } } while (0)
    LAS float* al_l = (LAS float*)(L + DA_SCR + wid * 256);
    const unsigned krow = 32 * kh + r32, qrow = 32 * qh + r32;
    float m_reg = -1e30f, l_reg = 0.f; f32x16 o[4];
#pragma unroll
    for (int d = 0; d < 4; ++d)
#pragma unroll
        for (int r = 0; r < 16; ++r) o[d][r] = 0.f;
    constexpr int NT = 64;
    DA_SLOAD(0); VM_WAIT(); DA_SWRITE(0);
    __syncthreads();
#define DA_COMPUTE(bf, MASKNEW) do { LAS unsigned char* Kb = L + DA_K + (bf) * DA_IMG; LAS unsigned char* Qb = L + DA_Q;         \
        unsigned kr_ = krow, qr_ = qrow, ln_ = lane; asm volatile("" : "+v"(kr_), "+v"(qr_), "+v"(ln_));     \
        const unsigned xk = ((kr_ & 3) << 2) | ((kr_ >> 2) & 3), xq = ((qr_ & 3) << 2) | ((qr_ >> 2) & 3), fk = (kr_ >> 1) & 7, fq = (qr_ >> 1) & 7;   \
        f32x16 p0;                                                                                                              \
        _Pragma("unroll") for (int r = 0; r < 16; ++r) p0[r] = 0.f;                                                             \
        _Pragma("unroll") for (int g_ = 0; g_ < 10; ++g_) { bf16x8 kf[2], qf[2];                                                 \
            _Pragma("unroll") for (int ss = 0; ss < 2; ++ss) { const int s = 2 * g_ + ss;                                       \
                const unsigned ka = s < 16 ? (s >> 3) * DA_L1 + 256u * kr_ + 16u * ((2 * (s & 7) + hi) ^ xk) : DA_R + 128u * kr_ + 16u * ((2 * (s - 16) + hi) ^ fk);   \
                const unsigned qa = s < 16 ? (s >> 3) * DA_L1 + 256u * qr_ + 16u * ((2 * (s & 7) + hi) ^ xq) : DA_R + 128u * qr_ + 16u * ((2 * (s - 16) + hi) ^ fq);   \
                kf[ss] = ld_lds8(Kb + ka); qf[ss] = ld_lds8(Qb + qa); }                                                         \
            SBAR();                                                                                                             \
            _Pragma("unroll") for (int ss = 0; ss < 2; ++ss) p0 = __builtin_amdgcn_mfma_f32_32x32x16_bf16(kf[ss], qf[ss], p0, 0, 0, 0);   \
            SBAR(); }                                                                                                           \
        if (MASKNEW) { const float NEG = -__builtin_inff(); const int tq = (int)qrow >> 3;                                      \
            _Pragma("unroll") for (int r = 0; r < 16; ++r) { const int kk = crow32(r, hi); if (kk > tq) p0[r] = NEG; } }         \
        float alpha; bf16x8 pa0, pa1;                                                                                           \
        softmax32(p0, m_reg, l_reg, alpha, pa0, pa1);                                                                           \
        if (__any(alpha < 1.f)) { if (hi == 0) al_l[r32] = alpha; LDS_WAIT();                                                    \
            _Pragma("unroll") for (int r = 0; r < 16; ++r) { const float a_ = al_l[crow32(r, hi)];                              \
                _Pragma("unroll") for (int d_ = 0; d_ < 4; ++d_) o[d_][r] *= a_; } }                                            \
        LAS unsigned char* Vb = Kb + dh * DA_L1;                                                                                \
        _Pragma("unroll") for (int c = 0; c < 4; ++c) {                                                                         \
            const s16x4 a0 = tr_rd(Vb + tr_addr(ln_, 32 * kh, c, 0, 0)), a1 = tr_rd(Vb + tr_addr(ln_, 32 * kh, c, 0, 1));       \
            const s16x4 b0 = tr_rd(Vb + tr_addr(ln_, 32 * kh, c, 1, 0)), b1 = tr_rd(Vb + tr_addr(ln_, 32 * kh, c, 1, 1));       \
            SBAR();                                                                                                             \
            o[c] = __builtin_amdgcn_mfma_f32_32x32x16_bf16(pa0, (bf16x8){a0[0], a0[1], a0[2], a0[3], a1[0], a1[1], a1[2], a1[3]}, o[c], 0, 0, 0);   \
            o[c] = __builtin_amdgcn_mfma_f32_32x32x16_bf16(pa1, (bf16x8){b0[0], b0[1], b0[2], b0[3], b1[0], b1[1], b1[2], b1[3]}, o[c], 0, 0, 0);   \
            SBAR(); } } while (0)
    for (int t = 0; t < NT; t += 2) {
        if (t + 1 < NT) DA_SLOAD(t + 1);
        DA_COMPUTE(0, false);
        if (t + 1 < NT) { VM_WAIT(); DA_SWRITE(1); }
        __syncthreads();
        if (t + 2 < NT) DA_SLOAD(t + 2);
        DA_COMPUTE(1, false);
        if (t + 2 < NT) { VM_WAIT(); DA_SWRITE(0); }
        __syncthreads();
    }
    if (sp == 1) {
        { LAS unsigned char* Kb = L + DA_K; const bf16* kn = (const bf16*)(F.ws + WS_KNEW) + (size_t)sb * DSEQ * 320;
          int tid2 = tid; asm volatile("" : "+v"(tid2));
#pragma unroll
          for (int i = 0; i < 5; ++i) { const int id = tid2 + 512 * i, row = id / 40, ch = id - row * 40; bf16x8 v = {0, 0, 0, 0, 0, 0, 0, 0};
              if (row < DSEQ) v = *(const bf16x8*)(kn + (size_t)row * 320 + ch * 8);
              const unsigned o_ = ch < 16 ? off_b(row, ch) : (ch < 32 ? DA_L1 + off_b(row, ch - 16) : DA_R + off_r(row, ch - 32));
              *(LAS bf16x8*)(Kb + o_) = v; } }
        __syncthreads();
        if (kh == 0) { DA_COMPUTE(0, true); }
        __syncthreads();
    }
#undef DA_COMPUTE
#undef DA_SLOAD
#undef DA_SWRITE
    { unsigned l2 = (unsigned)lane; asm volatile("" : "+v"(l2));
      const unsigned e_r32 = l2 & 31, e_hi = l2 >> 5; const int pi = 2 * sp + kh;
      float* po = (float*)(F.ws + WS_PART) + ((size_t)(sb * 4 + pi) * 64 + 32 * qh) * 256 + 128 * dh;
      const unsigned eo = 4 * e_hi * 256 + e_r32;
#pragma unroll
      for (int r = 0; r < 16; ++r) {
#pragma unroll
        for (int c = 0; c < 4; ++c) po[eo + ((r & 3) + 8 * (r >> 2)) * 256 + 32 * c] = o[c][r]; }
      if (dh == 0 && e_hi == 0) { float* ml = (float*)(F.ws + WS_ML) + ((size_t)(sb * 4 + pi) * 64 + 32 * qh + e_r32) * 2; ml[0] = m_reg; ml[1] = l_reg; } }
    __syncthreads();
}
__device__ __forceinline__ void decode_combine_row(Frame& F, int row) {
    const int sb = row >> 6, q = row & 63, l = F.lane;
    const float* ml = (const float*)(F.ws + WS_ML); const float* po = (const float*)(F.ws + WS_PART);
    float mm[4], ll[4], M_ = -1e30f;
#pragma unroll
    for (int p = 0; p < 4; ++p) { const f32x2 v = *(const f32x2*)(ml + ((size_t)(sb * 4 + p) * 64 + q) * 2); mm[p] = v.x; ll[p] = v.y; M_ = fmaxf(M_, v.x); }
    float Lsum = 0.f; f32x4 acc = {0.f, 0.f, 0.f, 0.f};
#pragma unroll
    for (int p = 0; p < 4; ++p) { const float w = exp2f(mm[p] - M_); Lsum += w * ll[p]; acc = acc + *((const f32x4*)(po + ((size_t)(sb * 4 + p) * 64 + q) * 256) + l) * w; }
    store4bf((bf16*)(F.ws + WS_OLAT) + (size_t)row * 256 + 4 * l, acc * (1.f / Lsum));
}

struct Args { const void* in[22]; float* out; unsigned char* ws; int ph_lo, ph_hi; };
__global__ void __launch_bounds__(NWAVES * 64, 2) mk_fwd(Args args) {
    extern __shared__ __attribute__((aligned(16))) unsigned char lds[];
    Frame F;
    F.lds = (LAS unsigned char*)lds;
    F.MISC = (volatile LAS unsigned*)(F.lds + MISC_OFF);
    F.tid = threadIdx.x; F.lane = F.tid & 63; F.wave = __builtin_amdgcn_readfirstlane(F.tid >> 6);
    F.G = gridDim.x; F.gw = blockIdx.x * NWAVES + F.wave; F.NGW = F.G * NWAVES;
    F.ws = args.ws; F.out = args.out; F.ctl = (gu32*)(args.ws + WS_CTL);
    F.x_p = (const float*)args.in[0]; F.x_s = (const float*)args.in[1]; F.cache_ckv = (const float*)args.in[2]; F.cache_kr = (const float*)args.in[3]; F.state_conv = (const float*)args.in[4];
    F.page_table = (const int*)args.in[5]; F.c_p = (const float*)args.in[6]; F.c_s = (const float*)args.in[7]; F.w_ada = (const float*)args.in[8]; F.b_ada = (const float*)args.in[9];
    F.g_attn = (const float*)args.in[10]; F.w_in = (const float*)args.in[11]; F.g_q = (const float*)args.in[12]; F.w_q_b = (const float*)args.in[13]; F.g_kv = (const float*)args.in[14];
    F.w_kv_b = (const float*)args.in[15]; F.conv_w = (const float*)args.in[16]; F.w_o = (const float*)args.in[17]; F.g_mlp = (const float*)args.in[18]; F.w_1 = (const float*)args.in[19];
    F.w_2 = (const float*)args.in[20]; F.g_final = (const float*)args.in[21];
    for (int u = F.tid; u < (LDS_BYTES - LDSCTL_OFF) / 4; u += NWAVES * 64) ((LAS unsigned*)(F.lds + LDSCTL_OFF))[u] = 0u;
    __syncthreads();
    XcdBarrier bar; bar.bar = (unsigned*)(F.ctl + CW_BAR); bar.x = 0; bar.st = nullptr;
    if (!MK_PER_PHASE) bar = xcd_barrier_post((unsigned*)(F.ctl + CW_BAR), F.MISC + 8);
#define GRID_BAR() do { if (MK_PER_PHASE) { if (F.tid == 0) __hip_atomic_store(F.ctl + CW_TMO, 0xBADBA0u, RLX_AGENT); } else { xcd_barrier(bar); } } while (0)
    const int lo = args.ph_lo, hi = args.ph_hi;
#ifndef PH_MASK
#define PH_MASK 0xFFFFFFFFu
#endif
#define IN(k) (((PH_MASK >> (k)) & 1u) && lo <= (k) && (k) < hi)
#define BOTH(k) (IN(k) && IN((k) + 1))
#define RELANE() do { unsigned z_ = 0u; asm volatile("" : "+v"(z_)); int l_ = (int)__builtin_amdgcn_mbcnt_hi(~0u, __builtin_amdgcn_mbcnt_lo(~0u, z_)); F.lane = l_; F.tid = F.wave * 64 + l_; } while (0)
    const pg8::bf16_t* U = (const pg8::bf16_t*)(F.ws + WS_U);
    float* mod = (float*)(F.ws + WS_MOD);

    if (IN(0)) { RELANE(); p0_prologue(F); if (BOTH(0)) GRID_BAR(); }
    if (IN(1)) { RELANE();
        for (int m = F.gw; m < M; m += F.NGW) { const float* mr = mod + (size_t)seq_of_row(m) * (6 * D);
            norm_mod_row(F, m < MP ? F.x_p + (size_t)m * D : F.x_s + (size_t)(m - MP) * D, F.g_attn, mr + D, mr, (bf16*)(F.ws + WS_U) + (size_t)m * D); }
        if (BOTH(1)) GRID_BAR();
    }
    if (IN(2)) { RELANE();
        pg8::Gemm g{U, (const pg8::bf16_t*)(F.ws + WS_WIN), M, NIN, D, D, D, 0}; pg8::StaticOrder S; S.init(M, NIN, F.G, (int)blockIdx.x);
        Epi<1> E{F.ws, F.x_p, F.x_s, F.out};
        pg8::gemm_phase<Epi<1>, pg8::StaticOrder, true, true>(F.lds + RING_OFF, g, S, E);
        if (BOTH(2)) GRID_BAR();
    }
    if (IN(3)) { RELANE(); for (int m = F.gw; m < M; m += F.NGW) small_row(F, m); if (BOTH(3)) GRID_BAR(); }
    if (IN(4)) { RELANE();
        { pg8::Gemm g{(const pg8::bf16_t*)(F.ws + WS_QA), (const pg8::bf16_t*)(F.ws + WS_WQB), M, NQ, QLORA, QLORA, QLORA, 0}; pg8::StaticOrder S; S.init(M, NQ, F.G, (int)blockIdx.x);
          Epi<2> E{F.ws, F.x_p, F.x_s, F.out};
          pg8::gemm_phase<Epi<2>, pg8::StaticOrder, true, true>(F.lds + RING_OFF, g, S, E); }
        __syncthreads();
        { pg8::Gemm g{(const pg8::bf16_t*)(F.ws + WS_CKVN), (const pg8::bf16_t*)(F.ws + WS_WKVB), MP, 2048, KVL, KVL, KVL, 0}; pg8::StaticOrder S; S.init(MP, 2048, F.G, (int)blockIdx.x);
          Epi<3> E{F.ws, F.x_p, F.x_s, F.out};
          pg8::gemm_phase<Epi<3>, pg8::StaticOrder, true, true>(F.lds + RING_OFF, g, S, E); }
        if (BOTH(4)) GRID_BAR();
    }
    if (IN(5)) { RELANE();
        pg8::Gemm g{(const pg8::bf16_t*)(F.ws + WS_QB) + (size_t)MP * NQ, (const pg8::bf16_t*)(F.ws + WS_WUK), MS, 2048, 256, NQ, 256, 128 * 2}; pg8::StaticOrder S; S.init(MS, 2048, F.G, (int)blockIdx.x);
        Epi<4> E{F.ws, F.x_p, F.x_s, F.out};
        pg8::gemm_phase<Epi<4>, pg8::StaticOrder, true, true>(F.lds + RING_OFF, g, S, E);
        if (BOTH(5)) GRID_BAR();
    }
    if (IN(6)) { RELANE();
        const bool dec_first = (blockIdx.x & 1) != 0;
        if (dec_first) { for (int du = blockIdx.x; du < 2 * DB; du += F.G) attn_decode_unit(F, du >> 1, du & 1); }
        for (int it = blockIdx.x; it < NB * NH * 8; it += F.G) {
            const int xcd = it & 7, j = it >> 3, bh = (xcd * 4 + (j >> 3)) & 31, pr = j & 7, b = bh >> 3, h = bh & 7;
            for (int k = 0; k < 2; ++k) attn_prompt_block(F, b, h, k == 0 ? 15 - pr : pr);
        }
        if (!dec_first) { for (int du = blockIdx.x; du < 2 * DB; du += F.G) attn_decode_unit(F, du >> 1, du & 1); }
        if (BOTH(6)) GRID_BAR();
    }
    if (IN(7)) { RELANE(); for (int r = F.gw; r < MS * NH; r += F.NGW) decode_combine_row(F, r); if (BOTH(7)) GRID_BAR(); }
    if (IN(8)) { RELANE();
        pg8::Gemm g{(const pg8::bf16_t*)(F.ws + WS_OLAT), (const pg8::bf16_t*)(F.ws + WS_WKVB), MS, 2048, 256, 2048, 256, 256 * 2}; pg8::StaticOrder S; S.init(MS, 2048, F.G, (int)blockIdx.x);
        Epi<5> E{F.ws, F.x_p, F.x_s, F.out};
        pg8::gemm_phase<Epi<5>, pg8::StaticOrder, true, true>(F.lds + RING_OFF, g, S, E);
        if (BOTH(8)) GRID_BAR();
    }
    if (IN(9)) { RELANE(); for (int m = F.gw; m < M; m += F.NGW) merged_row(F, m); if (BOTH(9)) GRID_BAR(); }
    if (IN(10)) { RELANE();
        pg8::Gemm g{(const pg8::bf16_t*)(F.ws + WS_MERGED), (const pg8::bf16_t*)(F.ws + WS_WO), M, D, D, D, D, 0}; pg8::StaticOrder S; S.init(M, D, F.G, (int)blockIdx.x);
        Epi<6> E{F.ws, F.x_p, F.x_s, F.out};
        pg8::gemm_phase<Epi<6>, pg8::StaticOrder, true, true>(F.lds + RING_OFF, g, S, E);
        if (BOTH(10)) GRID_BAR();
    }
    if (IN(11)) { RELANE();
        for (int m = F.gw; m < M; m += F.NGW) { const float* mr = mod + (size_t)seq_of_row(m) * (6 * D);
            norm_mod_row(F, (const float*)(F.ws + WS_X1) + (size_t)m * D, F.g_mlp, mr + 4 * D, mr + 3 * D, (bf16*)(F.ws + WS_U) + (size_t)m * D); }
        if (BOTH(11)) GRID_BAR();
    }
    if (IN(12)) { RELANE();
        pg8::Gemm g{U, (const pg8::bf16_t*)(F.ws + WS_W1), M, FF, D, D, D, 0}; pg8::StaticOrder S; S.init(M, FF, F.G, (int)blockIdx.x);
        Epi<7> E{F.ws, F.x_p, F.x_s, F.out};
        pg8::gemm_phase<Epi<7>, pg8::StaticOrder, true, true>(F.lds + RING_OFF, g, S, E);
        if (BOTH(12)) GRID_BAR();
    }
    if (IN(13)) { RELANE();
        pg8::Gemm g{(const pg8::bf16_t*)(F.ws + WS_HDN), (const pg8::bf16_t*)(F.ws + WS_W2), M, D, FF, FF, FF, 0}; pg8::StaticOrder S; S.init(M, D, F.G, (int)blockIdx.x);
        Epi<8> E{F.ws, F.x_p, F.x_s, F.out};
        pg8::gemm_phase<Epi<8>, pg8::StaticOrder, true, true>(F.lds + RING_OFF, g, S, E);
        if (BOTH(13)) GRID_BAR();
    }
    if (IN(14)) { RELANE(); for (int m = F.gw; m < M; m += F.NGW) final_row(F, m); }
#undef IN
#undef BOTH
}

extern "C" void kernel_launch(void* const* d_in, const int* in_sizes, int n_in, void* d_out, int out_size, void* d_ws, size_t ws_size, hipStream_t stream) {
    static int grid = 0;
    if (grid == 0) {
        if (n_in != 22 || out_size != (int)O_END || ws_size < WS_END) { fprintf(stderr, "kernel_launch: unexpected shapes (n_in %d, out %d, ws %zu); nothing launched\n", n_in, out_size, ws_size); grid = -1; return; }
        int dev = 0, cus = 0, per_cu = 0;
        if (hipGetDevice(&dev) != hipSuccess || hipDeviceGetAttribute(&cus, hipDeviceAttributeMultiprocessorCount, dev) != hipSuccess) { grid = -1; return; }
        if (hipFuncSetAttribute((const void*)mk_fwd, hipFuncAttributeMaxDynamicSharedMemorySize, LDS_BYTES) != hipSuccess) { fprintf(stderr, "kernel_launch: hipFuncSetAttribute failed\n"); grid = -1; return; }
        if (hipOccupancyMaxActiveBlocksPerMultiprocessor(&per_cu, (const void*)mk_fwd, NWAVES * 64, LDS_BYTES) != hipSuccess || per_cu < 1) fprintf(stderr, "kernel_launch: note: occupancy query says %d\n", per_cu);
        (void)hipGetLastError();
        grid = cus;
    }
    if (grid < 0) return;
    if (hipMemsetAsync((char*)d_ws + WS_CTL, 0, CTL_ZERO_BYTES, stream) != hipSuccess) return;
    Args a{};
    for (int i = 0; i < 22; ++i) a.in[i] = d_in[i];
    a.out = (float*)d_out; a.ws = (unsigned char*)d_ws;
#if MK_PER_PHASE
    for (int p = 0; p < N_PHASES; ++p) { a.ph_lo = p; a.ph_hi = p + 1; hipLaunchKernelGGL(mk_fwd, dim3(grid), dim3(NWAVES * 64), LDS_BYTES, stream, a); }
#else
    a.ph_lo = 0; a.ph_hi = N_PHASES; hipLaunchKernelGGL(mk_fwd, dim3(grid), dim3(NWAVES * 64), LDS_BYTES, stream, a);
#endif
}
```

```cpp
#include <hip/hip_runtime.h>
#include <cstdio>
#include <cstdint>
namespace pg8 {
#define PG8_LAS __attribute__((address_space(3)))
typedef unsigned short bf16_t;
typedef short bf16x8 __attribute__((ext_vector_type(8)));
typedef float f32x4 __attribute__((ext_vector_type(4)));
typedef unsigned u32x4 __attribute__((ext_vector_type(4)));
typedef unsigned u32x2 __attribute__((ext_vector_type(2)));
constexpr int BM = 256, BK = 64, HALF = 128, HTB = HALF * BK * 2  , STAGE_BYTES = 8 * HTB, NXCD = 8, WGM = 8;

__host__ __device__ __forceinline__ int lds_byte(int r, int c) { const int st = (r >> 4) * 2 + (c >> 5), rr = r & 15, cc = c & 31, ob = rr * 64 + cc * 2; return st * 1024 + (ob ^ (((ob >> 9) & 1) << 5)); }
__host__ __device__ __forceinline__ void stage_rc(int b, int& R, int& C) { const int st = b / 1024, sb = b % 1024, swz = sb ^ (((sb >> 9) & 1) << 5); R = (st >> 1) * 16 + swz / 64; C = (st & 1) * 32 + (swz % 64) / 2; }
__host__ __device__ __forceinline__ int perm32(int rho) { const int n = rho >> 4, i = rho & 15; return 8 * (i >> 2) + 4 * n + (i & 3); }

struct Unit { int pm, pn; };
struct Gemm { const bf16_t* A; const bf16_t* Bt; int M, N, K, lda, ldb, aoffn; };

struct StaticOrder {
    int nM, nN, nwg, G, c;
    __host__ __device__ void init(int M, int N, int G_, int c_) { nM = M / BM; nN = N / BM; nwg = nM * nN; G = G_; c = c_; }
    __host__ __device__ bool next(int i, Unit& u) const {
        const long L = (long)i * G + c; if (L >= nwg) return false;
        int wgid = (int)L; { const int q = nwg / NXCD, r = nwg % NXCD, xcd = wgid % NXCD, off = wgid / NXCD; wgid = (xcd < r ? xcd * (q + 1) : r * (q + 1) + (xcd - r) * q) + off; }
        const int nig = WGM * nN, gid = wgid / nig, fm = gid * WGM, gsz = (nM - fm) < WGM ? (nM - fm) : WGM;
        u.pm = fm + ((wgid % nig) % gsz); u.pn = (wgid % nig) / gsz; return true;
    }
    __device__ __forceinline__ void a_ready(const Unit&) const {}
    __device__ __forceinline__ void done(const Unit&) const {}
};
__device__ __forceinline__ unsigned cvt_pk_bf16(float lo, float hi) { unsigned r; asm volatile("v_cvt_pk_bf16_f32 %0, %1, %2" : "=v"(r) : "v"(lo), "v"(hi)); return r; }
template <class Epi, class Sched, bool ALIGN_EPI = false, bool SP2 = false>
__device__ __forceinline__ void gemm_phase(PG8_LAS unsigned char* lds, const Gemm g, const Sched& S, const Epi& E) {
    const int tid = threadIdx.x, wid = __builtin_amdgcn_readfirstlane(tid >> 6), lane = tid & 63, wr = wid >> 2, wc = wid & 3, fr = lane & 15, fq = lane >> 4;
    const int K = g.K, nt = K / BK;
    unsigned voffA[2], voffB[2];
#pragma unroll
    for (int i = 0; i < 2; ++i) { int R, C; stage_rc(tid * 16 + i * 8192, R, C); const int Rb = Epi::PERM ? ((R & ~31) + perm32(R & 31)) : R;
        voffA[i] = (unsigned)(R * g.lda + C) * 2u; voffB[i] = (unsigned)(Rb * g.ldb + C) * 2u; }
    const size_t kstep = (size_t)(BK * 2);
    const size_t hsA = (size_t)HALF * g.lda * 2, hsB = (size_t)HALF * g.ldb * 2;
    const size_t tsA = 2 * hsA, tsB = 2 * hsB;
    const unsigned ldsw = (unsigned)wid * 1024u;
    const int aoff = lds_byte(wr * 64 + fr, fq * 8), boff = lds_byte(wc * 32 + fr, fq * 8);
#define PG8_SA(b, h) (((b) * 2 + (h)) * HTB)
#define PG8_SB(b, h) ((4 + (b) * 2 + (h)) * HTB)
#define PG8_STAGE(bufoff, gbase, voff) do { _Pragma("unroll") for (int _i = 0; _i < 2; ++_i) \
        __builtin_amdgcn_global_load_lds((const unsigned*)((const char*)(gbase) + (voff)[_i]), (PG8_LAS unsigned*)(lds + (bufoff) + ldsw + _i * 8192), 16, 0, 0); } while (0)
#define PG8_LDA(dst, b, h) do { _Pragma("unroll") for (int m = 0; m < 4; ++m) _Pragma("unroll") for (int k = 0; k < 2; ++k) dst[m][k] = *(const PG8_LAS bf16x8*)(lds + PG8_SA(b, h) + aoff + m * 2048 + k * 1024); } while (0)
#define PG8_LDB(dst, b, h) do { _Pragma("unroll") for (int n = 0; n < 2; ++n) _Pragma("unroll") for (int k = 0; k < 2; ++k) dst[n][k] = *(const PG8_LAS bf16x8*)(lds + PG8_SB(b, h) + boff + n * 2048 + k * 1024); } while (0)
#define PG8_MMA(ai, bj, At, Bt) do { __builtin_amdgcn_s_setprio(1); _Pragma("unroll") for (int m = 0; m < 4; ++m) _Pragma("unroll") for (int n = 0; n < 2; ++n) _Pragma("unroll") for (int k = 0; k < 2; ++k) \
        acc[ai][bj][m][n] = __builtin_amdgcn_mfma_f32_16x16x32_bf16(Bt[n][k], At[m][k], acc[ai][bj][m][n], 0, 0, 0); __builtin_amdgcn_s_setprio(0); } while (0)
#define PG8_WAIT_V(n) asm volatile("s_waitcnt vmcnt(" #n ")" ::: "memory")
#define PG8_WAIT_L(n) asm volatile("s_waitcnt lgkmcnt(" #n ")" ::: "memory")
#define PG8_BAR __builtin_amdgcn_s_barrier()
#define PG8_SCHED __builtin_amdgcn_sched_barrier(0)
    Unit cur, nxt; int ui = 0;
    if (!S.next(0, cur)) return;
    f32x4 acc[2][2][4][2];
#pragma unroll
    for (int a = 0; a < 2; ++a)
#pragma unroll
        for (int b = 0; b < 2; ++b)
#pragma unroll
            for (int m = 0; m < 4; ++m)
#pragma unroll
                for (int n = 0; n < 2; ++n) acc[a][b][m][n] = (f32x4){0.f, 0.f, 0.f, 0.f};
    bf16x8 At[4][2], B0[2][2], B1[2][2];
    const char* cA = (const char*)g.A + (size_t)cur.pm * tsA + (size_t)cur.pn * g.aoffn; const char* cB = (const char*)g.Bt + (size_t)cur.pn * tsB;
    S.a_ready(cur);
    if constexpr (SP2) {
        PG8_STAGE(PG8_SB(0, 0), cB, voffB); PG8_STAGE(PG8_SB(0, 1), cB + hsB, voffB); PG8_STAGE(PG8_SA(0, 0), cA, voffA); PG8_STAGE(PG8_SA(0, 1), cA + hsA, voffA);
        if (wr == 1) PG8_BAR;
        PG8_WAIT_V(2); PG8_BAR;
        PG8_STAGE(PG8_SB(1, 0), cB + kstep, voffB); PG8_STAGE(PG8_SA(1, 0), cA + kstep, voffA); PG8_STAGE(PG8_SB(1, 1), cB + hsB + kstep, voffB);
        PG8_WAIT_V(6); PG8_BAR;
    } else {
        PG8_STAGE(PG8_SB(0, 0), cB, voffB); PG8_STAGE(PG8_SA(0, 0), cA, voffA); PG8_STAGE(PG8_SB(0, 1), cB + hsB, voffB); PG8_STAGE(PG8_SA(0, 1), cA + hsA, voffA);
        if (wr == 1) PG8_BAR;
        PG8_WAIT_V(4); PG8_BAR;
        PG8_STAGE(PG8_SB(1, 0), cB + kstep, voffB); PG8_STAGE(PG8_SA(1, 0), cA + kstep, voffA); PG8_STAGE(PG8_SB(1, 1), cB + hsB + kstep, voffB);
        PG8_WAIT_V(6); PG8_BAR;
    }
    for (;;) {
        const bool has_next = S.next(ui + 1, nxt);
        const char* nA = has_next ? (const char*)g.A + (size_t)nxt.pm * tsA + (size_t)nxt.pn * g.aoffn : cA; const char* nB = has_next ? (const char*)g.Bt + (size_t)nxt.pn * tsB : cB;
#pragma nounroll
        for (int t = 0; t < nt; t += 2) {
            const bool last = (t == nt - 2);
            const char* a1 = cA + (size_t)(t + 1) * kstep;
            const char* a2 = last ? nA : cA + (size_t)(t + 2) * kstep; const char* b2 = last ? nB : cB + (size_t)(t + 2) * kstep;
            const char* a3 = a2 + kstep; const char* b3 = b2 + kstep;
            if (last && has_next) S.a_ready(nxt);
            if constexpr (SP2) {
            PG8_LDB(B0, 0, 0); PG8_LDB(B1, 0, 1); PG8_SCHED; PG8_LDA(At, 0, 0); PG8_STAGE(PG8_SA(1, 1), a1 + hsA, voffA);
            PG8_WAIT_V(8); PG8_WAIT_L(0); PG8_BAR; PG8_MMA(0, 0, At, B0); PG8_MMA(0, 1, At, B1); PG8_BAR; PG8_SCHED;
            PG8_LDA(At, 0, 1); PG8_STAGE(PG8_SB(0, 0), b2, voffB); PG8_STAGE(PG8_SB(0, 1), b2 + hsB, voffB); PG8_STAGE(PG8_SA(0, 0), a2, voffA);
            PG8_WAIT_V(8); PG8_WAIT_L(0); PG8_BAR; PG8_MMA(1, 0, At, B0); PG8_MMA(1, 1, At, B1); PG8_BAR; PG8_SCHED;
            PG8_LDB(B0, 1, 0); PG8_LDB(B1, 1, 1); PG8_SCHED; PG8_LDA(At, 1, 0); PG8_STAGE(PG8_SA(0, 1), a2 + hsA, voffA);
            PG8_WAIT_V(8); PG8_WAIT_L(0); PG8_BAR; PG8_MMA(0, 0, At, B0); PG8_MMA(0, 1, At, B1); PG8_BAR; PG8_SCHED;
            PG8_LDA(At, 1, 1); PG8_STAGE(PG8_SB(1, 0), b3, voffB); PG8_STAGE(PG8_SB(1, 1), b3 + hsB, voffB); PG8_STAGE(PG8_SA(1, 0), a3, voffA);
            PG8_WAIT_V(8); PG8_WAIT_L(0); PG8_BAR; PG8_MMA(1, 0, At, B0); PG8_MMA(1, 1, At, B1); PG8_BAR; PG8_SCHED;
            } else {
            PG8_LDB(B0, 0, 0); PG8_SCHED; PG8_LDA(At, 0, 0); PG8_STAGE(PG8_SA(1, 1), a1 + hsA, voffA);
            PG8_WAIT_L(8); PG8_BAR; PG8_WAIT_L(0); PG8_MMA(0, 0, At, B0); PG8_BAR; PG8_SCHED;
            PG8_LDB(B1, 0, 1); PG8_STAGE(PG8_SB(0, 0), b2, voffB);
            PG8_BAR; PG8_WAIT_L(0); PG8_MMA(0, 1, At, B1); PG8_BAR;
            PG8_LDA(At, 0, 1); PG8_STAGE(PG8_SA(0, 0), a2, voffA);
            PG8_BAR; PG8_WAIT_L(0); PG8_MMA(1, 0, At, B0); PG8_BAR; PG8_SCHED;
            PG8_STAGE(PG8_SB(0, 1), b2 + hsB, voffB);
            PG8_WAIT_V(6); PG8_BAR; PG8_MMA(1, 1, At, B1); PG8_BAR;
            PG8_LDB(B0, 1, 0); PG8_SCHED; PG8_LDA(At, 1, 0); PG8_STAGE(PG8_SA(0, 1), a2 + hsA, voffA);
            PG8_WAIT_L(8); PG8_BAR; PG8_WAIT_L(0); PG8_MMA(0, 0, At, B0); PG8_BAR; PG8_SCHED;
            PG8_LDB(B1, 1, 1); PG8_STAGE(PG8_SB(1, 0), b3, voffB);
            PG8_BAR; PG8_WAIT_L(0); PG8_MMA(0, 1, At, B1); PG8_BAR;
            PG8_LDA(At, 1, 1); PG8_STAGE(PG8_SA(1, 0), a3, voffA);
            PG8_BAR; PG8_WAIT_L(0); PG8_MMA(1, 0, At, B0); PG8_BAR; PG8_SCHED;
            PG8_STAGE(PG8_SB(1, 1), b3 + hsB, voffB);
            PG8_WAIT_V(6); PG8_BAR; PG8_MMA(1, 1, At, B1); PG8_BAR;
            }
        }
        if constexpr (ALIGN_EPI) { if (wr == 0) PG8_BAR; }
        if constexpr (!Epi::AFTER_DRAIN) { E(acc, cur, wr, wc, fr, fq); S.done(cur); }
        if (!has_next) break;
#pragma unroll
        for (int a = 0; a < 2; ++a)
#pragma unroll
            for (int b = 0; b < 2; ++b)
#pragma unroll
                for (int m = 0; m < 4; ++m)
#pragma unroll
                    for (int n = 0; n < 2; ++n) acc[a][b][m][n] = (f32x4){0.f, 0.f, 0.f, 0.f};
        cur = nxt; cA = nA; cB = nB; ++ui;
        if constexpr (ALIGN_EPI) { if (wr == 1) PG8_BAR; }
    }
    PG8_WAIT_V(0);
    if constexpr (!ALIGN_EPI) { if (wr == 0) PG8_BAR; }
    PG8_BAR;
    if constexpr (Epi::AFTER_DRAIN) { E.fused(acc, cur, wr, wc, fr, fq, lds, wid, lane); S.done(cur); }
#undef PG8_SA
#undef PG8_SB
#undef PG8_STAGE
#undef PG8_LDA
#undef PG8_LDB
#undef PG8_MMA
#undef PG8_WAIT_V
#undef PG8_WAIT_L
#undef PG8_BAR
#undef PG8_SCHED
}}

constexpr int NWAVES = 8;
#ifndef MK_PER_PHASE
#define MK_PER_PHASE 0
#endif
constexpr int N_PHASES = 15;

constexpr int D = 1024, NB = 4, SEQ = 4096, DB = 128, DSEQ = 8, PAST = 8192, PAGE = 128, NPAGES = 64;
constexpr int NH = 8, QLORA = 384, KVL = 256, NOPE = 128, ROPE = 64, VD = 128, FF = 4096;
constexpr int MP = NB * SEQ, MS = DB * DSEQ, M = MP + MS;
constexpr int NSEQ = NB + DB;
constexpr int DIN = 5824, NIN = 5888;
constexpr int NSM = 768, NBIG = 5120, NQ = 1536;
constexpr int NPOS = SEQ + DSEQ;
constexpr float EPS = 1e-6f;
constexpr float QSCALE = 0.07216878364870322f * 1.4426950408889634f;

constexpr size_t MiB = 1u << 20;
constexpr size_t WS_CTL = 0, CTL_ZERO_BYTES = 1 * MiB;
constexpr size_t WS_MOD = 1 * MiB, WS_TAB = 5 * MiB, WS_WIN = 8 * MiB, WS_WQB = 20 * MiB, WS_WKVB = 22 * MiB, WS_WUK = 23 * MiB, WS_WO = 24 * MiB, WS_W1 = 26 * MiB, WS_W2 = 34 * MiB;
constexpr size_t WS_U = 42 * MiB, WS_SM = 76 * MiB, WS_BIG = 128 * MiB, WS_QA = 298 * MiB, WS_CKVN = 311 * MiB, WS_QB = 320 * MiB, WS_KP = 371 * MiB, WS_VP = 419 * MiB;
constexpr size_t WS_QL = 451 * MiB, WS_KNEW = 456 * MiB, WS_OLAT = 457 * MiB, WS_ATT = 461 * MiB, WS_MERGED = 495 * MiB, WS_X1 = 529 * MiB, WS_HDN = 597 * MiB, WS_PART = 733 * MiB, WS_ML = 766 * MiB, WS_END = 800 * MiB;
static_assert(WS_MOD + (size_t)NSEQ * 6 * D * 4 <= WS_TAB && WS_TAB + (size_t)NPOS * 32 * 8 <= WS_WIN && WS_WIN + (size_t)NIN * D * 2 <= WS_WQB && WS_WQB + (size_t)NQ * QLORA * 2 <= WS_WKVB, "ws map 1");
static_assert(WS_WKVB + (size_t)2048 * 256 * 2 <= WS_WUK && WS_WUK + (size_t)2048 * 256 * 2 <= WS_WO && WS_WO + (size_t)D * D * 2 <= WS_W1 && WS_W1 + (size_t)FF * D * 2 <= WS_W2 && WS_W2 + (size_t)FF * D * 2 <= WS_U, "ws map 2");
static_assert(WS_U + (size_t)M * D * 2 <= WS_SM && WS_SM + (size_t)M * NSM * 4 <= WS_BIG && WS_BIG + (size_t)M * NBIG * 2 <= WS_QA && WS_QA + (size_t)M * QLORA * 2 <= WS_CKVN && WS_CKVN + (size_t)M * KVL * 2 <= WS_QB, "ws map 3");
static_assert(WS_QB + (size_t)M * NQ * 2 <= WS_KP && WS_KP + (size_t)MP * NH * 192 * 2 <= WS_VP && WS_VP + (size_t)MP * NH * 128 * 2 <= WS_QL && WS_QL + (size_t)MS * NH * 320 * 2 <= WS_KNEW && WS_KNEW + (size_t)MS * 320 * 2 <= WS_OLAT, "ws map 4");
static_assert(WS_OLAT + (size_t)MS * NH * 256 * 2 <= WS_ATT && WS_ATT + (size_t)M * D * 2 <= WS_MERGED && WS_MERGED + (size_t)M * D * 2 <= WS_X1 && WS_X1 + (size_t)M * D * 4 <= WS_HDN && WS_HDN + (size_t)M * FF * 2 <= WS_PART, "ws map 5");
constexpr size_t O_Y = 0, O_CKVP = (size_t)M * D, O_KRP = O_CKVP + (size_t)MP * KVL, O_CVP = O_KRP + (size_t)MP * ROPE, O_CKVS = O_CVP + (size_t)NB * 2 * D, O_KRS = O_CKVS + (size_t)MS * KVL, O_CVS = O_KRS + (size_t)MS * ROPE, O_END = O_CVS + (size_t)DB * 2 * D;
static_assert(O_END == 23666688, "d_out size");
constexpr int CW_TMO = 0, CW_CODE = 1, CW_BAR = 4096;
constexpr int RING_OFF = 0, RING_BYTES = 131072;
constexpr int LDSCTL_OFF = RING_BYTES, MISC_OFF = LDSCTL_OFF + 320;
constexpr int LDS_BYTES = 147456;
static_assert(MISC_OFF + 128 <= LDS_BYTES, "LDS map");

#define GAS __attribute__((address_space(1)))
#define LAS __attribute__((address_space(3)))
typedef unsigned short bf16;
typedef unsigned v4u __attribute__((ext_vector_type(4)));
typedef unsigned v2u __attribute__((ext_vector_type(2)));
typedef float f32x4 __attribute__((ext_vector_type(4)));
typedef float f32x2 __attribute__((ext_vector_type(2)));
typedef float f32x16 __attribute__((ext_vector_type(16)));
typedef short bf16x8 __attribute__((ext_vector_type(8)));
typedef GAS unsigned gu32;
#define RLX_AGENT __ATOMIC_RELAXED, __HIP_MEMORY_SCOPE_AGENT
#define LDS_WAIT() asm volatile("s_waitcnt lgkmcnt(0)" ::: "memory")
#define VM_WAIT() asm volatile("s_waitcnt vmcnt(0)" ::: "memory")
__device__ __forceinline__ unsigned f2bf(float f) { unsigned u = __builtin_bit_cast(unsigned, f); return (u + 0x7fffu + ((u >> 16) & 1u)) >> 16; }
__device__ __forceinline__ unsigned pk2(float lo, float hi) { return f2bf(lo) | (f2bf(hi) << 16); }
__device__ __forceinline__ float bf2f(unsigned short b) { return __builtin_bit_cast(float, (unsigned)b << 16); }
__device__ __forceinline__ float bflo(unsigned w) { return __builtin_bit_cast(float, w << 16); }
__device__ __forceinline__ float bfhi(unsigned w) { return __builtin_bit_cast(float, w & 0xffff0000u); }
#define XB_TMO      128
#define XB_XCNT(j)  (256  + 64 * (j))
#define XB_XSUB(j)  (1280 + 64 * (j))
#define XB_XGEN(j)  (2304 + 64 * (j))
#define XB_TOP      3328
#define XB_TOPGEN   3392
#define XCD_BAR_WORDS 3456
#define XB_SPIN_CAP (1u << 18)

__device__ __forceinline__ unsigned xb_ld(unsigned* p)              { return __hip_atomic_load(p, __ATOMIC_RELAXED, __HIP_MEMORY_SCOPE_AGENT); }
__device__ __forceinline__ unsigned xb_add(unsigned* p, unsigned v) { return __hip_atomic_fetch_add(p, v, __ATOMIC_RELAXED, __HIP_MEMORY_SCOPE_AGENT); }
__device__ __forceinline__ unsigned xb_xcc_id() { return (unsigned)__builtin_amdgcn_s_getreg((3 << 11) | 20) & 0xFu; }
#define XB_SPIN(cond, bar) do { unsigned _sp = 0; while (cond) { __builtin_amdgcn_s_sleep(1); \
    if ((++_sp & 255u) == 0u) { if (xb_ld(&(bar)[XB_TMO])) break; if (_sp > XB_SPIN_CAP) { atomicAdd(&(bar)[XB_TMO], 1u); break; } } } } while (0)

struct XcdBarrier {
    unsigned* bar; unsigned x;
    volatile LAS unsigned* st;
};

__device__ __forceinline__ XcdBarrier xcd_barrier_post(unsigned* bar, volatile LAS unsigned* st) {
    XcdBarrier b; b.bar = bar; b.x = xb_xcc_id(); b.st = st;
    if (threadIdx.x == 0) (void)xb_add(&bar[XB_XCNT(b.x)], 1u);
    return b;
}
__device__ __forceinline__ void xcd_barrier_complete(unsigned* bar, unsigned x, unsigned& nloc, unsigned& nx) {
    const unsigned G = gridDim.x * gridDim.y * gridDim.z;
    unsigned sum, cnt, mine, sp = 0u;
    for (;;) {
        sum = 0u; cnt = 0u; mine = 0u;
#pragma unroll
        for (unsigned j = 0; j < 16; ++j) { const unsigned c = xb_ld(&bar[XB_XCNT(j)]); sum += c; cnt += (c > 0u) ? 1u : 0u; mine = (j == x) ? c : mine; }
        if (sum == G) break;
        __builtin_amdgcn_s_sleep(1);
        if ((++sp & 255u) == 0u) { if (xb_ld(&bar[XB_TMO])) break; if (sp > XB_SPIN_CAP) { atomicAdd(&bar[XB_TMO], 1u); break; } }
    }
    nloc = mine > 0u ? mine : 1u; nx = cnt > 0u ? cnt : 1u;
}

__device__ __forceinline__ void xcd_barrier(const XcdBarrier& b) {
    asm volatile("s_waitcnt vmcnt(0)" ::: "memory");
    __syncthreads();
    if (threadIdx.x == 0) {
        unsigned* bar = b.bar;
        __builtin_amdgcn_s_waitcnt(0);
        unsigned nloc = b.st[0], nx = b.st[1];
        if (nloc == 0u) { xcd_barrier_complete(bar, b.x, nloc, nx); b.st[0] = nloc; b.st[1] = nx; }
        const unsigned old = xb_add(&bar[XB_XSUB(b.x)], 1u);
        const unsigned gen = old / nloc;
        if (old + 1u == (gen + 1u) * nloc) {
            __builtin_amdgcn_fence(__ATOMIC_RELEASE, "agent");
            asm volatile("s_waitcnt vmcnt(0)" ::: "memory");
            const unsigned og = xb_add(&bar[XB_TOP], 1u);
            const unsigned tg = og / nx;
            if (og + 1u == (tg + 1u) * nx) xb_add(&bar[XB_TOPGEN], 1u);
            else XB_SPIN(xb_ld(&bar[XB_TOPGEN]) == tg, bar);
            __builtin_amdgcn_fence(__ATOMIC_ACQUIRE, "agent");
            xb_add(&bar[XB_XGEN(b.x)], 1u);
            asm volatile("s_waitcnt vmcnt(0)" ::: "memory");
        } else {
            XB_SPIN(xb_ld(&bar[XB_XGEN(b.x)]) == gen, bar);
            __builtin_amdgcn_fence(__ATOMIC_ACQUIRE, "agent");
            asm volatile("s_waitcnt vmcnt(0)" ::: "memory");
        }
    }
    __syncthreads();
}
struct Frame {
    LAS unsigned char* lds; volatile LAS unsigned* MISC; gu32* ctl;
    int tid, lane, wave, G, gw, NGW;
    const float *x_p, *x_s, *cache_ckv, *cache_kr, *state_conv; const int* page_table;
    const float *c_p, *c_s, *w_ada, *b_ada, *g_attn, *w_in, *g_q, *w_q_b, *g_kv, *w_kv_b, *conv_w, *w_o, *g_mlp, *w_1, *w_2, *g_final;
    float* out; unsigned char* ws;
};
__device__ const double ROPE_INV[32] = {1.0, 0.7498942093324559, 0.5623413251903491, 0.4216965034285822, 0.31622776601683794, 0.23713737056616552, 0.1778279410038923, 0.1333521432163324,
    0.1, 0.07498942093324558, 0.05623413251903491, 0.042169650342858224, 0.03162277660168379, 0.023713737056616554, 0.01778279410038923, 0.01333521432163324,
    0.01, 0.007498942093324558, 0.005623413251903491, 0.004216965034285823, 0.0031622776601683794, 0.0023713737056616554, 0.0017782794100389228, 0.001333521432163324,
    0.001, 0.0007498942093324559, 0.0005623413251903491, 0.00042169650342858224, 0.00031622776601683794, 0.00023713737056616554, 0.00017782794100389227, 0.0001333521432163324};

__device__ __forceinline__ float wave_sum(float v) {
#pragma unroll
    for (int o = 1; o < 64; o <<= 1) v += __shfl_xor(v, o);
    return v;
}
__device__ __forceinline__ float wave_max(float v) {
#pragma unroll
    for (int o = 1; o < 64; o <<= 1) v = fmaxf(v, __shfl_xor(v, o));
    return v;
}
__device__ __forceinline__ float silu_f(float x) { return x / (1.f + __expf(-x)); }
__device__ __forceinline__ float sigmoid_f(float x) { return 1.f / (1.f + __expf(-x)); }
__device__ __forceinline__ int seq_of_row(int row) { return row < MP ? (row >> 12) : NB + ((row - MP) >> 3); }
__device__ __forceinline__ int pidx_of_row(int row) { return row < MP ? (row & (SEQ - 1)) : SEQ + ((row - MP) & (DSEQ - 1)); }
__device__ __forceinline__ void store8bf(bf16* p, f32x4 a, f32x4 b) {
    v4u w; w.x = pg8::cvt_pk_bf16(a[0], a[1]); w.y = pg8::cvt_pk_bf16(a[2], a[3]); w.z = pg8::cvt_pk_bf16(b[0], b[1]); w.w = pg8::cvt_pk_bf16(b[2], b[3]);
    *(v4u*)p = w;
}
__device__ __forceinline__ void store4bf(bf16* p, f32x4 a) { v2u w; w.x = pg8::cvt_pk_bf16(a[0], a[1]); w.y = pg8::cvt_pk_bf16(a[2], a[3]); *(v2u*)p = w; }

template <int MODE> struct Epi {
    static constexpr bool PERM = true, AFTER_DRAIN = false;
    unsigned char* ws; const float* x_p; const float* x_s; float* out;
    __device__ __forceinline__ void operator()(const pg8::f32x4 (&acc)[2][2][4][2], const pg8::Unit& u, int wr, int wc, int fr, int fq) const {
        const int rowb = u.pm * 256 + wr * 64 + fr, cw = wc * 32 + 8 * fq;
#pragma unroll
        for (int ai = 0; ai < 2; ++ai)
#pragma unroll
            for (int m = 0; m < 4; ++m) {
                const int row = rowb + ai * 128 + m * 16;
#pragma unroll
                for (int bj = 0; bj < 2; ++bj) {
                    const f32x4 v0 = acc[ai][bj][m][0], v1 = acc[ai][bj][m][1];
                    const int col = u.pn * 256 + bj * 128 + cw;
                    if constexpr (MODE == 1) {
                        if (u.pn < 3) { float* p = (float*)(ws + WS_SM) + (size_t)row * NSM + col; *(f32x4*)p = v0; *(f32x4*)(p + 4) = v1; }
                        else { store8bf((bf16*)(ws + WS_BIG) + (size_t)row * NBIG + (col - NSM), v0, v1); }
                    } else if constexpr (MODE == 2) {
                        bf16* qb = (bf16*)(ws + WS_QB) + (size_t)row * NQ;
                        if (u.pn < 4) { store8bf(qb + col, v0 * QSCALE, v1 * QSCALE); }
                        else {
                            const int r = col - 1024, h = r >> 6, q4 = ((r & 63) >> 3) * 4;
                            const float* tb = (const float*)(ws + WS_TAB) + ((size_t)pidx_of_row(row) * 32 + q4) * 2;
                            const f32x4 t01 = *(const f32x4*)tb, t23 = *(const f32x4*)(tb + 4);
                            f32x4 cs = {t01[0], t01[2], t23[0], t23[2]}, sn = {t01[1], t01[3], t23[1], t23[3]};
                            const f32x4 o1 = (v0 * cs - v1 * sn) * QSCALE, o2 = (v1 * cs + v0 * sn) * QSCALE;
                            store4bf(qb + 1024 + h * 64 + q4, o1); store4bf(qb + 1024 + h * 64 + 32 + q4, o2);
                            if (row >= MP) { bf16* ql = (bf16*)(ws + WS_QL) + ((size_t)(row - MP) * NH + h) * 320 + 256; store4bf(ql + q4, o1); store4bf(ql + 32 + q4, o2); }
                        }
                    } else if constexpr (MODE == 3) {
                        const size_t tok = (size_t)((row >> 12) * NH + u.pn) * SEQ + (row & (SEQ - 1));
                        if (bj == 0) store8bf((bf16*)(ws + WS_KP) + tok * 192 + cw, v0, v1);
                        else         store8bf((bf16*)(ws + WS_VP) + tok * 128 + cw, v0, v1);
                    } else if constexpr (MODE == 4) {
                        store8bf((bf16*)(ws + WS_QL) + ((size_t)row * NH + u.pn) * 320 + bj * 128 + cw, v0, v1);
                    } else if constexpr (MODE == 5) {
                        if (bj == 1) store8bf((bf16*)(ws + WS_ATT) + (size_t)(MP + row) * D + u.pn * 128 + cw, v0, v1);
                    } else if constexpr (MODE == 6 || MODE == 8) {
                        const float* g = (const float*)(ws + WS_MOD) + (size_t)seq_of_row(row) * (6 * D) + (MODE == 6 ? 2 : 5) * D + col;
                        const float* xr = (MODE == 6) ? ((row < MP ? x_p + (size_t)row * D : x_s + (size_t)(row - MP) * D) + col) : ((const float*)(ws + WS_X1) + (size_t)row * D + col);
                        float* o = (MODE == 6) ? ((float*)(ws + WS_X1) + (size_t)row * D + col) : (out + O_Y + (size_t)row * D + col);
                        const f32x4 g0 = *(const f32x4*)g, g1 = *(const f32x4*)(g + 4), x0 = *(const f32x4*)xr, x1 = *(const f32x4*)(xr + 4);
                        *(f32x4*)o = x0 + g0 * v0; *(f32x4*)(o + 4) = x1 + g1 * v1;
                    } else if constexpr (MODE == 7) {
                        f32x4 a = v0, b = v1;
#pragma unroll
                        for (int e = 0; e < 4; ++e) { a[e] = fmaxf(a[e], 0.f); a[e] *= a[e]; b[e] = fmaxf(b[e], 0.f); b[e] *= b[e]; }
                        store8bf((bf16*)(ws + WS_HDN) + (size_t)row * FF + col, a, b);
                    }
                }
                asm volatile("" ::: "memory");
            }
    }
};

template <int MAP> __device__ __forceinline__ int wt_row(int n) {
    if constexpr (MAP == 0) return n;
    else if constexpr (MAP == 1) return n < 704 ? n : n + 64;
    else { const int h = n / 192, j = n - h * 192;
        if (j < 128) return h * 128 + j;
        const int i = j - 128, x2 = i >> 5, idx = i & 31;
        return 1024 + h * 64 + 8 * (idx >> 2) + 4 * x2 + (idx & 3); }
}
template <int MAP> __device__ __forceinline__ void transpose_item(const float* W, int K, int N, bf16* WT, const float* kscale, LAS float* scr, int item, int lane) {
    const int nblk = N / 32, kb = item / nblk, nb = item % nblk, k0 = 64 * kb, n0 = 32 * nb;
#pragma unroll 8
    for (int i = 0; i < 32; ++i) { const int kk = 2 * i + (lane >> 5); scr[kk * 33 + (lane & 31)] = W[(size_t)(k0 + kk) * N + n0 + (lane & 31)]; }
    LDS_WAIT(); asm volatile("" ::: "memory");
    const int c = lane & 7;
    float ks[8];
#pragma unroll
    for (int e = 0; e < 8; ++e) ks[e] = kscale ? kscale[k0 + 8 * c + e] : 1.f;
#pragma unroll
    for (int j = 0; j < 4; ++j) { const int n = (lane >> 3) + 8 * j; const LAS float* s = scr + (8 * c) * 33 + n;
        v4u o; o.x = pk2(s[0 * 33] * ks[0], s[1 * 33] * ks[1]); o.y = pk2(s[2 * 33] * ks[2], s[3 * 33] * ks[3]); o.z = pk2(s[4 * 33] * ks[4], s[5 * 33] * ks[5]); o.w = pk2(s[6 * 33] * ks[6], s[7 * 33] * ks[7]);
        *(GAS v4u*)(WT + (size_t)wt_row<MAP>(n0 + n) * K + k0 + 8 * c) = o; }
    LDS_WAIT(); asm volatile("" ::: "memory");
}
__device__ __forceinline__ int crow32(int r, int hi) { return (r & 3) + 8 * (r >> 2) + 4 * hi; }
__device__ __forceinline__ bf16x8 pack8f(const float* a) {
    v4u w; w.x = pg8::cvt_pk_bf16(a[0], a[1]); w.y = pg8::cvt_pk_bf16(a[2], a[3]); w.z = pg8::cvt_pk_bf16(a[4], a[5]); w.w = pg8::cvt_pk_bf16(a[6], a[7]);
    return __builtin_bit_cast(bf16x8, w);
}
__device__ __forceinline__ void adaln_task(Frame& F, int et) {
    const int e0 = et * 32, r = F.lane & 31, h = F.lane >> 5, w = F.wave;
    f32x16 acc[5];
#pragma unroll
    for (int st = 0; st < 5; ++st)
#pragma unroll
        for (int i = 0; i < 16; ++i) acc[st][i] = 0.f;
    for (int ks = 0; ks < 8; ++ks) {
        const int k0 = w * 128 + ks * 16 + 8 * h;
        float a[8];
#pragma unroll
        for (int j = 0; j < 8; ++j) a[j] = F.w_ada[(size_t)(k0 + j) * (6 * D) + e0 + r];
        const bf16x8 af = pack8f(a);
#pragma unroll
        for (int st = 0; st < 5; ++st) {
            int s = 32 * st + r; s = s < NSEQ ? s : NSEQ - 1;
            const float* cp = (s < NB ? F.c_p + (size_t)s * D : F.c_s + (size_t)(s - NB) * D) + k0;
            const f32x4 c0 = *(const f32x4*)cp, c1 = *(const f32x4*)(cp + 4);
            float b[8] = {silu_f(c0[0]), silu_f(c0[1]), silu_f(c0[2]), silu_f(c0[3]), silu_f(c1[0]), silu_f(c1[1]), silu_f(c1[2]), silu_f(c1[3])};
            acc[st] = __builtin_amdgcn_mfma_f32_32x32x16_bf16(af, pack8f(b), acc[st], 0, 0, 0);
        }
    }
    LAS float* red = (LAS float*)F.lds;
    float* mod = (float*)(F.ws + WS_MOD);
#pragma unroll
    for (int st = 0; st < 5; ++st) {
#pragma unroll
        for (int i = 0; i < 16; ++i) red[(w * 16 + i) * 64 + F.lane] = acc[st][i];
        __syncthreads();
#pragma unroll
        for (int q = 0; q < 2; ++q) {
            const int idx = F.tid + 512 * q, reg = idx >> 6, lo = idx & 63;
            float sum = 0.f;
#pragma unroll
            for (int ww = 0; ww < 8; ++ww) sum += red[ww * 1024 + idx];
            const int s = 32 * st + (lo & 31), e = e0 + crow32(reg, lo >> 5);
            if (s < NSEQ) mod[(size_t)s * (6 * D) + e] = sum + F.b_ada[e];
        }
        __syncthreads();
    }
}
__device__ __forceinline__ void p0_prologue(Frame& F) {
    for (int et = blockIdx.x; et < (6 * D) / 32; et += F.G) adaln_task(F, et);
    __syncthreads();
    LAS float* scr = (LAS float*)(F.lds + RING_OFF + F.wave * 16384);
    constexpr int I_IN = (D / 64) * (DIN / 32), I_QB = (QLORA / 64) * (NQ / 32), I_KVB = (KVL / 64) * (2048 / 32), I_O = (D / 64) * (D / 32), I_1 = (D / 64) * (FF / 32), I_2 = (FF / 64) * (D / 32);
    constexpr int NITEMS = I_IN + I_QB + I_KVB + I_O + I_1 + I_2;
    for (int it = F.gw; it < NITEMS; it += F.NGW) {
        int r = it;
        if (r < I_IN) { transpose_item<1>(F.w_in, D, DIN, (bf16*)(F.ws + WS_WIN), nullptr, scr, r, F.lane); continue; } r -= I_IN;
        if (r < I_QB) { transpose_item<2>(F.w_q_b, QLORA, NQ, (bf16*)(F.ws + WS_WQB), F.g_q, scr, r, F.lane); continue; } r -= I_QB;
        if (r < I_KVB) { transpose_item<0>(F.w_kv_b, KVL, 2048, (bf16*)(F.ws + WS_WKVB), nullptr, scr, r, F.lane); continue; } r -= I_KVB;
        if (r < I_O) { transpose_item<0>(F.w_o, D, D, (bf16*)(F.ws + WS_WO), nullptr, scr, r, F.lane); continue; } r -= I_O;
        if (r < I_1) { transpose_item<0>(F.w_1, D, FF, (bf16*)(F.ws + WS_W1), nullptr, scr, r, F.lane); continue; } r -= I_1;
        transpose_item<0>(F.w_2, FF, D, (bf16*)(F.ws + WS_W2), nullptr, scr, r, F.lane);
    }
    const int gt = F.gw * 64 + F.lane, NGT = F.NGW * 64;
    for (int i = gt; i < 64 * D / 8; i += NGT) *(v4u*)((bf16*)(F.ws + WS_WIN) + (size_t)704 * D + (size_t)i * 8) = (v4u){0u, 0u, 0u, 0u};
    for (int i = gt; i < 2048 * 256 / 8; i += NGT) {
        const int row = i >> 5, k8 = (i & 31) * 8, hh = row >> 8, c = row & 255; v4u o = {0u, 0u, 0u, 0u};
        if (k8 < 128) { const float* s = F.w_kv_b + (size_t)c * 2048 + hh * 256 + k8; const f32x4 a = *(const f32x4*)s, b = *(const f32x4*)(s + 4);
            o.x = pk2(a[0], a[1]); o.y = pk2(a[2], a[3]); o.z = pk2(b[0], b[1]); o.w = pk2(b[2], b[3]); }
        *(v4u*)((bf16*)(F.ws + WS_WUK) + (size_t)row * 256 + k8) = o;
    }
    for (int i = gt; i < NPOS * 32; i += NGT) {
        const int p = i >> 5, fi = i & 31; const double pos = (double)(p < SEQ ? p : p + (PAST - SEQ));
        const double rev = pos * ROPE_INV[fi] * 0.15915494309189535; const float fr = (float)(rev - __builtin_rint(rev));
        f32x2 cs; cs.x = __builtin_amdgcn_cosf(fr); cs.y = __builtin_amdgcn_sinf(fr);
        *((f32x2*)(F.ws + WS_TAB) + i) = cs;
    }
}
__device__ __forceinline__ void norm_mod_row(Frame& F, const float* src, const float* g, const float* sc, const float* sh, bf16* dst) {
    f32x4 v[4]; float s = 0.f;
#pragma unroll
    for (int j = 0; j < 4; ++j) { v[j] = *((const f32x4*)src + F.lane + 64 * j); s += (v[j].x * v[j].x + v[j].y * v[j].y) + (v[j].z * v[j].z + v[j].w * v[j].w); }
    const float r = 1.f / sqrtf(wave_sum(s) * (1.f / D) + EPS);
#pragma unroll
    for (int j = 0; j < 4; ++j) { const int c4 = F.lane + 64 * j; const f32x4 gg = *((const f32x4*)g + c4), ss = *((const f32x4*)sc + c4), hh = *((const f32x4*)sh + c4);
        const f32x4 o = (v[j] * r) * gg * (ss + 1.f) + hh; store4bf(dst + c4 * 4, o); }
}
__device__ __forceinline__ void small_row(Frame& F, int m) {
    const float* sm = (const float*)(F.ws + WS_SM) + (size_t)m * NSM;
    const int l = F.lane; const bool samp = m >= MP; const int ms = m - MP;
    const f32x4 qa = *((const f32x4*)sm + l); const f32x2 qb = *((const f32x2*)(sm + 256) + l);
    float s = (qa.x * qa.x + qa.y * qa.y) + (qa.z * qa.z + qa.w * qa.w) + (qb.x * qb.x + qb.y * qb.y);
    const float rq = 1.f / sqrtf(wave_sum(s) * (1.f / QLORA) + EPS);
    bf16* qo = (bf16*)(F.ws + WS_QA) + (size_t)m * QLORA;
    store4bf(qo + 4 * l, qa * rq); *(unsigned*)(qo + 256 + 2 * l) = pg8::cvt_pk_bf16(qb.x * rq, qb.y * rq);
    const f32x4 kv = *((const f32x4*)(sm + 384) + l);
    s = (kv.x * kv.x + kv.y * kv.y) + (kv.z * kv.z + kv.w * kv.w);
    const float rk = 1.f / sqrtf(wave_sum(s) * (1.f / KVL) + EPS);
    const f32x4 kn = (kv * rk) * *((const f32x4*)F.g_kv + l);
    float* ock = samp ? F.out + O_CKVS + (size_t)ms * KVL : F.out + O_CKVP + (size_t)m * KVL;
    *((f32x4*)ock + l) = kn;
    store4bf((bf16*)(F.ws + WS_CKVN) + (size_t)m * KVL + 4 * l, kn);
    if (samp) store4bf((bf16*)(F.ws + WS_KNEW) + (size_t)ms * 320 + 4 * l, kn);
    if (l < 32) {
        const float x1 = sm[640 + l], x2 = sm[672 + l];
        const f32x2 cs = *((const f32x2*)(F.ws + WS_TAB) + (size_t)pidx_of_row(m) * 32 + l);
        const float o1 = x1 * cs.x - x2 * cs.y, o2 = x2 * cs.x + x1 * cs.y;
        float* okr = samp ? F.out + O_KRS + (size_t)ms * ROPE : F.out + O_KRP + (size_t)m * ROPE;
        okr[l] = o1; okr[32 + l] = o2;
        const bf16 b1 = (bf16)f2bf(o1), b2 = (bf16)f2bf(o2);
        if (samp) { bf16* kn2 = (bf16*)(F.ws + WS_KNEW) + (size_t)ms * 320 + 256; kn2[l] = b1; kn2[32 + l] = b2; }
        else { const int b = m >> 12, t = m & (SEQ - 1);
#pragma unroll
            for (int hh = 0; hh < NH; ++hh) { bf16* kp = (bf16*)(F.ws + WS_KP) + ((size_t)(b * NH + hh) * SEQ + t) * 192 + 128; kp[l] = b1; kp[32 + l] = b2; } }
    }
    const int t = samp ? (ms & (DSEQ - 1)) : (m & (SEQ - 1)), T = samp ? DSEQ : SEQ;
    if (t >= T - 2) {
        const bf16* big = (const bf16*)(F.ws + WS_BIG) + (size_t)m * NBIG;
        float* oc = (samp ? F.out + O_CVS + (size_t)(ms >> 3) * 2 * D : F.out + O_CVP + (size_t)(m >> 12) * 2 * D) + (size_t)(t - (T - 2)) * D;
#pragma unroll
        for (int j = 0; j < 2; ++j) { const int c8 = (l + 64 * j) * 8;
            const v4u cg = *(const v4u*)(big + 1024 + c8), xi = *(const v4u*)(big + 2048 + c8);
            f32x4 a = {bflo(cg.x) * bflo(xi.x), bfhi(cg.x) * bfhi(xi.x), bflo(cg.y) * bflo(xi.y), bfhi(cg.y) * bfhi(xi.y)};
            f32x4 b = {bflo(cg.z) * bflo(xi.z), bfhi(cg.z) * bfhi(xi.z), bflo(cg.w) * bflo(xi.w), bfhi(cg.w) * bfhi(xi.w)};
            *(f32x4*)(oc + c8) = a; *(f32x4*)(oc + c8 + 4) = b; }
    }
}
__device__ __forceinline__ void naive_attn_prompt_row(Frame& F, int rid) {
    const int h = rid & 7, m = rid >> 3, b = m >> 12, t = m & (SEQ - 1), l = F.lane;
    LAS float* qs = (LAS float*)(F.lds + F.wave * 8192); LAS float* sc = qs + 320;
    const bf16* qb = (const bf16*)(F.ws + WS_QB) + (size_t)m * NQ;
    qs[l] = bf2f(qb[h * 128 + l]); qs[64 + l] = bf2f(qb[h * 128 + 64 + l]); qs[128 + l] = bf2f(qb[1024 + h * 64 + l]);
    LDS_WAIT(); asm volatile("" ::: "memory");
    const bf16* K = (const bf16*)(F.ws + WS_KP) + (size_t)(b * NH + h) * SEQ * 192; const bf16* V = (const bf16*)(F.ws + WS_VP) + (size_t)(b * NH + h) * SEQ * 128;
    const int nk = t + 1; float mx = -1e30f, lsum = 0.f, o0 = 0.f, o1 = 0.f;
    for (int c0 = 0; c0 < nk; c0 += 1024) {
        const int cn = (nk - c0) < 1024 ? (nk - c0) : 1024; float cm = -1e30f;
        for (int i = l; i < cn; i += 64) { const bf16* kr = K + (size_t)(c0 + i) * 192; float s = 0.f;
#pragma unroll 4
            for (int d8 = 0; d8 < 24; ++d8) { const v4u kk = *(const v4u*)(kr + d8 * 8); const f32x4 qa = *(const LAS f32x4*)(qs + d8 * 8), qc = *(const LAS f32x4*)(qs + d8 * 8 + 4);
                s += bflo(kk.x) * qa.x + bfhi(kk.x) * qa.y + bflo(kk.y) * qa.z + bfhi(kk.y) * qa.w + bflo(kk.z) * qc.x + bfhi(kk.z) * qc.y + bflo(kk.w) * qc.z + bfhi(kk.w) * qc.w; }
            sc[i] = s; cm = fmaxf(cm, s); }
        cm = wave_max(cm); const float mn = fmaxf(mx, cm), alpha = exp2f(mx - mn); mx = mn; o0 *= alpha; o1 *= alpha; lsum *= alpha;
        float ps = 0.f;
        for (int i = l; i < cn; i += 64) { const float p = exp2f(sc[i] - mn); sc[i] = p; ps += p; }
        lsum += wave_sum(ps);
        LDS_WAIT(); asm volatile("" ::: "memory");
        for (int i = 0; i < cn; ++i) { const float p = sc[i]; const unsigned vv = *(const unsigned*)(V + (size_t)(c0 + i) * 128 + 2 * l); o0 += p * bflo(vv); o1 += p * bfhi(vv); }
        LDS_WAIT(); asm volatile("" ::: "memory");
    }
    const float inv = 1.f / lsum;
    *(unsigned*)((bf16*)(F.ws + WS_ATT) + (size_t)m * D + h * 128 + 2 * l) = pg8::cvt_pk_bf16(o0 * inv, o1 * inv);
}
__device__ __forceinline__ void naive_attn_decode_row(Frame& F, int rid) {
    const int h = rid & 7, sm = rid >> 3, sb = sm >> 3, t = sm & 7, l = F.lane;
    LAS float* qs = (LAS float*)(F.lds + F.wave * 8192); LAS float* sc = qs + 320;
    const bf16* ql = (const bf16*)(F.ws + WS_QL) + ((size_t)sm * NH + h) * 320;
#pragma unroll
    for (int j = 0; j < 5; ++j) qs[l + 64 * j] = bf2f(ql[l + 64 * j]);
    LDS_WAIT(); asm volatile("" ::: "memory");
    const int* pt = F.page_table + sb * NPAGES; const bf16* knew = (const bf16*)(F.ws + WS_KNEW) + (size_t)sb * DSEQ * 320;
    const int nk = PAST + t + 1; float mx = -1e30f, lsum = 0.f; f32x4 o = {0.f, 0.f, 0.f, 0.f};
    for (int c0 = 0; c0 < nk; c0 += 1024) {
        const int cn = (nk - c0) < 1024 ? (nk - c0) : 1024; float cm = -1e30f;
        for (int i = l; i < cn; i += 64) { const int j = c0 + i; float s = 0.f;
            if (j < PAST) { const size_t prow = (size_t)pt[j >> 7] * PAGE + (j & 127); const float* ck = F.cache_ckv + prow * KVL; const float* kr = F.cache_kr + prow * ROPE;
#pragma unroll 4
                for (int d4 = 0; d4 < 64; ++d4) { const f32x4 kk = *(const f32x4*)(ck + d4 * 4); const f32x4 qq = *(const LAS f32x4*)(qs + d4 * 4); s += kk.x * qq.x + kk.y * qq.y + kk.z * qq.z + kk.w * qq.w; }
#pragma unroll 4
                for (int d4 = 0; d4 < 16; ++d4) { const f32x4 kk = *(const f32x4*)(kr + d4 * 4); const f32x4 qq = *(const LAS f32x4*)(qs + 256 + d4 * 4); s += kk.x * qq.x + kk.y * qq.y + kk.z * qq.z + kk.w * qq.w; }
            } else { const bf16* kn = knew + (size_t)(j - PAST) * 320;
#pragma unroll 4
                for (int d8 = 0; d8 < 40; ++d8) { const v4u kk = *(const v4u*)(kn + d8 * 8); const f32x4 qa = *(const LAS f32x4*)(qs + d8 * 8), qc = *(const LAS f32x4*)(qs + d8 * 8 + 4);
                    s += bflo(kk.x) * qa.x + bfhi(kk.x) * qa.y + bflo(kk.y) * qa.z + bfhi(kk.y) * qa.w + bflo(kk.z) * qc.x + bfhi(kk.z) * qc.y + bflo(kk.w) * qc.z + bfhi(kk.w) * qc.w; }
            }
            sc[i] = s; cm = fmaxf(cm, s); }
        cm = wave_max(cm); const float mn = fmaxf(mx, cm), alpha = exp2f(mx - mn); mx = mn; o = o * alpha; lsum *= alpha;
        float ps = 0.f;
        for (int i = l; i < cn; i += 64) { const float p = exp2f(sc[i] - mn); sc[i] = p; ps += p; }
        lsum += wave_sum(ps);
        LDS_WAIT(); asm volatile("" ::: "memory");
        for (int i = 0; i < cn; ++i) { const int j = c0 + i; const float p = sc[i]; f32x4 vv;
            if (j < PAST) { const size_t prow = (size_t)pt[j >> 7] * PAGE + (j & 127); vv = *((const f32x4*)(F.cache_ckv + prow * KVL) + l); }
            else { const v2u w = *((const v2u*)(knew + (size_t)(j - PAST) * 320) + l); vv = (f32x4){bflo(w.x), bfhi(w.x), bflo(w.y), bfhi(w.y)}; }
            o = o + vv * p; }
        LDS_WAIT(); asm volatile("" ::: "memory");
    }
    const float inv = 1.f / lsum;
    store4bf((bf16*)(F.ws + WS_OLAT) + ((size_t)sm * NH + h) * 256 + 4 * l, o * inv);
}
__device__ __forceinline__ void merged_row(Frame& F, int m) {
    const bool samp = m >= MP; const int ms = m - MP, l = F.lane;
    const int t = samp ? (ms & (DSEQ - 1)) : (m & (SEQ - 1));
    const bf16* big = (const bf16*)(F.ws + WS_BIG) + (size_t)m * NBIG;
    const bf16* att = (const bf16*)(F.ws + WS_ATT) + (size_t)m * D; bf16* mo = (bf16*)(F.ws + WS_MERGED) + (size_t)m * D;
    const float* sc0 = F.state_conv + (size_t)(samp ? (ms >> 3) : 0) * 2 * D;
#pragma unroll
    for (int j = 0; j < 2; ++j) {
        const int c8 = (l + 64 * j) * 8;
        const v4u bg = *(const v4u*)(big + c8), cg = *(const v4u*)(big + 1024 + c8), xi = *(const v4u*)(big + 2048 + c8), ga = *(const v4u*)(big + 3072 + c8), gb = *(const v4u*)(big + 4096 + c8), at = *(const v4u*)(att + c8);
        v4u cg1 = {0u, 0u, 0u, 0u}, xi1 = cg1, cg2 = cg1, xi2 = cg1;
        if (t >= 1) { cg1 = *(const v4u*)(big - NBIG + 1024 + c8); xi1 = *(const v4u*)(big - NBIG + 2048 + c8); }
        if (t >= 2) { cg2 = *(const v4u*)(big - 2 * NBIG + 1024 + c8); xi2 = *(const v4u*)(big - 2 * NBIG + 2048 + c8); }
        float res[8];
#pragma unroll
        for (int e = 0; e < 8; ++e) {
            const unsigned wb = ((const unsigned*)&bg)[e >> 1], wc = ((const unsigned*)&cg)[e >> 1], wx = ((const unsigned*)&xi)[e >> 1], wa = ((const unsigned*)&ga)[e >> 1], wg = ((const unsigned*)&gb)[e >> 1], wt = ((const unsigned*)&at)[e >> 1];
            const unsigned wc1 = ((const unsigned*)&cg1)[e >> 1], wx1 = ((const unsigned*)&xi1)[e >> 1], wc2 = ((const unsigned*)&cg2)[e >> 1], wx2 = ((const unsigned*)&xi2)[e >> 1];
#define SEL(w) ((e & 1) ? bfhi(w) : bflo(w))
            const int col = c8 + e;
            const float v0 = SEL(wc) * SEL(wx);
            float v1 = SEL(wc1) * SEL(wx1), v2 = SEL(wc2) * SEL(wx2);
            if (samp) { if (t == 0) { v1 = sc0[D + col]; v2 = sc0[col]; } else if (t == 1) { v2 = sc0[D + col]; } }
            const float z = F.conv_w[col] * v2 + F.conv_w[D + col] * v1 + F.conv_w[2 * D + col] * v0;
            res[e] = sigmoid_f(SEL(wa)) * SEL(wt) + sigmoid_f(SEL(wg)) * (SEL(wb) * z);
#undef SEL
        }
        v4u o; o.x = pg8::cvt_pk_bf16(res[0], res[1]); o.y = pg8::cvt_pk_bf16(res[2], res[3]); o.z = pg8::cvt_pk_bf16(res[4], res[5]); o.w = pg8::cvt_pk_bf16(res[6], res[7]);
        *(v4u*)(mo + c8) = o;
    }
}
__device__ __forceinline__ void final_row(Frame& F, int m) {
    float* y = F.out + O_Y + (size_t)m * D; f32x4 v[4]; float s = 0.f;
#pragma unroll
    for (int j = 0; j < 4; ++j) { v[j] = *((const f32x4*)y + F.lane + 64 * j); s += (v[j].x * v[j].x + v[j].y * v[j].y) + (v[j].z * v[j].z + v[j].w * v[j].w); }
    const float r = 1.f / sqrtf(wave_sum(s) * (1.f / D) + EPS);
#pragma unroll
    for (int j = 0; j < 4; ++j) *((f32x4*)y + F.lane + 64 * j) = (v[j] * r) * *((const f32x4*)F.g_final + F.lane + 64 * j);
}
#define SBAR() __builtin_amdgcn_sched_barrier(0)
typedef short s16x4 __attribute__((ext_vector_type(4)));
typedef LAS s16x4* lds_s16x4p;
__device__ __forceinline__ unsigned cvtpk(float lo, float hi) { return pg8::cvt_pk_bf16(lo, hi); }
__device__ __forceinline__ bf16x8 ld_lds8(LAS unsigned char* p) { return *(const LAS bf16x8*)p; }
__device__ __forceinline__ s16x4 tr_rd(LAS unsigned char* p) { return __builtin_bit_cast(s16x4, __builtin_amdgcn_ds_read_tr16_b64_v4i16((LAS s16x4*)p)); }
__device__ __forceinline__ unsigned off_b(unsigned row, unsigned ch) { return 256u * row + 16u * (ch ^ (((row & 3) << 2) | ((row >> 2) & 3))); }
__device__ __forceinline__ unsigned off_r(unsigned row, unsigned ch) { return 128u * row + 16u * (ch ^ ((row >> 1) & 7)); }
__device__ __forceinline__ unsigned tr_addr(unsigned lane, unsigned rowbase, unsigned c, unsigned ks, unsigned t) {
    const unsigned h = lane >> 5, blk = (lane >> 4) & 1, q = (lane & 15) >> 2, p = lane & 3;
    return off_b(rowbase + 16 * ks + 8 * h + 4 * t + q, 4 * c + 2 * blk + (p >> 1)) + 8 * (p & 1);
}
constexpr float THR2 = 11.5f;
#define PK4(P, B_, OUT) do { unsigned a0 = cvtpk(P[B_+0], P[B_+1]), a1 = cvtpk(P[B_+2], P[B_+3]);                          \
        unsigned b0 = cvtpk(P[B_+4], P[B_+5]), b1 = cvtpk(P[B_+6], P[B_+7]);                                             \
        auto r0 = __builtin_amdgcn_permlane32_swap(a0, b0, false, false); auto r1 = __builtin_amdgcn_permlane32_swap(a1, b1, false, false); \
        v4u w = {r0[0], r1[0], r0[1], r1[1]}; OUT = __builtin_bit_cast(bf16x8, w); } while (0)
__device__ __forceinline__ float swap_max(float v) { auto rr = __builtin_amdgcn_permlane32_swap(__float_as_uint(v), __float_as_uint(v), false, false); return fmaxf(__uint_as_float(rr[0]), __uint_as_float(rr[1])); }
__device__ __forceinline__ float swap_sum(float v) { auto rr = __builtin_amdgcn_permlane32_swap(__float_as_uint(v), __float_as_uint(v), false, false); return __uint_as_float(rr[0]) + __uint_as_float(rr[1]); }
__device__ __forceinline__ void softmax64(f32x16& p0, f32x16& p1, float& m_reg, float& l_reg, float& alpha, bf16x8& pa0, bf16x8& pa1, bf16x8& pa2, bf16x8& pa3) {
    float pmax = p0[0];
#pragma unroll
    for (int r = 1; r < 16; ++r) pmax = fmaxf(pmax, p0[r]);
#pragma unroll
    for (int r = 0; r < 16; ++r) pmax = fmaxf(pmax, p1[r]);
    pmax = swap_max(pmax);
    float mn;
    if (__all(pmax - m_reg <= THR2)) { mn = m_reg; alpha = 1.f; } else { mn = fmaxf(m_reg, pmax); alpha = __builtin_amdgcn_exp2f(m_reg - mn); m_reg = mn; }
    float ps = 0.f;
#pragma unroll
    for (int r = 0; r < 16; ++r) { p0[r] = __builtin_amdgcn_exp2f(p0[r] - mn); ps += p0[r]; }
#pragma unroll
    for (int r = 0; r < 16; ++r) { p1[r] = __builtin_amdgcn_exp2f(p1[r] - mn); ps += p1[r]; }
    l_reg = l_reg * alpha + swap_sum(ps);
    PK4(p0, 0, pa0); PK4(p0, 8, pa1); PK4(p1, 0, pa2); PK4(p1, 8, pa3);
}
__device__ __forceinline__ void softmax32(f32x16& p0, float& m_reg, float& l_reg, float& alpha, bf16x8& pa0, bf16x8& pa1) {
    float pmax = p0[0];
#pragma unroll
    for (int r = 1; r < 16; ++r) pmax = fmaxf(pmax, p0[r]);
    pmax = swap_max(pmax);
    float mn;
    if (__all(pmax - m_reg <= THR2)) { mn = m_reg; alpha = 1.f; } else { mn = fmaxf(m_reg, pmax); alpha = __builtin_amdgcn_exp2f(m_reg - mn); m_reg = mn; }
    float ps = 0.f;
#pragma unroll
    for (int r = 0; r < 16; ++r) { p0[r] = __builtin_amdgcn_exp2f(p0[r] - mn); ps += p0[r]; }
    l_reg = l_reg * alpha + swap_sum(ps);
    PK4(p0, 0, pa0); PK4(p0, 8, pa1);
}
constexpr int PA_V = 0, PA_VB = 16384, PA_K = 2 * PA_VB, PA_KB = 24576, PA_SCR = PA_K + 2 * PA_KB;
__device__ __forceinline__ int pv_st(int k, int c) { const int kk = (k & ~0xC) | ((k & 4) << 1) | ((k & 8) >> 1); return ((kk >> 3) * 4 + (c >> 5)) * 512 + ((kk & 7) * 32 + (c & 31)) * 2; }
__device__ __forceinline__ int pv_rd_base(int lane) { return ((lane & 3) << 3) | (((lane >> 2) & 3) << 6) | (((lane >> 4) & 1) << 5) | (((lane >> 5) & 1) << 8); }
template <int VB> __device__ __forceinline__ void pa_pv_tile(f32x16* o, unsigned vb0, bf16x8 pa0, bf16x8 pa1, bf16x8 pa2, bf16x8 pa3) {
#define TRRD(dst, off) asm volatile("ds_read_b64_tr_b16 %0, %1 offset:%2" : "=&v"(dst) : "v"(vb0), "i"(off) : "memory")
#define PV_D0(d0) do { s16x4 l0, l1, l2, l3, h0, h1, h2, h3; constexpr int b_ = PA_V + VB * PA_VB + (d0) * 512;   \
        TRRD(l0, b_); TRRD(h0, b_ + 2048); TRRD(l1, b_ + 4096); TRRD(h1, b_ + 6144); TRRD(l2, b_ + 8192); TRRD(h2, b_ + 10240); TRRD(l3, b_ + 12288); TRRD(h3, b_ + 14336); \
        asm volatile("s_waitcnt lgkmcnt(0)" ::: "memory"); SBAR();   \
        o[d0] = __builtin_amdgcn_mfma_f32_32x32x16_bf16(pa0, (bf16x8){l0[0], l0[1], l0[2], l0[3], h0[0], h0[1], h0[2], h0[3]}, o[d0], 0, 0, 0);   \
        o[d0] = __builtin_amdgcn_mfma_f32_32x32x16_bf16(pa1, (bf16x8){l1[0], l1[1], l1[2], l1[3], h1[0], h1[1], h1[2], h1[3]}, o[d0], 0, 0, 0);   \
        o[d0] = __builtin_amdgcn_mfma_f32_32x32x16_bf16(pa2, (bf16x8){l2[0], l2[1], l2[2], l2[3], h2[0], h2[1], h2[2], h2[3]}, o[d0], 0, 0, 0);   \
        o[d0] = __builtin_amdgcn_mfma_f32_32x32x16_bf16(pa3, (bf16x8){l3[0], l3[1], l3[2], l3[3], h3[0], h3[1], h3[2], h3[3]}, o[d0], 0, 0, 0); } while (0)
    PV_D0(0); PV_D0(1); PV_D0(2); PV_D0(3);
#undef PV_D0
#undef TRRD
}
__device__ __forceinline__ void attn_prompt_block(Frame& F, int b, int h, int qb) {
    unsigned z_ = 0u; asm volatile("" : "+v"(z_)); const int lane = (int)__builtin_amdgcn_mbcnt_hi(~0u, __builtin_amdgcn_mbcnt_lo(~0u, z_));
    const int wid = F.wave, tid = wid * 64 + lane, r32 = lane & 31, hi = lane >> 5;
    LAS unsigned char* L = F.lds;
    const bf16* Kg = (const bf16*)(F.ws + WS_KP) + (size_t)(b * NH + h) * SEQ * 192;
    const bf16* Vg = (const bf16*)(F.ws + WS_VP) + (size_t)(b * NH + h) * SEQ * 128;
    const int row0 = b * SEQ + qb * 256 + wid * 32;
    const int qpos = qb * 256 + wid * 32 + r32;
    const int qlo = qb * 256 + wid * 32;
    const int NT = 4 * (qb + 1);
    bf16x8 qr[12];
    { const bf16* qp = (const bf16*)(F.ws + WS_QB) + (size_t)(row0 + r32) * NQ;
#pragma unroll
      for (int d0 = 0; d0 < 12; ++d0) qr[d0] = *(const bf16x8*)(qp + (d0 < 8 ? h * 128 + 16 * d0 + 8 * hi : 1024 + h * 64 + 16 * (d0 - 8) + 8 * hi)); }
    unsigned kso[3], vso[2];
#pragma unroll
    for (int i = 0; i < 3; ++i) { const unsigned p = (unsigned)(wid * 3 + i) * 64 + lane, row = p / 24, chp = p - row * 24, ch = chp ^ ((row >> 1) & 7); kso[i] = row * 192 + ch * 8; }
#pragma unroll
    for (int i = 0; i < 2; ++i) { const unsigned B_ = ((unsigned)(wid * 2 + i) * 64 + lane) * 16, st = B_ >> 9, wi = B_ & 511, kk = (st >> 2) * 8 + (wi >> 6), c = (st & 3) * 32 + ((wi & 63) >> 1);
        const unsigned k = (kk & ~0xCu) | ((kk & 4) << 1) | ((kk & 8) >> 1); vso[i] = k * 128 + c; }
#define PA_STAGE(t, bf) do { const bf16* kt = Kg + (size_t)(t) * 64 * 192; const bf16* vt = Vg + (size_t)(t) * 64 * 128;   \
        _Pragma("unroll") for (int i = 0; i < 3; ++i) __builtin_amdgcn_global_load_lds((const unsigned*)(kt + kso[i]), (LAS unsigned*)(L + PA_K + (bf) * PA_KB + (wid * 3 + i) * 1024), 16, 0, 0);   \
        _Pragma("unroll") for (int i = 0; i < 2; ++i) __builtin_amdgcn_global_load_lds((const unsigned*)(vt + vso[i]), (LAS unsigned*)(L + PA_V + (bf) * PA_VB + (wid * 2 + i) * 1024), 16, 0, 0); } while (0)
    LAS float* al_l = (LAS float*)(L + PA_SCR + wid * 256); LAS float* li_l = al_l + 32;
    const unsigned vb0 = (unsigned)pv_rd_base(lane);
    const int fx = (r32 >> 1) & 7;
    int kb4[4];
#pragma unroll
    for (int dd = 0; dd < 4; ++dd) kb4[dd] = r32 * 384 + (((2 * dd + hi) ^ fx) << 4);
    float m_reg = -1e30f, l_reg = 0.f; f32x16 o[4];
#pragma unroll
    for (int d = 0; d < 4; ++d)
#pragma unroll
        for (int r = 0; r < 16; ++r) o[d][r] = 0.f;
    PA_STAGE(0, 0); VM_WAIT();
    __syncthreads();
#define PA_STEP(t, KB) do {                                                                                                     \
        if ((t) + 1 < NT) PA_STAGE((t) + 1, (KB) ^ 1);                                                                          \
        f32x16 p0, p1;                                                                                                          \
        _Pragma("unroll") for (int r = 0; r < 16; ++r) { p0[r] = 0.f; p1[r] = 0.f; }                                            \
        _Pragma("unroll") for (int g_ = 0; g_ < 6; ++g_) { bf16x8 kf[4];                                                        \
            _Pragma("unroll") for (int dd = 0; dd < 2; ++dd) { const int d0 = 2 * g_ + dd; LAS unsigned char* a = L + PA_K + (KB) * PA_KB + kb4[d0 & 3] + (d0 >> 2) * 128; kf[2 * dd] = ld_lds8(a); kf[2 * dd + 1] = ld_lds8(a + 32 * 384); }   \
            SBAR();                                                                                                             \
            _Pragma("unroll") for (int dd = 0; dd < 2; ++dd) {                                                                  \
                p0 = __builtin_amdgcn_mfma_f32_32x32x16_bf16(kf[2 * dd], qr[2 * g_ + dd], p0, 0, 0, 0);                          \
                p1 = __builtin_amdgcn_mfma_f32_32x32x16_bf16(kf[2 * dd + 1], qr[2 * g_ + dd], p1, 0, 0, 0); }                    \
            SBAR(); }                                                                                                           \
        const int kb_ = (t) * 64;                                                                                               \
        if (kb_ + 63 > qlo) { const float NEG = -__builtin_inff();                                                              \
            _Pragma("unroll") for (int r = 0; r < 16; ++r) { const int key = kb_ + crow32(r, hi); if (key > qpos) p0[r] = NEG; if (key + 32 > qpos) p1[r] = NEG; } }   \
        float alpha; bf16x8 pa0, pa1, pa2, pa3;                                                                                 \
        softmax64(p0, p1, m_reg, l_reg, alpha, pa0, pa1, pa2, pa3);                                                             \
        if (__any(alpha < 1.f)) { if (hi == 0) al_l[r32] = alpha; LDS_WAIT();                                                    \
            _Pragma("unroll") for (int r = 0; r < 16; ++r) { const float a_ = al_l[crow32(r, hi)];                              \
                _Pragma("unroll") for (int d_ = 0; d_ < 4; ++d_) o[d_][r] *= a_; } }                                            \
        pa_pv_tile<KB>(o, vb0, pa0, pa1, pa2, pa3);                                                                             \
        VM_WAIT();                                                                                                              \
        __syncthreads(); } while (0)
    for (int t = 0; t < NT; t += 2) { PA_STEP(t, 0); PA_STEP(t + 1, 1); }
#undef PA_STEP
#undef PA_STAGE
    if (hi == 0) li_l[r32] = l_reg;
    LDS_WAIT();
    { unsigned eo = (unsigned)(4 * hi * D + r32);
      asm volatile("" : "+v"(eo));
      bf16* Ow = (bf16*)(F.ws + WS_ATT) + (size_t)row0 * D + h * 128;
#pragma unroll
      for (int r = 0; r < 16; ++r) { const int orow = crow32(r, hi); const float rl = __builtin_amdgcn_rcpf(li_l[orow]);
#pragma unroll
        for (int d0 = 0; d0 < 4; ++d0) { const float v = o[d0][r] * rl; const float vn = __shfl_xor(v, 1);
            if ((r32 & 1) == 0) *(unsigned*)(Ow + eo + ((r & 3) + 8 * (r >> 2)) * D + d0 * 32) = cvtpk(v, vn); } } }
    __syncthreads();
}
constexpr int DA_Q = 0, DA_IMG = 40960, DA_K = DA_IMG, DA_SCR = 3 * DA_IMG, DA_L1 = 16384, DA_R = 32768;
#define DA_BAR() do { asm volatile("s_waitcnt lgkmcnt(0)" ::: "memory"); __builtin_amdgcn_s_barrier(); asm volatile("" ::: "memory"); } while (0)
__device__ __forceinline__ void attn_decode_unit(Frame& F, int sb, int sp) {
    unsigned z_ = 0u; asm volatile("" : "+v"(z_)); const int lane = (int)__builtin_amdgcn_mbcnt_hi(~0u, __builtin_amdgcn_mbcnt_lo(~0u, z_));
    const int wid = F.wave, tid = wid * 64 + lane, r32 = lane & 31, hi = lane >> 5;
    LAS unsigned char* L = F.lds;
    const int* pt = F.page_table + sb * NPAGES + sp * 32;
    constexpr int NT = 64;
    { const bf16* ql = (const bf16*)(F.ws + WS_QL) + (size_t)sb * 64 * 320;
#pragma unroll
      for (int i = 0; i < 5; ++i) { const int id = tid + 512 * i, row = id / 40, ch = id - row * 40; const bf16x8 v = *(const bf16x8*)(ql + (size_t)row * 320 + ch * 8);
          const unsigned o_ = ch < 16 ? off_b(row, ch) : (ch < 32 ? DA_L1 + off_b(row, ch - 16) : DA_R + off_r(row, ch - 32));
          *(LAS bf16x8*)(L + DA_Q + o_) = v; } }
    __syncthreads();
    if (wid >= 4) {
        const unsigned lt = (unsigned)((wid - 4) * 64 + lane);
        const int ptv = pt[lane & 31];
        f32x4 cA[16], rA[4], cB[16], rB[4];
        const unsigned cvo = (lt >> 6) * 1024u + (lt & 63) * 16u, rvo = (lt >> 4) * 256u + (lt & 15) * 16u;
        unsigned wlo[4];
        { const unsigned c4 = lt & 63, row0 = lt >> 6, ch = (c4 & 31) >> 1;
#pragma unroll
          for (int v = 0; v < 4; ++v) wlo[v] = (c4 >> 5) * DA_L1 + 256u * row0 + 16u * (ch ^ (((row0 & 3) << 2) | (((row0 >> 2) + v) & 3))) + 8u * (c4 & 1); }
        const unsigned wro = DA_R + off_r(lt >> 4, (lt & 15) >> 1) + 8u * (lt & 1);
#define DA_LOAD(t, c_, r_) do { const size_t prow = (size_t)__builtin_amdgcn_readlane(ptv, (t) >> 1) * PAGE + ((t) & 1) * 64;     \
        const char* cb_ = (const char*)F.cache_ckv + prow * (KVL * 4); const char* rb_ = (const char*)F.cache_kr + prow * (ROPE * 4);   \
        _Pragma("unroll") for (int i = 0; i < 16; ++i) c_[i] = __builtin_nontemporal_load((const f32x4*)(cb_ + 4096 * i + cvo));     \
        _Pragma("unroll") for (int i = 0; i < 4; ++i) r_[i] = __builtin_nontemporal_load((const f32x4*)(rb_ + 4096 * i + rvo)); } while (0)
#define DA_WRITE(bf, c_, r_) do { LAS unsigned char* Kb = L + DA_K + (bf) * DA_IMG;                                             \
        _Pragma("unroll") for (int i = 0; i < 16; ++i) { v2u w; w.x = cvtpk(c_[i][0], c_[i][1]); w.y = cvtpk(c_[i][2], c_[i][3]); *(LAS v2u*)(Kb + wlo[i & 3] + 1024 * i) = w; }   \
        _Pragma("unroll") for (int i = 0; i < 4; ++i) { v2u w; w.x = cvtpk(r_[i][0], r_[i][1]); w.y = cvtpk(r_[i][2], r_[i][3]); *(LAS v2u*)(Kb + wro + 2048 * i) = w; } } while (0)
        DA_LOAD(0, cA, rA); DA_LOAD(1, cB, rB);
        for (int t = 0; t < NT; t += 2) {
            DA_WRITE(0, cA, rA);
            DA_LOAD(t + 2 < NT ? t + 2 : NT - 1, cA, rA);
            DA_BAR();
            DA_WRITE(1, cB, rB);
            DA_LOAD(t + 3 < NT ? t + 3 : NT - 1, cB, rB);
            DA_BAR();
        }
#undef DA_LOAD
#undef DA_WRITE
        if (sp == 1) {
            LAS unsigned char* Kb = L + DA_K; const bf16* kn = (const bf16*)(F.ws + WS_KNEW) + (size_t)sb * DSEQ * 320;
#pragma unroll
            for (int i = 0; i < 10; ++i) { const int id = lt + 256 * i, row = id / 40, ch = id - row * 40; bf16x8 v = {0, 0, 0, 0, 0, 0, 0, 0};
                if (row < DSEQ) v = *(const bf16x8*)(kn + (size_t)row * 320 + ch * 8);
                const unsigned o_ = ch < 16 ? off_b(row, ch) : (ch < 32 ? DA_L1 + off_b(row, ch - 16) : DA_R + off_r(row, ch - 32));
                *(LAS bf16x8*)(Kb + o_) = v; }
            DA_BAR();
        }
    } else {
        const int kh = wid & 1, qh = wid >> 1;
        LAS float* al_l = (LAS float*)(L + DA_SCR + wid * 256);
        const unsigned krow = 32 * kh + r32, qrow = 32 * qh + r32;
        float m_reg = -1e30f, l_reg = 0.f; f32x16 o[8];
#pragma unroll
        for (int d = 0; d < 8; ++d)
#pragma unroll
            for (int r = 0; r < 16; ++r) o[d][r] = 0.f;
#define DA_KADDR(s) ((s) < 16 ? ((s) >> 3) * DA_L1 + 256u * kr_ + 16u * ((2 * ((s) & 7) + hi) ^ xk) : DA_R + 128u * kr_ + 16u * ((2 * ((s) - 16) + hi) ^ fk))
#define DA_QADDR(s) ((s) < 16 ? ((s) >> 3) * DA_L1 + 256u * qr_ + 16u * ((2 * ((s) & 7) + hi) ^ xq) : DA_R + 128u * qr_ + 16u * ((2 * ((s) - 16) + hi) ^ fq))
#define DA_LDG(g, sl) do { kf[sl][0] = ld_lds8(Kb + DA_KADDR(2 * (g))); qf[sl][0] = ld_lds8(Qb + DA_QADDR(2 * (g))); kf[sl][1] = ld_lds8(Kb + DA_KADDR(2 * (g) + 1)); qf[sl][1] = ld_lds8(Qb + DA_QADDR(2 * (g) + 1)); } while (0)
#define DA_LDV(c, sl) do { LAS unsigned char* Vb_ = Kb + ((c) >> 2) * DA_L1;                                                     \
            va[sl][0] = tr_rd(Vb_ + tr_addr(ln_, 32 * kh, (c) & 3, 0, 0)); va[sl][1] = tr_rd(Vb_ + tr_addr(ln_, 32 * kh, (c) & 3, 0, 1));   \
            va[sl][2] = tr_rd(Vb_ + tr_addr(ln_, 32 * kh, (c) & 3, 1, 0)); va[sl][3] = tr_rd(Vb_ + tr_addr(ln_, 32 * kh, (c) & 3, 1, 1)); } while (0)
#define DA_COMPUTE(bf, MASKNEW) do { LAS unsigned char* Kb = L + DA_K + (bf) * DA_IMG; LAS unsigned char* Qb = L + DA_Q;         \
        unsigned kr_ = krow, qr_ = qrow, ln_ = lane; asm volatile("" : "+v"(kr_), "+v"(qr_), "+v"(ln_));     \
        const unsigned xk = ((kr_ & 3) << 2) | ((kr_ >> 2) & 3), xq = ((qr_ & 3) << 2) | ((qr_ >> 2) & 3), fk = (kr_ >> 1) & 7, fq = (qr_ >> 1) & 7;   \
        f32x16 p0;                                                                                                              \
        _Pragma("unroll") for (int r = 0; r < 16; ++r) p0[r] = 0.f;                                                             \
        { bf16x8 kf[2][2], qf[2][2];                           \
          DA_LDG(0, 0);                                                                                                         \
          _Pragma("unroll") for (int g_ = 0; g_ < 10; ++g_) {                                                                   \
            if (g_ + 1 < 10) DA_LDG(g_ + 1, (g_ + 1) & 1);                                                                      \
            SBAR();                                                                                                             \
            p0 = __builtin_amdgcn_mfma_f32_32x32x16_bf16(kf[g_ & 1][0], qf[g_ & 1][0], p0, 0, 0, 0);                             \
            p0 = __builtin_amdgcn_mfma_f32_32x32x16_bf16(kf[g_ & 1][1], qf[g_ & 1][1], p0, 0, 0, 0);                             \
            SBAR(); } }                                                                                                         \
        if (MASKNEW) { const float NEG = -__builtin_inff(); const int tq = (int)qrow >> 3;                                      \
            _Pragma("unroll") for (int r = 0; r < 16; ++r) { const int kk = crow32(r, hi); if (kk > tq) p0[r] = NEG; } }         \
        float alpha; bf16x8 pa0, pa1;                                                                                           \
        softmax32(p0, m_reg, l_reg, alpha, pa0, pa1);                                                                           \
        if (__any(alpha < 1.f)) { if (hi == 0) al_l[r32] = alpha; LDS_WAIT();                                                    \
            _Pragma("unroll") for (int r = 0; r < 16; ++r) { const float a_ = al_l[crow32(r, hi)];                              \
                _Pragma("unroll") for (int d_ = 0; d_ < 8; ++d_) o[d_][r] *= a_; } }                                            \
        { s16x4 va[2][4];                                                             \
          DA_LDV(0, 0);                                                                                                         \
          _Pragma("unroll") for (int c = 0; c < 8; ++c) {                                                                       \
            if (c + 1 < 8) DA_LDV(c + 1, (c + 1) & 1);                                                                          \
            SBAR();                                                                                                             \
            o[c] = __builtin_amdgcn_mfma_f32_32x32x16_bf16(pa0, (bf16x8){va[c & 1][0][0], va[c & 1][0][1], va[c & 1][0][2], va[c & 1][0][3], va[c & 1][1][0], va[c & 1][1][1], va[c & 1][1][2], va[c & 1][1][3]}, o[c], 0, 0, 0);   \
            o[c] = __builtin_amdgcn_mfma_f32_32x32x16_bf16(pa1, (bf16x8){va[c & 1][2][0], va[c & 1][2][1], va[c & 1][2][2], va[c & 1][2][3], va[c & 1][3][0], va[c & 1][3][1], va[c & 1][3][2], va[c & 1][3][3]}, o[c], 0, 0, 0);   \
            SBAR(); } } } while (0)
        for (int t = 0; t < NT; t += 2) {
            DA_BAR(); DA_COMPUTE(0, false);
            DA_BAR(); DA_COMPUTE(1, false);
        }
        if (sp == 1) { DA_BAR(); if (kh == 0) { DA_COMPUTE(0, true); } }
#undef DA_COMPUTE
#undef DA_LDG
#undef DA_LDV
#undef DA_KADDR
#undef DA_QADDR
        { unsigned l2 = (unsigned)lane; asm volatile("" : "+v"(l2));
          const unsigned e_r32 = l2 & 31, e_hi = l2 >> 5; const int pi = 2 * sp + kh;
          float* po = (float*)(F.ws + WS_PART) + ((size_t)(sb * 4 + pi) * 64 + 32 * qh) * 256;
          const unsigned eo = 4 * e_hi * 256 + e_r32;
#pragma unroll
          for (int r = 0; r < 16; ++r) {
#pragma unroll
            for (int c = 0; c < 8; ++c) po[eo + ((r & 3) + 8 * (r >> 2)) * 256 + 32 * c] = o[c][r]; }
          if (e_hi == 0) { float* ml = (float*)(F.ws + WS_ML) + ((size_t)(sb * 4 + pi) * 64 + 32 * qh + e_r32) * 2; ml[0] = m_reg; ml[1] = l_reg; } }
    }
    __syncthreads();
}
__device__ __forceinline__ void decode_combine_row(Frame& F, int row) {
    const int sb = row >> 6, q = row & 63, l = F.lane;
    const float* ml = (const float*)(F.ws + WS_ML); const float* po = (const float*)(F.ws + WS_PART);
    float mm[4], ll[4], M_ = -1e30f;
#pragma unroll
    for (int p = 0; p < 4; ++p) { const f32x2 v = *(const f32x2*)(ml + ((size_t)(sb * 4 + p) * 64 + q) * 2); mm[p] = v.x; ll[p] = v.y; M_ = fmaxf(M_, v.x); }
    float Lsum = 0.f; f32x4 acc = {0.f, 0.f, 0.f, 0.f};
#pragma unroll
    for (int p = 0; p < 4; ++p) { const float w = exp2f(mm[p] - M_); Lsum += w * ll[p]; acc = acc + *((const f32x4*)(po + ((size_t)(sb * 4 + p) * 64 + q) * 256) + l) * w; }
    store4bf((bf16*)(F.ws + WS_OLAT) + (size_t)row * 256 + 4 * l, acc * (1.f / Lsum));
}

struct Args { const void* in[22]; float* out; unsigned char* ws; int ph_lo, ph_hi; };
__global__ void __launch_bounds__(NWAVES * 64, 2) mk_fwd(Args args) {
    extern __shared__ __attribute__((aligned(16))) unsigned char lds[];
    Frame F;
    F.lds = (LAS unsigned char*)lds;
    F.MISC = (volatile LAS unsigned*)(F.lds + MISC_OFF);
    F.tid = threadIdx.x; F.lane = F.tid & 63; F.wave = __builtin_amdgcn_readfirstlane(F.tid >> 6);
    F.G = gridDim.x; F.gw = blockIdx.x * NWAVES + F.wave; F.NGW = F.G * NWAVES;
    F.ws = args.ws; F.out = args.out; F.ctl = (gu32*)(args.ws + WS_CTL);
    F.x_p = (const float*)args.in[0]; F.x_s = (const float*)args.in[1]; F.cache_ckv = (const float*)args.in[2]; F.cache_kr = (const float*)args.in[3]; F.state_conv = (const float*)args.in[4];
    F.page_table = (const int*)args.in[5]; F.c_p = (const float*)args.in[6]; F.c_s = (const float*)args.in[7]; F.w_ada = (const float*)args.in[8]; F.b_ada = (const float*)args.in[9];
    F.g_attn = (const float*)args.in[10]; F.w_in = (const float*)args.in[11]; F.g_q = (const float*)args.in[12]; F.w_q_b = (const float*)args.in[13]; F.g_kv = (const float*)args.in[14];
    F.w_kv_b = (const float*)args.in[15]; F.conv_w = (const float*)args.in[16]; F.w_o = (const float*)args.in[17]; F.g_mlp = (const float*)args.in[18]; F.w_1 = (const float*)args.in[19];
    F.w_2 = (const float*)args.in[20]; F.g_final = (const float*)args.in[21];
    for (int u = F.tid; u < (LDS_BYTES - LDSCTL_OFF) / 4; u += NWAVES * 64) ((LAS unsigned*)(F.lds + LDSCTL_OFF))[u] = 0u;
    __syncthreads();
    XcdBarrier bar; bar.bar = (unsigned*)(F.ctl + CW_BAR); bar.x = 0; bar.st = nullptr;
    if (!MK_PER_PHASE) bar = xcd_barrier_post((unsigned*)(F.ctl + CW_BAR), F.MISC + 8);
#define GRID_BAR() do { if (MK_PER_PHASE) { if (F.tid == 0) __hip_atomic_store(F.ctl + CW_TMO, 0xBADBA0u, RLX_AGENT); } else { xcd_barrier(bar); } } while (0)
    const int lo = args.ph_lo, hi = args.ph_hi;
#ifndef PH_MASK
#define PH_MASK 0xFFFFFFFFu
#endif
#define IN(k) (((PH_MASK >> (k)) & 1u) && lo <= (k) && (k) < hi)
#define BOTH(k) (IN(k) && IN((k) + 1))
#define RELANE() do { unsigned z_ = 0u; asm volatile("" : "+v"(z_)); int l_ = (int)__builtin_amdgcn_mbcnt_hi(~0u, __builtin_amdgcn_mbcnt_lo(~0u, z_)); F.lane = l_; F.tid = F.wave * 64 + l_; } while (0)
    const pg8::bf16_t* U = (const pg8::bf16_t*)(F.ws + WS_U);
    float* mod = (float*)(F.ws + WS_MOD);

    if (IN(0)) { RELANE(); p0_prologue(F); if (BOTH(0)) GRID_BAR(); }
    if (IN(1)) { RELANE();
        for (int m = F.gw; m < M; m += F.NGW) { const float* mr = mod + (size_t)seq_of_row(m) * (6 * D);
            norm_mod_row(F, m < MP ? F.x_p + (size_t)m * D : F.x_s + (size_t)(m - MP) * D, F.g_attn, mr + D, mr, (bf16*)(F.ws + WS_U) + (size_t)m * D); }
        if (BOTH(1)) GRID_BAR();
    }
    if (IN(2)) { RELANE();
        pg8::Gemm g{U, (const pg8::bf16_t*)(F.ws + WS_WIN), M, NIN, D, D, D, 0}; pg8::StaticOrder S; S.init(M, NIN, F.G, (int)blockIdx.x);
        Epi<1> E{F.ws, F.x_p, F.x_s, F.out};
        pg8::gemm_phase<Epi<1>, pg8::StaticOrder, true, true>(F.lds + RING_OFF, g, S, E);
        if (BOTH(2)) GRID_BAR();
    }
    if (IN(3)) { RELANE(); for (int m = F.gw; m < M; m += F.NGW) small_row(F, m); if (BOTH(3)) GRID_BAR(); }
    if (IN(4)) { RELANE();
        { pg8::Gemm g{(const pg8::bf16_t*)(F.ws + WS_QA), (const pg8::bf16_t*)(F.ws + WS_WQB), M, NQ, QLORA, QLORA, QLORA, 0}; pg8::StaticOrder S; S.init(M, NQ, F.G, (int)blockIdx.x);
          Epi<2> E{F.ws, F.x_p, F.x_s, F.out};
          pg8::gemm_phase<Epi<2>, pg8::StaticOrder, true, true>(F.lds + RING_OFF, g, S, E); }
        __syncthreads();
        { pg8::Gemm g{(const pg8::bf16_t*)(F.ws + WS_CKVN), (const pg8::bf16_t*)(F.ws + WS_WKVB), MP, 2048, KVL, KVL, KVL, 0}; pg8::StaticOrder S; S.init(MP, 2048, F.G, (int)blockIdx.x);
          Epi<3> E{F.ws, F.x_p, F.x_s, F.out};
          pg8::gemm_phase<Epi<3>, pg8::StaticOrder, true, true>(F.lds + RING_OFF, g, S, E); }
        if (BOTH(4)) GRID_BAR();
    }
    if (IN(5)) { RELANE();
        pg8::Gemm g{(const pg8::bf16_t*)(F.ws + WS_QB) + (size_t)MP * NQ, (const pg8::bf16_t*)(F.ws + WS_WUK), MS, 2048, 256, NQ, 256, 128 * 2}; pg8::StaticOrder S; S.init(MS, 2048, F.G, (int)blockIdx.x);
        Epi<4> E{F.ws, F.x_p, F.x_s, F.out};
        pg8::gemm_phase<Epi<4>, pg8::StaticOrder, true, true>(F.lds + RING_OFF, g, S, E);
        if (BOTH(5)) GRID_BAR();
    }
    if (IN(6)) { RELANE();
        const bool dec_first = ((blockIdx.x >> 3) & 1) != 0;
        if (dec_first) { for (int du = blockIdx.x; du < 2 * DB; du += F.G) attn_decode_unit(F, du >> 1, du & 1); }
        for (int it = blockIdx.x; it < NB * NH * 8; it += F.G) {
            const int xcd = it & 7, j = it >> 3, bh = (xcd * 4 + (j >> 3)) & 31, pr = j & 7, b = bh >> 3, h = bh & 7;
            for (int k = 0; k < 2; ++k) attn_prompt_block(F, b, h, k == 0 ? 15 - pr : pr);
        }
        if (!dec_first) { for (int du = blockIdx.x; du < 2 * DB; du += F.G) attn_decode_unit(F, du >> 1, du & 1); }
        if (BOTH(6)) GRID_BAR();
    }
    if (IN(7)) { RELANE(); for (int r = F.gw; r < MS * NH; r += F.NGW) decode_combine_row(F, r); if (BOTH(7)) GRID_BAR(); }
    if (IN(8)) { RELANE();
        pg8::Gemm g{(const pg8::bf16_t*)(F.ws + WS_OLAT), (const pg8::bf16_t*)(F.ws + WS_WKVB), MS, 2048, 256, 2048, 256, 256 * 2}; pg8::StaticOrder S; S.init(MS, 2048, F.G, (int)blockIdx.x);
        Epi<5> E{F.ws, F.x_p, F.x_s, F.out};
        pg8::gemm_phase<Epi<5>, pg8::StaticOrder, true, true>(F.lds + RING_OFF, g, S, E);
        if (BOTH(8)) GRID_BAR();
    }
    if (IN(9)) { RELANE(); for (int m = F.gw; m < M; m += F.NGW) merged_row(F, m); if (BOTH(9)) GRID_BAR(); }
    if (IN(10)) { RELANE();
        pg8::Gemm g{(const pg8::bf16_t*)(F.ws + WS_MERGED), (const pg8::bf16_t*)(F.ws + WS_WO), M, D, D, D, D, 0}; pg8::StaticOrder S; S.init(M, D, F.G, (int)blockIdx.x);
        Epi<6> E{F.ws, F.x_p, F.x_s, F.out};
        pg8::gemm_phase<Epi<6>, pg8::StaticOrder, true, true>(F.lds + RING_OFF, g, S, E);
        if (BOTH(10)) GRID_BAR();
    }
    if (IN(11)) { RELANE();
        for (int m = F.gw; m < M; m += F.NGW) { const float* mr = mod + (size_t)seq_of_row(m) * (6 * D);
            norm_mod_row(F, (const float*)(F.ws + WS_X1) + (size_t)m * D, F.g_mlp, mr + 4 * D, mr + 3 * D, (bf16*)(F.ws + WS_U) + (size_t)m * D); }
        if (BOTH(11)) GRID_BAR();
    }
    if (IN(12)) { RELANE();
        pg8::Gemm g{U, (const pg8::bf16_t*)(F.ws + WS_W1), M, FF, D, D, D, 0}; pg8::StaticOrder S; S.init(M, FF, F.G, (int)blockIdx.x);
        Epi<7> E{F.ws, F.x_p, F.x_s, F.out};
        pg8::gemm_phase<Epi<7>, pg8::StaticOrder, true, true>(F.lds + RING_OFF, g, S, E);
        if (BOTH(12)) GRID_BAR();
    }
    if (IN(13)) { RELANE();
        pg8::Gemm g{(const pg8::bf16_t*)(F.ws + WS_HDN), (const pg8::bf16_t*)(F.ws + WS_W2), M, D, FF, FF, FF, 0}; pg8::StaticOrder S; S.init(M, D, F.G, (int)blockIdx.x);
        Epi<8> E{F.ws, F.x_p, F.x_s, F.out};
        pg8::gemm_phase<Epi<8>, pg8::StaticOrder, true, true>(F.lds + RING_OFF, g, S, E);
        if (BOTH(13)) GRID_BAR();
    }
    if (IN(14)) { RELANE(); for (int m = F.gw; m < M; m += F.NGW) final_row(F, m); }
#undef IN
#undef BOTH
}

extern "C" void kernel_launch(void* const* d_in, const int* in_sizes, int n_in, void* d_out, int out_size, void* d_ws, size_t ws_size, hipStream_t stream) {
    static int grid = 0;
    if (grid == 0) {
        if (n_in != 22 || out_size != (int)O_END || ws_size < WS_END) { fprintf(stderr, "kernel_launch: unexpected shapes (n_in %d, out %d, ws %zu); nothing launched\n", n_in, out_size, ws_size); grid = -1; return; }
        int dev = 0, cus = 0, per_cu = 0;
        if (hipGetDevice(&dev) != hipSuccess || hipDeviceGetAttribute(&cus, hipDeviceAttributeMultiprocessorCount, dev) != hipSuccess) { grid = -1; return; }
        if (hipFuncSetAttribute((const void*)mk_fwd, hipFuncAttributeMaxDynamicSharedMemorySize, LDS_BYTES) != hipSuccess) { fprintf(stderr, "kernel_launch: hipFuncSetAttribute failed\n"); grid = -1; return; }
        if (hipOccupancyMaxActiveBlocksPerMultiprocessor(&per_cu, (const void*)mk_fwd, NWAVES * 64, LDS_BYTES) != hipSuccess || per_cu < 1) fprintf(stderr, "kernel_launch: note: occupancy query says %d\n", per_cu);
        (void)hipGetLastError();
        grid = cus;
    }
    if (grid < 0) return;
    if (hipMemsetAsync((char*)d_ws + WS_CTL, 0, CTL_ZERO_BYTES, stream) != hipSuccess) return;
    Args a{};
    for (int i = 0; i < 22; ++i) a.in[i] = d_in[i];
    a.out = (float*)d_out; a.ws = (unsigned char*)d_ws;
#if MK_PER_PHASE
    for (int p = 0; p < N_PHASES; ++p) { a.ph_lo = p; a.ph_hi = p + 1; hipLaunchKernelGGL(mk_fwd, dim3(grid), dim3(NWAVES * 64), LDS_BYTES, stream, a); }
#else
    a.ph_lo = 0; a.ph_hi = N_PHASES; hipLaunchKernelGGL(mk_fwd, dim3(grid), dim3(NWAVES * 64), LDS_BYTES, stream, a);
#endif
}
```

```cpp
#include <hip/hip_runtime.h>
#include <cstdio>
#include <cstdint>
namespace pg8 {
#define PG8_LAS __attribute__((address_space(3)))
typedef unsigned short bf16_t;
typedef short bf16x8 __attribute__((ext_vector_type(8)));
typedef float f32x4 __attribute__((ext_vector_type(4)));
typedef unsigned u32x4 __attribute__((ext_vector_type(4)));
typedef unsigned u32x2 __attribute__((ext_vector_type(2)));
constexpr int BM = 256, BK = 64, HALF = 128, HTB = HALF * BK * 2  , STAGE_BYTES = 8 * HTB, NXCD = 8, WGM = 8;

__host__ __device__ __forceinline__ int lds_byte(int r, int c) { const int st = (r >> 4) * 2 + (c >> 5), rr = r & 15, cc = c & 31, ob = rr * 64 + cc * 2; return st * 1024 + (ob ^ (((ob >> 9) & 1) << 5)); }
__host__ __device__ __forceinline__ void stage_rc(int b, int& R, int& C) { const int st = b / 1024, sb = b % 1024, swz = sb ^ (((sb >> 9) & 1) << 5); R = (st >> 1) * 16 + swz / 64; C = (st & 1) * 32 + (swz % 64) / 2; }
__host__ __device__ __forceinline__ int perm32(int rho) { const int n = rho >> 4, i = rho & 15; return 8 * (i >> 2) + 4 * n + (i & 3); }

struct Unit { int pm, pn; };
struct Gemm { const bf16_t* A; const bf16_t* Bt; int M, N, K, lda, ldb, aoffn, pn_shift, pn_mask, boffk; };

struct StaticOrder {
    int nM, nN, nwg, G, c;
    __host__ __device__ void init(int M, int N, int G_, int c_) { nM = M / BM; nN = N / BM; nwg = nM * nN; G = G_; c = c_; }
    __host__ __device__ bool next(int i, Unit& u) const {
        const long L = (long)i * G + c; if (L >= nwg) return false;
        int wgid = (int)L; { const int q = nwg / NXCD, r = nwg % NXCD, xcd = wgid % NXCD, off = wgid / NXCD; wgid = (xcd < r ? xcd * (q + 1) : r * (q + 1) + (xcd - r) * q) + off; }
        const int nig = WGM * nN, gid = wgid / nig, fm = gid * WGM, gsz = (nM - fm) < WGM ? (nM - fm) : WGM;
        u.pm = fm + ((wgid % nig) % gsz); u.pn = (wgid % nig) / gsz; return true;
    }
    __device__ __forceinline__ void a_ready(const Unit&) const {}
    __device__ __forceinline__ void done(const Unit&) const {}
};
__device__ __forceinline__ unsigned cvt_pk_bf16(float lo, float hi) { unsigned r; asm volatile("v_cvt_pk_bf16_f32 %0, %1, %2" : "=v"(r) : "v"(lo), "v"(hi)); return r; }
template <class Epi, class Sched, bool ALIGN_EPI = false, bool SP2 = false>
__device__ __forceinline__ void gemm_phase(PG8_LAS unsigned char* lds, const Gemm g, const Sched& S, const Epi& E) {
    const int tid = threadIdx.x, wid = __builtin_amdgcn_readfirstlane(tid >> 6), lane = tid & 63, wr = wid >> 2, wc = wid & 3, fr = lane & 15, fq = lane >> 4;
    const int K = g.K, nt = K / BK;
    unsigned voffA[2], voffB[2];
#pragma unroll
    for (int i = 0; i < 2; ++i) { int R, C; stage_rc(tid * 16 + i * 8192, R, C); const int Rb = Epi::PERM ? ((R & ~31) + perm32(R & 31)) : R;
        voffA[i] = (unsigned)(R * g.lda + C) * 2u; voffB[i] = (unsigned)(Rb * g.ldb + C) * 2u; }
    const size_t kstep = (size_t)(BK * 2);
    const size_t hsA = (size_t)HALF * g.lda * 2, hsB = (size_t)HALF * g.ldb * 2;
    const size_t tsA = 2 * hsA, tsB = 2 * hsB;
    const unsigned ldsw = (unsigned)wid * 1024u;
    const int aoff = lds_byte(wr * 64 + fr, fq * 8), boff = lds_byte(wc * 32 + fr, fq * 8);
#define PG8_SA(b, h) (((b) * 2 + (h)) * HTB)
#define PG8_SB(b, h) ((4 + (b) * 2 + (h)) * HTB)
#define PG8_STAGE(bufoff, gbase, voff) do { _Pragma("unroll") for (int _i = 0; _i < 2; ++_i) \
        __builtin_amdgcn_global_load_lds((const unsigned*)((const char*)(gbase) + (voff)[_i]), (PG8_LAS unsigned*)(lds + (bufoff) + ldsw + _i * 8192), 16, 0, 0); } while (0)
#define PG8_LDA(dst, b, h) do { _Pragma("unroll") for (int m = 0; m < 4; ++m) _Pragma("unroll") for (int k = 0; k < 2; ++k) dst[m][k] = *(const PG8_LAS bf16x8*)(lds + PG8_SA(b, h) + aoff + m * 2048 + k * 1024); } while (0)
#define PG8_LDB(dst, b, h) do { _Pragma("unroll") for (int n = 0; n < 2; ++n) _Pragma("unroll") for (int k = 0; k < 2; ++k) dst[n][k] = *(const PG8_LAS bf16x8*)(lds + PG8_SB(b, h) + boff + n * 2048 + k * 1024); } while (0)
#define PG8_MMA(ai, bj, At, Bt) do { __builtin_amdgcn_s_setprio(1); _Pragma("unroll") for (int m = 0; m < 4; ++m) _Pragma("unroll") for (int n = 0; n < 2; ++n) _Pragma("unroll") for (int k = 0; k < 2; ++k) \
        acc[ai][bj][m][n] = __builtin_amdgcn_mfma_f32_16x16x32_bf16(Bt[n][k], At[m][k], acc[ai][bj][m][n], 0, 0, 0); __builtin_amdgcn_s_setprio(0); } while (0)
#define PG8_WAIT_V(n) asm volatile("s_waitcnt vmcnt(" #n ")" ::: "memory")
#define PG8_WAIT_L(n) asm volatile("s_waitcnt lgkmcnt(" #n ")" ::: "memory")
#define PG8_BAR __builtin_amdgcn_s_barrier()
#define PG8_SCHED __builtin_amdgcn_sched_barrier(0)
    Unit cur, nxt; int ui = 0;
    if (!S.next(0, cur)) return;
    f32x4 acc[2][2][4][2];
#pragma unroll
    for (int a = 0; a < 2; ++a)
#pragma unroll
        for (int b = 0; b < 2; ++b)
#pragma unroll
            for (int m = 0; m < 4; ++m)
#pragma unroll
                for (int n = 0; n < 2; ++n) acc[a][b][m][n] = (f32x4){0.f, 0.f, 0.f, 0.f};
    bf16x8 At[4][2], B0[2][2], B1[2][2];
    const char* cA = (const char*)g.A + (size_t)cur.pm * tsA + (size_t)(cur.pn >> g.pn_shift) * g.aoffn; const char* cB = (const char*)g.Bt + (size_t)(cur.pn & g.pn_mask) * tsB + (size_t)(cur.pn >> g.pn_shift) * g.boffk;
    S.a_ready(cur);
    if constexpr (SP2) {
        PG8_STAGE(PG8_SB(0, 0), cB, voffB); PG8_STAGE(PG8_SB(0, 1), cB + hsB, voffB); PG8_STAGE(PG8_SA(0, 0), cA, voffA); PG8_STAGE(PG8_SA(0, 1), cA + hsA, voffA);
        if (wr == 1) PG8_BAR;
        PG8_WAIT_V(2); PG8_BAR;
        PG8_STAGE(PG8_SB(1, 0), cB + kstep, voffB); PG8_STAGE(PG8_SA(1, 0), cA + kstep, voffA); PG8_STAGE(PG8_SB(1, 1), cB + hsB + kstep, voffB);
        PG8_WAIT_V(6); PG8_BAR;
    } else {
        PG8_STAGE(PG8_SB(0, 0), cB, voffB); PG8_STAGE(PG8_SA(0, 0), cA, voffA); PG8_STAGE(PG8_SB(0, 1), cB + hsB, voffB); PG8_STAGE(PG8_SA(0, 1), cA + hsA, voffA);
        if (wr == 1) PG8_BAR;
        PG8_WAIT_V(4); PG8_BAR;
        PG8_STAGE(PG8_SB(1, 0), cB + kstep, voffB); PG8_STAGE(PG8_SA(1, 0), cA + kstep, voffA); PG8_STAGE(PG8_SB(1, 1), cB + hsB + kstep, voffB);
        PG8_WAIT_V(6); PG8_BAR;
    }
    for (;;) {
        const bool has_next = S.next(ui + 1, nxt);
        const char* nA = has_next ? (const char*)g.A + (size_t)nxt.pm * tsA + (size_t)(nxt.pn >> g.pn_shift) * g.aoffn : cA; const char* nB = has_next ? (const char*)g.Bt + (size_t)(nxt.pn & g.pn_mask) * tsB + (size_t)(nxt.pn >> g.pn_shift) * g.boffk : cB;
#pragma nounroll
        for (int t = 0; t < nt; t += 2) {
            const bool last = (t == nt - 2);
            const char* a1 = cA + (size_t)(t + 1) * kstep;
            const char* a2 = last ? nA : cA + (size_t)(t + 2) * kstep; const char* b2 = last ? nB : cB + (size_t)(t + 2) * kstep;
            const char* a3 = a2 + kstep; const char* b3 = b2 + kstep;
            if (last && has_next) S.a_ready(nxt);
            if constexpr (SP2) {
            PG8_LDB(B0, 0, 0); PG8_LDB(B1, 0, 1); PG8_SCHED; PG8_LDA(At, 0, 0); PG8_STAGE(PG8_SA(1, 1), a1 + hsA, voffA);
            PG8_WAIT_V(8); PG8_WAIT_L(0); PG8_BAR; PG8_MMA(0, 0, At, B0); PG8_MMA(0, 1, At, B1); PG8_BAR; PG8_SCHED;
            PG8_LDA(At, 0, 1); PG8_STAGE(PG8_SB(0, 0), b2, voffB); PG8_STAGE(PG8_SB(0, 1), b2 + hsB, voffB); PG8_STAGE(PG8_SA(0, 0), a2, voffA);
            PG8_WAIT_V(8); PG8_WAIT_L(0); PG8_BAR; PG8_MMA(1, 0, At, B0); PG8_MMA(1, 1, At, B1); PG8_BAR; PG8_SCHED;
            PG8_LDB(B0, 1, 0); PG8_LDB(B1, 1, 1); PG8_SCHED; PG8_LDA(At, 1, 0); PG8_STAGE(PG8_SA(0, 1), a2 + hsA, voffA);
            PG8_WAIT_V(8); PG8_WAIT_L(0); PG8_BAR; PG8_MMA(0, 0, At, B0); PG8_MMA(0, 1, At, B1); PG8_BAR; PG8_SCHED;
            PG8_LDA(At, 1, 1); PG8_STAGE(PG8_SB(1, 0), b3, voffB); PG8_STAGE(PG8_SB(1, 1), b3 + hsB, voffB); PG8_STAGE(PG8_SA(1, 0), a3, voffA);
            PG8_WAIT_V(8); PG8_WAIT_L(0); PG8_BAR; PG8_MMA(1, 0, At, B0); PG8_MMA(1, 1, At, B1); PG8_BAR; PG8_SCHED;
            } else {
            PG8_LDB(B0, 0, 0); PG8_SCHED; PG8_LDA(At, 0, 0); PG8_STAGE(PG8_SA(1, 1), a1 + hsA, voffA);
            PG8_WAIT_L(8); PG8_BAR; PG8_WAIT_L(0); PG8_MMA(0, 0, At, B0); PG8_BAR; PG8_SCHED;
            PG8_LDB(B1, 0, 1); PG8_STAGE(PG8_SB(0, 0), b2, voffB);
            PG8_BAR; PG8_WAIT_L(0); PG8_MMA(0, 1, At, B1); PG8_BAR;
            PG8_LDA(At, 0, 1); PG8_STAGE(PG8_SA(0, 0), a2, voffA);
            PG8_BAR; PG8_WAIT_L(0); PG8_MMA(1, 0, At, B0); PG8_BAR; PG8_SCHED;
            PG8_STAGE(PG8_SB(0, 1), b2 + hsB, voffB);
            PG8_WAIT_V(6); PG8_BAR; PG8_MMA(1, 1, At, B1); PG8_BAR;
            PG8_LDB(B0, 1, 0); PG8_SCHED; PG8_LDA(At, 1, 0); PG8_STAGE(PG8_SA(0, 1), a2 + hsA, voffA);
            PG8_WAIT_L(8); PG8_BAR; PG8_WAIT_L(0); PG8_MMA(0, 0, At, B0); PG8_BAR; PG8_SCHED;
            PG8_LDB(B1, 1, 1); PG8_STAGE(PG8_SB(1, 0), b3, voffB);
            PG8_BAR; PG8_WAIT_L(0); PG8_MMA(0, 1, At, B1); PG8_BAR;
            PG8_LDA(At, 1, 1); PG8_STAGE(PG8_SA(1, 0), a3, voffA);
            PG8_BAR; PG8_WAIT_L(0); PG8_MMA(1, 0, At, B0); PG8_BAR; PG8_SCHED;
            PG8_STAGE(PG8_SB(1, 1), b3 + hsB, voffB);
            PG8_WAIT_V(6); PG8_BAR; PG8_MMA(1, 1, At, B1); PG8_BAR;
            }
        }
        if constexpr (ALIGN_EPI) { if (wr == 0) PG8_BAR; }
        if constexpr (!Epi::AFTER_DRAIN) { E(acc, cur, wr, wc, fr, fq); S.done(cur); }
        if (!has_next) break;
#pragma unroll
        for (int a = 0; a < 2; ++a)
#pragma unroll
            for (int b = 0; b < 2; ++b)
#pragma unroll
                for (int m = 0; m < 4; ++m)
#pragma unroll
                    for (int n = 0; n < 2; ++n) acc[a][b][m][n] = (f32x4){0.f, 0.f, 0.f, 0.f};
        cur = nxt; cA = nA; cB = nB; ++ui;
        if constexpr (ALIGN_EPI) { if (wr == 1) PG8_BAR; }
    }
    PG8_WAIT_V(0);
    if constexpr (!ALIGN_EPI) { if (wr == 0) PG8_BAR; }
    PG8_BAR;
    if constexpr (Epi::AFTER_DRAIN) { E.fused(acc, cur, wr, wc, fr, fq, lds, wid, lane); S.done(cur); }
#undef PG8_SA
#undef PG8_SB
#undef PG8_STAGE
#undef PG8_LDA
#undef PG8_LDB
#undef PG8_MMA
#undef PG8_WAIT_V
#undef PG8_WAIT_L
#undef PG8_BAR
#undef PG8_SCHED
}}

constexpr int NWAVES = 8;
#ifndef MK_PER_PHASE
#define MK_PER_PHASE 0
#endif
constexpr int N_PHASES = 15;

constexpr int D = 1024, NB = 4, SEQ = 4096, DB = 128, DSEQ = 8, PAST = 8192, PAGE = 128, NPAGES = 64;
constexpr int NH = 8, QLORA = 384, KVL = 256, NOPE = 128, ROPE = 64, VD = 128, FF = 4096;
constexpr int MP = NB * SEQ, MS = DB * DSEQ, M = MP + MS;
constexpr int NSEQ = NB + DB;
constexpr int DIN = 5824, NIN = 5888;
constexpr int NSM = 768, NBIG = 5120, NQ = 1536;
constexpr int NPOS = SEQ + DSEQ;
constexpr float EPS = 1e-6f;
constexpr float QSCALE = 0.07216878364870322f * 1.4426950408889634f;

constexpr size_t MiB = 1u << 20;
constexpr size_t WS_CTL = 0, CTL_ZERO_BYTES = 1 * MiB;
constexpr size_t WS_MOD = 1 * MiB, WS_TAB = 5 * MiB, WS_WIN = 8 * MiB, WS_WQB = 20 * MiB, WS_WKVB = 22 * MiB, WS_WUK = 23 * MiB, WS_WO = 24 * MiB, WS_W1 = 26 * MiB, WS_W2 = 34 * MiB;
constexpr size_t WS_U = 42 * MiB, WS_SM = 76 * MiB, WS_BIG = 128 * MiB, WS_QA = 298 * MiB, WS_CKVN = 311 * MiB, WS_QB = 320 * MiB, WS_KP = 371 * MiB, WS_VP = 419 * MiB;
constexpr size_t WS_QL = 451 * MiB, WS_KNEW = 456 * MiB, WS_OLAT = 457 * MiB, WS_ATT = 461 * MiB, WS_MERGED = 495 * MiB, WS_X1 = 529 * MiB, WS_HDN = 597 * MiB, WS_PART = 733 * MiB, WS_ML = 766 * MiB, WS_P1 = 768 * MiB, WS_P2 = 784 * MiB, WS_END = 816 * MiB;
static_assert(WS_MOD + (size_t)NSEQ * 6 * D * 4 <= WS_TAB && WS_TAB + (size_t)NPOS * 32 * 8 <= WS_WIN && WS_WIN + (size_t)NIN * D * 2 <= WS_WQB && WS_WQB + (size_t)NQ * QLORA * 2 <= WS_WKVB, "ws map 1");
static_assert(WS_WKVB + (size_t)2048 * 256 * 2 <= WS_WUK && WS_WUK + (size_t)2048 * 256 * 2 <= WS_WO && WS_WO + (size_t)D * D * 2 <= WS_W1 && WS_W1 + (size_t)FF * D * 2 <= WS_W2 && WS_W2 + (size_t)FF * D * 2 <= WS_U, "ws map 2");
static_assert(WS_U + (size_t)M * D * 2 <= WS_SM && WS_SM + (size_t)M * NSM * 4 <= WS_BIG && WS_BIG + (size_t)M * NBIG * 2 <= WS_QA && WS_QA + (size_t)M * QLORA * 2 <= WS_CKVN && WS_CKVN + (size_t)M * KVL * 2 <= WS_QB, "ws map 3");
static_assert(WS_QB + (size_t)M * NQ * 2 <= WS_KP && WS_KP + (size_t)MP * NH * 192 * 2 <= WS_VP && WS_VP + (size_t)MP * NH * 128 * 2 <= WS_QL && WS_QL + (size_t)MS * NH * 320 * 2 <= WS_KNEW && WS_KNEW + (size_t)MS * 320 * 2 <= WS_OLAT, "ws map 4");
static_assert(WS_OLAT + (size_t)MS * NH * 256 * 2 <= WS_ATT && WS_ATT + (size_t)M * D * 2 <= WS_MERGED && WS_MERGED + (size_t)M * D * 2 <= WS_X1 && WS_X1 + (size_t)M * D * 4 <= WS_HDN && WS_HDN + (size_t)M * FF * 2 <= WS_PART, "ws map 5");
constexpr size_t O_Y = 0, O_CKVP = (size_t)M * D, O_KRP = O_CKVP + (size_t)MP * KVL, O_CVP = O_KRP + (size_t)MP * ROPE, O_CKVS = O_CVP + (size_t)NB * 2 * D, O_KRS = O_CKVS + (size_t)MS * KVL, O_CVS = O_KRS + (size_t)MS * ROPE, O_END = O_CVS + (size_t)DB * 2 * D;
static_assert(O_END == 23666688, "d_out size");
constexpr int CW_TMO = 0, CW_CODE = 1, CW_BAR = 4096;
constexpr int RING_OFF = 0, RING_BYTES = 131072;
constexpr int LDSCTL_OFF = RING_BYTES, MISC_OFF = LDSCTL_OFF + 320;
constexpr int LDS_BYTES = 147456;
static_assert(MISC_OFF + 128 <= LDS_BYTES, "LDS map");

#define GAS __attribute__((address_space(1)))
#define LAS __attribute__((address_space(3)))
typedef unsigned short bf16;
typedef unsigned v4u __attribute__((ext_vector_type(4)));
typedef unsigned v2u __attribute__((ext_vector_type(2)));
typedef float f32x4 __attribute__((ext_vector_type(4)));
typedef float f32x2 __attribute__((ext_vector_type(2)));
typedef float f32x16 __attribute__((ext_vector_type(16)));
typedef short bf16x8 __attribute__((ext_vector_type(8)));
typedef GAS unsigned gu32;
#define RLX_AGENT __ATOMIC_RELAXED, __HIP_MEMORY_SCOPE_AGENT
#define LDS_WAIT() asm volatile("s_waitcnt lgkmcnt(0)" ::: "memory")
#define VM_WAIT() asm volatile("s_waitcnt vmcnt(0)" ::: "memory")
__device__ __forceinline__ unsigned f2bf(float f) { unsigned u = __builtin_bit_cast(unsigned, f); return (u + 0x7fffu + ((u >> 16) & 1u)) >> 16; }
__device__ __forceinline__ unsigned pk2(float lo, float hi) { return f2bf(lo) | (f2bf(hi) << 16); }
__device__ __forceinline__ float bf2f(unsigned short b) { return __builtin_bit_cast(float, (unsigned)b << 16); }
__device__ __forceinline__ float bflo(unsigned w) { return __builtin_bit_cast(float, w << 16); }
__device__ __forceinline__ float bfhi(unsigned w) { return __builtin_bit_cast(float, w & 0xffff0000u); }
#define XB_TMO      128
#define XB_XCNT(j)  (256  + 64 * (j))
#define XB_XSUB(j)  (1280 + 64 * (j))
#define XB_XGEN(j)  (2304 + 64 * (j))
#define XB_TOP      3328
#define XB_TOPGEN   3392
#define XCD_BAR_WORDS 3456
#define XB_SPIN_CAP (1u << 18)

__device__ __forceinline__ unsigned xb_ld(unsigned* p)              { return __hip_atomic_load(p, __ATOMIC_RELAXED, __HIP_MEMORY_SCOPE_AGENT); }
__device__ __forceinline__ unsigned xb_add(unsigned* p, unsigned v) { return __hip_atomic_fetch_add(p, v, __ATOMIC_RELAXED, __HIP_MEMORY_SCOPE_AGENT); }
__device__ __forceinline__ unsigned xb_xcc_id() { return (unsigned)__builtin_amdgcn_s_getreg((3 << 11) | 20) & 0xFu; }
#define XB_SPIN(cond, bar) do { unsigned _sp = 0; while (cond) { __builtin_amdgcn_s_sleep(1); \
    if ((++_sp & 255u) == 0u) { if (xb_ld(&(bar)[XB_TMO])) break; if (_sp > XB_SPIN_CAP) { atomicAdd(&(bar)[XB_TMO], 1u); break; } } } } while (0)

struct XcdBarrier {
    unsigned* bar; unsigned x;
    volatile LAS unsigned* st;
};

__device__ __forceinline__ XcdBarrier xcd_barrier_post(unsigned* bar, volatile LAS unsigned* st) {
    XcdBarrier b; b.bar = bar; b.x = xb_xcc_id(); b.st = st;
    if (threadIdx.x == 0) (void)xb_add(&bar[XB_XCNT(b.x)], 1u);
    return b;
}
__device__ __forceinline__ void xcd_barrier_complete(unsigned* bar, unsigned x, unsigned& nloc, unsigned& nx) {
    const unsigned G = gridDim.x * gridDim.y * gridDim.z;
    unsigned sum, cnt, mine, sp = 0u;
    for (;;) {
        sum = 0u; cnt = 0u; mine = 0u;
#pragma unroll
        for (unsigned j = 0; j < 16; ++j) { const unsigned c = xb_ld(&bar[XB_XCNT(j)]); sum += c; cnt += (c > 0u) ? 1u : 0u; mine = (j == x) ? c : mine; }
        if (sum == G) break;
        __builtin_amdgcn_s_sleep(1);
        if ((++sp & 255u) == 0u) { if (xb_ld(&bar[XB_TMO])) break; if (sp > XB_SPIN_CAP) { atomicAdd(&bar[XB_TMO], 1u); break; } }
    }
    nloc = mine > 0u ? mine : 1u; nx = cnt > 0u ? cnt : 1u;
}

__device__ __forceinline__ void xcd_barrier(const XcdBarrier& b) {
    asm volatile("s_waitcnt vmcnt(0)" ::: "memory");
    __syncthreads();
    if (threadIdx.x == 0) {
        unsigned* bar = b.bar;
        __builtin_amdgcn_s_waitcnt(0);
        unsigned nloc = b.st[0], nx = b.st[1];
        if (nloc == 0u) { xcd_barrier_complete(bar, b.x, nloc, nx); b.st[0] = nloc; b.st[1] = nx; }
        const unsigned old = xb_add(&bar[XB_XSUB(b.x)], 1u);
        const unsigned gen = old / nloc;
        if (old + 1u == (gen + 1u) * nloc) {
            __builtin_amdgcn_fence(__ATOMIC_RELEASE, "agent");
            asm volatile("s_waitcnt vmcnt(0)" ::: "memory");
            const unsigned og = xb_add(&bar[XB_TOP], 1u);
            const unsigned tg = og / nx;
            if (og + 1u == (tg + 1u) * nx) xb_add(&bar[XB_TOPGEN], 1u);
            else XB_SPIN(xb_ld(&bar[XB_TOPGEN]) == tg, bar);
            __builtin_amdgcn_fence(__ATOMIC_ACQUIRE, "agent");
            xb_add(&bar[XB_XGEN(b.x)], 1u);
            asm volatile("s_waitcnt vmcnt(0)" ::: "memory");
        } else {
            XB_SPIN(xb_ld(&bar[XB_XGEN(b.x)]) == gen, bar);
            __builtin_amdgcn_fence(__ATOMIC_ACQUIRE, "agent");
            asm volatile("s_waitcnt vmcnt(0)" ::: "memory");
        }
    }
    __syncthreads();
}
struct Frame {
    LAS unsigned char* lds; volatile LAS unsigned* MISC; gu32* ctl;
    int tid, lane, wave, G, gw, NGW;
    const float *x_p, *x_s, *cache_ckv, *cache_kr, *state_conv; const int* page_table;
    const float *c_p, *c_s, *w_ada, *b_ada, *g_attn, *w_in, *g_q, *w_q_b, *g_kv, *w_kv_b, *conv_w, *w_o, *g_mlp, *w_1, *w_2, *g_final;
    float* out; unsigned char* ws;
};
__device__ const double ROPE_INV[32] = {1.0, 0.7498942093324559, 0.5623413251903491, 0.4216965034285822, 0.31622776601683794, 0.23713737056616552, 0.1778279410038923, 0.1333521432163324,
    0.1, 0.07498942093324558, 0.05623413251903491, 0.042169650342858224, 0.03162277660168379, 0.023713737056616554, 0.01778279410038923, 0.01333521432163324,
    0.01, 0.007498942093324558, 0.005623413251903491, 0.004216965034285823, 0.0031622776601683794, 0.0023713737056616554, 0.0017782794100389228, 0.001333521432163324,
    0.001, 0.0007498942093324559, 0.0005623413251903491, 0.00042169650342858224, 0.00031622776601683794, 0.00023713737056616554, 0.00017782794100389227, 0.0001333521432163324};

__device__ __forceinline__ float wave_sum(float v) {
#pragma unroll
    for (int o = 1; o < 64; o <<= 1) v += __shfl_xor(v, o);
    return v;
}
__device__ __forceinline__ float wave_max(float v) {
#pragma unroll
    for (int o = 1; o < 64; o <<= 1) v = fmaxf(v, __shfl_xor(v, o));
    return v;
}
__device__ __forceinline__ float silu_f(float x) { return x / (1.f + __expf(-x)); }
__device__ __forceinline__ float sigmoid_f(float x) { return 1.f / (1.f + __expf(-x)); }
__device__ __forceinline__ int seq_of_row(int row) { return row < MP ? (row >> 12) : NB + ((row - MP) >> 3); }
__device__ __forceinline__ int pidx_of_row(int row) { return row < MP ? (row & (SEQ - 1)) : SEQ + ((row - MP) & (DSEQ - 1)); }
__device__ __forceinline__ void store8bf(bf16* p, f32x4 a, f32x4 b) {
    v4u w; w.x = pg8::cvt_pk_bf16(a[0], a[1]); w.y = pg8::cvt_pk_bf16(a[2], a[3]); w.z = pg8::cvt_pk_bf16(b[0], b[1]); w.w = pg8::cvt_pk_bf16(b[2], b[3]);
    *(v4u*)p = w;
}
__device__ __forceinline__ void store4bf(bf16* p, f32x4 a) { v2u w; w.x = pg8::cvt_pk_bf16(a[0], a[1]); w.y = pg8::cvt_pk_bf16(a[2], a[3]); *(v2u*)p = w; }

template <int MODE> struct Epi {
    static constexpr bool PERM = true, AFTER_DRAIN = false;
    unsigned char* ws; const float* x_p; const float* x_s; float* out;
    __device__ __forceinline__ void operator()(const pg8::f32x4 (&acc)[2][2][4][2], const pg8::Unit& u, int wr, int wc, int fr, int fq) const {
        const int rowb = u.pm * 256 + wr * 64 + fr, cw = wc * 32 + 8 * fq;
#pragma unroll
        for (int ai = 0; ai < 2; ++ai)
#pragma unroll
            for (int m = 0; m < 4; ++m) {
                const int row = rowb + ai * 128 + m * 16;
#pragma unroll
                for (int bj = 0; bj < 2; ++bj) {
                    const f32x4 v0 = acc[ai][bj][m][0], v1 = acc[ai][bj][m][1];
                    const int col = u.pn * 256 + bj * 128 + cw;
                    if constexpr (MODE == 1) {
                        if (u.pn < 3) { float* p = (float*)(ws + WS_SM) + (size_t)row * NSM + col; *(f32x4*)p = v0; *(f32x4*)(p + 4) = v1; }
                        else { store8bf((bf16*)(ws + WS_BIG) + (size_t)row * NBIG + (col - NSM), v0, v1); }
                    } else if constexpr (MODE == 2) {
                        bf16* qb = (bf16*)(ws + WS_QB) + (size_t)row * NQ;
                        if (u.pn < 4) { store8bf(qb + col, v0 * QSCALE, v1 * QSCALE); }
                        else {
                            const int r = col - 1024, h = r >> 6, q4 = ((r & 63) >> 3) * 4;
                            const float* tb = (const float*)(ws + WS_TAB) + ((size_t)pidx_of_row(row) * 32 + q4) * 2;
                            const f32x4 t01 = *(const f32x4*)tb, t23 = *(const f32x4*)(tb + 4);
                            f32x4 cs = {t01[0], t01[2], t23[0], t23[2]}, sn = {t01[1], t01[3], t23[1], t23[3]};
                            const f32x4 o1 = (v0 * cs - v1 * sn) * QSCALE, o2 = (v1 * cs + v0 * sn) * QSCALE;
                            store4bf(qb + 1024 + h * 64 + q4, o1); store4bf(qb + 1024 + h * 64 + 32 + q4, o2);
                            if (row >= MP) { bf16* ql = (bf16*)(ws + WS_QL) + ((size_t)(row - MP) * NH + h) * 320 + 256; store4bf(ql + q4, o1); store4bf(ql + 32 + q4, o2); }
                        }
                    } else if constexpr (MODE == 3) {
                        const size_t tok = (size_t)((row >> 12) * NH + u.pn) * SEQ + (row & (SEQ - 1));
                        if (bj == 0) store8bf((bf16*)(ws + WS_KP) + tok * 192 + cw, v0, v1);
                        else         store8bf((bf16*)(ws + WS_VP) + tok * 128 + cw, v0, v1);
                    } else if constexpr (MODE == 4) {
                        store8bf((bf16*)(ws + WS_QL) + ((size_t)row * NH + u.pn) * 320 + bj * 128 + cw, v0, v1);
                    } else if constexpr (MODE == 5) {
                        if (bj == 1) store8bf((bf16*)(ws + WS_ATT) + (size_t)(MP + row) * D + u.pn * 128 + cw, v0, v1);
                    } else if constexpr (MODE == 6 || MODE == 8) {
                        const float* g = (const float*)(ws + WS_MOD) + (size_t)seq_of_row(row) * (6 * D) + (MODE == 6 ? 2 : 5) * D + col;
                        const float* xr = (MODE == 6) ? ((row < MP ? x_p + (size_t)row * D : x_s + (size_t)(row - MP) * D) + col) : ((const float*)(ws + WS_X1) + (size_t)row * D + col);
                        float* o = (MODE == 6) ? ((float*)(ws + WS_X1) + (size_t)row * D + col) : (out + O_Y + (size_t)row * D + col);
                        const f32x4 g0 = *(const f32x4*)g, g1 = *(const f32x4*)(g + 4), x0 = *(const f32x4*)xr, x1 = *(const f32x4*)(xr + 4);
                        *(f32x4*)o = x0 + g0 * v0; *(f32x4*)(o + 4) = x1 + g1 * v1;
                    } else if constexpr (MODE == 9 || MODE == 10) {
                        float* p = (float*)(ws + (MODE == 9 ? WS_P1 : WS_P2)) + ((size_t)(u.pn >> 2) * MS + row) * D + (u.pn & 3) * 256 + bj * 128 + cw;
                        *(f32x4*)p = v0; *(f32x4*)(p + 4) = v1;
                    } else if constexpr (MODE == 7) {
                        f32x4 a = v0, b = v1;
#pragma unroll
                        for (int e = 0; e < 4; ++e) { a[e] = fmaxf(a[e], 0.f); a[e] *= a[e]; b[e] = fmaxf(b[e], 0.f); b[e] *= b[e]; }
                        store8bf((bf16*)(ws + WS_HDN) + (size_t)row * FF + col, a, b);
                    }
                }
                asm volatile("" ::: "memory");
            }
    }
};

template <int MAP> __device__ __forceinline__ int wt_row(int n) {
    if constexpr (MAP == 0) return n;
    else if constexpr (MAP == 1) return n < 704 ? n : n + 64;
    else { const int h = n / 192, j = n - h * 192;
        if (j < 128) return h * 128 + j;
        const int i = j - 128, x2 = i >> 5, idx = i & 31;
        return 1024 + h * 64 + 8 * (idx >> 2) + 4 * x2 + (idx & 3); }
}
template <int MAP> __device__ __forceinline__ void transpose_item(const float* W, int K, int N, bf16* WT, const float* kscale, LAS float* scr, int item, int lane) {
    const int nblk = N / 32, kb = item / nblk, nb = item % nblk, k0 = 64 * kb, n0 = 32 * nb;
#pragma unroll 8
    for (int i = 0; i < 32; ++i) { const int kk = 2 * i + (lane >> 5); scr[kk * 33 + (lane & 31)] = W[(size_t)(k0 + kk) * N + n0 + (lane & 31)]; }
    LDS_WAIT(); asm volatile("" ::: "memory");
    const int c = lane & 7;
    float ks[8];
#pragma unroll
    for (int e = 0; e < 8; ++e) ks[e] = kscale ? kscale[k0 + 8 * c + e] : 1.f;
#pragma unroll
    for (int j = 0; j < 4; ++j) { const int n = (lane >> 3) + 8 * j; const LAS float* s = scr + (8 * c) * 33 + n;
        v4u o; o.x = pk2(s[0 * 33] * ks[0], s[1 * 33] * ks[1]); o.y = pk2(s[2 * 33] * ks[2], s[3 * 33] * ks[3]); o.z = pk2(s[4 * 33] * ks[4], s[5 * 33] * ks[5]); o.w = pk2(s[6 * 33] * ks[6], s[7 * 33] * ks[7]);
        *(GAS v4u*)(WT + (size_t)wt_row<MAP>(n0 + n) * K + k0 + 8 * c) = o; }
    LDS_WAIT(); asm volatile("" ::: "memory");
}
__device__ __forceinline__ int crow32(int r, int hi) { return (r & 3) + 8 * (r >> 2) + 4 * hi; }
__device__ __forceinline__ bf16x8 pack8f(const float* a) {
    v4u w; w.x = pg8::cvt_pk_bf16(a[0], a[1]); w.y = pg8::cvt_pk_bf16(a[2], a[3]); w.z = pg8::cvt_pk_bf16(a[4], a[5]); w.w = pg8::cvt_pk_bf16(a[6], a[7]);
    return __builtin_bit_cast(bf16x8, w);
}
__device__ __forceinline__ void adaln_task(Frame& F, int et) {
    const int e0 = et * 32, r = F.lane & 31, h = F.lane >> 5, w = F.wave;
    f32x16 acc[5];
#pragma unroll
    for (int st = 0; st < 5; ++st)
#pragma unroll
        for (int i = 0; i < 16; ++i) acc[st][i] = 0.f;
    for (int ks = 0; ks < 8; ++ks) {
        const int k0 = w * 128 + ks * 16 + 8 * h;
        float a[8];
#pragma unroll
        for (int j = 0; j < 8; ++j) a[j] = F.w_ada[(size_t)(k0 + j) * (6 * D) + e0 + r];
        const bf16x8 af = pack8f(a);
#pragma unroll
        for (int st = 0; st < 5; ++st) {
            int s = 32 * st + r; s = s < NSEQ ? s : NSEQ - 1;
            const float* cp = (s < NB ? F.c_p + (size_t)s * D : F.c_s + (size_t)(s - NB) * D) + k0;
            const f32x4 c0 = *(const f32x4*)cp, c1 = *(const f32x4*)(cp + 4);
            float b[8] = {silu_f(c0[0]), silu_f(c0[1]), silu_f(c0[2]), silu_f(c0[3]), silu_f(c1[0]), silu_f(c1[1]), silu_f(c1[2]), silu_f(c1[3])};
            acc[st] = __builtin_amdgcn_mfma_f32_32x32x16_bf16(af, pack8f(b), acc[st], 0, 0, 0);
        }
    }
    LAS float* red = (LAS float*)F.lds;
    float* mod = (float*)(F.ws + WS_MOD);
#pragma unroll
    for (int st = 0; st < 5; ++st) {
#pragma unroll
        for (int i = 0; i < 16; ++i) red[(w * 16 + i) * 64 + F.lane] = acc[st][i];
        __syncthreads();
#pragma unroll
        for (int q = 0; q < 2; ++q) {
            const int idx = F.tid + 512 * q, reg = idx >> 6, lo = idx & 63;
            float sum = 0.f;
#pragma unroll
            for (int ww = 0; ww < 8; ++ww) sum += red[ww * 1024 + idx];
            const int s = 32 * st + (lo & 31), e = e0 + crow32(reg, lo >> 5);
            if (s < NSEQ) mod[(size_t)s * (6 * D) + e] = sum + F.b_ada[e];
        }
        __syncthreads();
    }
}
__device__ __forceinline__ void p0_prologue(Frame& F) {
    for (int et = blockIdx.x; et < (6 * D) / 32; et += F.G) adaln_task(F, et);
    __syncthreads();
    LAS float* scr = (LAS float*)(F.lds + RING_OFF + F.wave * 16384);
    constexpr int I_IN = (D / 64) * (DIN / 32), I_QB = (QLORA / 64) * (NQ / 32), I_KVB = (KVL / 64) * (2048 / 32), I_O = (D / 64) * (D / 32), I_1 = (D / 64) * (FF / 32), I_2 = (FF / 64) * (D / 32);
    constexpr int NITEMS = I_IN + I_QB + I_KVB + I_O + I_1 + I_2;
    for (int it = F.gw; it < NITEMS; it += F.NGW) {
        int r = it;
        if (r < I_IN) { transpose_item<1>(F.w_in, D, DIN, (bf16*)(F.ws + WS_WIN), nullptr, scr, r, F.lane); continue; } r -= I_IN;
        if (r < I_QB) { transpose_item<2>(F.w_q_b, QLORA, NQ, (bf16*)(F.ws + WS_WQB), F.g_q, scr, r, F.lane); continue; } r -= I_QB;
        if (r < I_KVB) { transpose_item<0>(F.w_kv_b, KVL, 2048, (bf16*)(F.ws + WS_WKVB), nullptr, scr, r, F.lane); continue; } r -= I_KVB;
        if (r < I_O) { transpose_item<0>(F.w_o, D, D, (bf16*)(F.ws + WS_WO), nullptr, scr, r, F.lane); continue; } r -= I_O;
        if (r < I_1) { transpose_item<0>(F.w_1, D, FF, (bf16*)(F.ws + WS_W1), nullptr, scr, r, F.lane); continue; } r -= I_1;
        transpose_item<0>(F.w_2, FF, D, (bf16*)(F.ws + WS_W2), nullptr, scr, r, F.lane);
    }
    const int gt = F.gw * 64 + F.lane, NGT = F.NGW * 64;
    for (int i = gt; i < 64 * D / 8; i += NGT) *(v4u*)((bf16*)(F.ws + WS_WIN) + (size_t)704 * D + (size_t)i * 8) = (v4u){0u, 0u, 0u, 0u};
    for (int i = gt; i < 2048 * 256 / 8; i += NGT) {
        const int row = i >> 5, k8 = (i & 31) * 8, hh = row >> 8, c = row & 255; v4u o = {0u, 0u, 0u, 0u};
        if (k8 < 128) { const float* s = F.w_kv_b + (size_t)c * 2048 + hh * 256 + k8; const f32x4 a = *(const f32x4*)s, b = *(const f32x4*)(s + 4);
            o.x = pk2(a[0], a[1]); o.y = pk2(a[2], a[3]); o.z = pk2(b[0], b[1]); o.w = pk2(b[2], b[3]); }
        *(v4u*)((bf16*)(F.ws + WS_WUK) + (size_t)row * 256 + k8) = o;
    }
    for (int i = gt; i < NPOS * 32; i += NGT) {
        const int p = i >> 5, fi = i & 31; const double pos = (double)(p < SEQ ? p : p + (PAST - SEQ));
        const double rev = pos * ROPE_INV[fi] * 0.15915494309189535; const float fr = (float)(rev - __builtin_rint(rev));
        f32x2 cs; cs.x = __builtin_amdgcn_cosf(fr); cs.y = __builtin_amdgcn_sinf(fr);
        *((f32x2*)(F.ws + WS_TAB) + i) = cs;
    }
}
__device__ __forceinline__ void norm_mod_row(Frame& F, const float* src, const float* g, const float* sc, const float* sh, bf16* dst) {
    f32x4 v[4]; float s = 0.f;
#pragma unroll
    for (int j = 0; j < 4; ++j) { v[j] = *((const f32x4*)src + F.lane + 64 * j); s += (v[j].x * v[j].x + v[j].y * v[j].y) + (v[j].z * v[j].z + v[j].w * v[j].w); }
    const float r = 1.f / sqrtf(wave_sum(s) * (1.f / D) + EPS);
#pragma unroll
    for (int j = 0; j < 4; ++j) { const int c4 = F.lane + 64 * j; const f32x4 gg = *((const f32x4*)g + c4), ss = *((const f32x4*)sc + c4), hh = *((const f32x4*)sh + c4);
        const f32x4 o = (v[j] * r) * gg * (ss + 1.f) + hh; store4bf(dst + c4 * 4, o); }
}
__device__ __forceinline__ void small_row(Frame& F, int m) {
    const float* sm = (const float*)(F.ws + WS_SM) + (size_t)m * NSM;
    const int l = F.lane; const bool samp = m >= MP; const int ms = m - MP;
    const f32x4 qa = *((const f32x4*)sm + l); const f32x2 qb = *((const f32x2*)(sm + 256) + l);
    float s = (qa.x * qa.x + qa.y * qa.y) + (qa.z * qa.z + qa.w * qa.w) + (qb.x * qb.x + qb.y * qb.y);
    const float rq = 1.f / sqrtf(wave_sum(s) * (1.f / QLORA) + EPS);
    bf16* qo = (bf16*)(F.ws + WS_QA) + (size_t)m * QLORA;
    store4bf(qo + 4 * l, qa * rq); *(unsigned*)(qo + 256 + 2 * l) = pg8::cvt_pk_bf16(qb.x * rq, qb.y * rq);
    const f32x4 kv = *((const f32x4*)(sm + 384) + l);
    s = (kv.x * kv.x + kv.y * kv.y) + (kv.z * kv.z + kv.w * kv.w);
    const float rk = 1.f / sqrtf(wave_sum(s) * (1.f / KVL) + EPS);
    const f32x4 kn = (kv * rk) * *((const f32x4*)F.g_kv + l);
    float* ock = samp ? F.out + O_CKVS + (size_t)ms * KVL : F.out + O_CKVP + (size_t)m * KVL;
    *((f32x4*)ock + l) = kn;
    store4bf((bf16*)(F.ws + WS_CKVN) + (size_t)m * KVL + 4 * l, kn);
    if (samp) store4bf((bf16*)(F.ws + WS_KNEW) + (size_t)ms * 320 + 4 * l, kn);
    if (l < 32) {
        const float x1 = sm[640 + l], x2 = sm[672 + l];
        const f32x2 cs = *((const f32x2*)(F.ws + WS_TAB) + (size_t)pidx_of_row(m) * 32 + l);
        const float o1 = x1 * cs.x - x2 * cs.y, o2 = x2 * cs.x + x1 * cs.y;
        float* okr = samp ? F.out + O_KRS + (size_t)ms * ROPE : F.out + O_KRP + (size_t)m * ROPE;
        okr[l] = o1; okr[32 + l] = o2;
        const bf16 b1 = (bf16)f2bf(o1), b2 = (bf16)f2bf(o2);
        if (samp) { bf16* kn2 = (bf16*)(F.ws + WS_KNEW) + (size_t)ms * 320 + 256; kn2[l] = b1; kn2[32 + l] = b2; }
        else { const int b = m >> 12, t = m & (SEQ - 1);
#pragma unroll
            for (int hh = 0; hh < NH; ++hh) { bf16* kp = (bf16*)(F.ws + WS_KP) + ((size_t)(b * NH + hh) * SEQ + t) * 192 + 128; kp[l] = b1; kp[32 + l] = b2; } }
    }
    const int t = samp ? (ms & (DSEQ - 1)) : (m & (SEQ - 1)), T = samp ? DSEQ : SEQ;
    if (t >= T - 2) {
        const bf16* big = (const bf16*)(F.ws + WS_BIG) + (size_t)m * NBIG;
        float* oc = (samp ? F.out + O_CVS + (size_t)(ms >> 3) * 2 * D : F.out + O_CVP + (size_t)(m >> 12) * 2 * D) + (size_t)(t - (T - 2)) * D;
#pragma unroll
        for (int j = 0; j < 2; ++j) { const int c8 = (l + 64 * j) * 8;
            const v4u cg = *(const v4u*)(big + 1024 + c8), xi = *(const v4u*)(big + 2048 + c8);
            f32x4 a = {bflo(cg.x) * bflo(xi.x), bfhi(cg.x) * bfhi(xi.x), bflo(cg.y) * bflo(xi.y), bfhi(cg.y) * bfhi(xi.y)};
            f32x4 b = {bflo(cg.z) * bflo(xi.z), bfhi(cg.z) * bfhi(xi.z), bflo(cg.w) * bflo(xi.w), bfhi(cg.w) * bfhi(xi.w)};
            *(f32x4*)(oc + c8) = a; *(f32x4*)(oc + c8 + 4) = b; }
    }
}
__device__ __forceinline__ void naive_attn_prompt_row(Frame& F, int rid) {
    const int h = rid & 7, m = rid >> 3, b = m >> 12, t = m & (SEQ - 1), l = F.lane;
    LAS float* qs = (LAS float*)(F.lds + F.wave * 8192); LAS float* sc = qs + 320;
    const bf16* qb = (const bf16*)(F.ws + WS_QB) + (size_t)m * NQ;
    qs[l] = bf2f(qb[h * 128 + l]); qs[64 + l] = bf2f(qb[h * 128 + 64 + l]); qs[128 + l] = bf2f(qb[1024 + h * 64 + l]);
    LDS_WAIT(); asm volatile("" ::: "memory");
    const bf16* K = (const bf16*)(F.ws + WS_KP) + (size_t)(b * NH + h) * SEQ * 192; const bf16* V = (const bf16*)(F.ws + WS_VP) + (size_t)(b * NH + h) * SEQ * 128;
    const int nk = t + 1; float mx = -1e30f, lsum = 0.f, o0 = 0.f, o1 = 0.f;
    for (int c0 = 0; c0 < nk; c0 += 1024) {
        const int cn = (nk - c0) < 1024 ? (nk - c0) : 1024; float cm = -1e30f;
        for (int i = l; i < cn; i += 64) { const bf16* kr = K + (size_t)(c0 + i) * 192; float s = 0.f;
#pragma unroll 4
            for (int d8 = 0; d8 < 24; ++d8) { const v4u kk = *(const v4u*)(kr + d8 * 8); const f32x4 qa = *(const LAS f32x4*)(qs + d8 * 8), qc = *(const LAS f32x4*)(qs + d8 * 8 + 4);
                s += bflo(kk.x) * qa.x + bfhi(kk.x) * qa.y + bflo(kk.y) * qa.z + bfhi(kk.y) * qa.w + bflo(kk.z) * qc.x + bfhi(kk.z) * qc.y + bflo(kk.w) * qc.z + bfhi(kk.w) * qc.w; }
            sc[i] = s; cm = fmaxf(cm, s); }
        cm = wave_max(cm); const float mn = fmaxf(mx, cm), alpha = exp2f(mx - mn); mx = mn; o0 *= alpha; o1 *= alpha; lsum *= alpha;
        float ps = 0.f;
        for (int i = l; i < cn; i += 64) { const float p = exp2f(sc[i] - mn); sc[i] = p; ps += p; }
        lsum += wave_sum(ps);
        LDS_WAIT(); asm volatile("" ::: "memory");
        for (int i = 0; i < cn; ++i) { const float p = sc[i]; const unsigned vv = *(const unsigned*)(V + (size_t)(c0 + i) * 128 + 2 * l); o0 += p * bflo(vv); o1 += p * bfhi(vv); }
        LDS_WAIT(); asm volatile("" ::: "memory");
    }
    const float inv = 1.f / lsum;
    *(unsigned*)((bf16*)(F.ws + WS_ATT) + (size_t)m * D + h * 128 + 2 * l) = pg8::cvt_pk_bf16(o0 * inv, o1 * inv);
}
__device__ __forceinline__ void naive_attn_decode_row(Frame& F, int rid) {
    const int h = rid & 7, sm = rid >> 3, sb = sm >> 3, t = sm & 7, l = F.lane;
    LAS float* qs = (LAS float*)(F.lds + F.wave * 8192); LAS float* sc = qs + 320;
    const bf16* ql = (const bf16*)(F.ws + WS_QL) + ((size_t)sm * NH + h) * 320;
#pragma unroll
    for (int j = 0; j < 5; ++j) qs[l + 64 * j] = bf2f(ql[l + 64 * j]);
    LDS_WAIT(); asm volatile("" ::: "memory");
    const int* pt = F.page_table + sb * NPAGES; const bf16* knew = (const bf16*)(F.ws + WS_KNEW) + (size_t)sb * DSEQ * 320;
    const int nk = PAST + t + 1; float mx = -1e30f, lsum = 0.f; f32x4 o = {0.f, 0.f, 0.f, 0.f};
    for (int c0 = 0; c0 < nk; c0 += 1024) {
        const int cn = (nk - c0) < 1024 ? (nk - c0) : 1024; float cm = -1e30f;
        for (int i = l; i < cn; i += 64) { const int j = c0 + i; float s = 0.f;
            if (j < PAST) { const size_t prow = (size_t)pt[j >> 7] * PAGE + (j & 127); const float* ck = F.cache_ckv + prow * KVL; const float* kr = F.cache_kr + prow * ROPE;
#pragma unroll 4
                for (int d4 = 0; d4 < 64; ++d4) { const f32x4 kk = *(const f32x4*)(ck + d4 * 4); const f32x4 qq = *(const LAS f32x4*)(qs + d4 * 4); s += kk.x * qq.x + kk.y * qq.y + kk.z * qq.z + kk.w * qq.w; }
#pragma unroll 4
                for (int d4 = 0; d4 < 16; ++d4) { const f32x4 kk = *(const f32x4*)(kr + d4 * 4); const f32x4 qq = *(const LAS f32x4*)(qs + 256 + d4 * 4); s += kk.x * qq.x + kk.y * qq.y + kk.z * qq.z + kk.w * qq.w; }
            } else { const bf16* kn = knew + (size_t)(j - PAST) * 320;
#pragma unroll 4
                for (int d8 = 0; d8 < 40; ++d8) { const v4u kk = *(const v4u*)(kn + d8 * 8); const f32x4 qa = *(const LAS f32x4*)(qs + d8 * 8), qc = *(const LAS f32x4*)(qs + d8 * 8 + 4);
                    s += bflo(kk.x) * qa.x + bfhi(kk.x) * qa.y + bflo(kk.y) * qa.z + bfhi(kk.y) * qa.w + bflo(kk.z) * qc.x + bfhi(kk.z) * qc.y + bflo(kk.w) * qc.z + bfhi(kk.w) * qc.w; }
            }
            sc[i] = s; cm = fmaxf(cm, s); }
        cm = wave_max(cm); const float mn = fmaxf(mx, cm), alpha = exp2f(mx - mn); mx = mn; o = o * alpha; lsum *= alpha;
        float ps = 0.f;
        for (int i = l; i < cn; i += 64) { const float p = exp2f(sc[i] - mn); sc[i] = p; ps += p; }
        lsum += wave_sum(ps);
        LDS_WAIT(); asm volatile("" ::: "memory");
        for (int i = 0; i < cn; ++i) { const int j = c0 + i; const float p = sc[i]; f32x4 vv;
            if (j < PAST) { const size_t prow = (size_t)pt[j >> 7] * PAGE + (j & 127); vv = *((const f32x4*)(F.cache_ckv + prow * KVL) + l); }
            else { const v2u w = *((const v2u*)(knew + (size_t)(j - PAST) * 320) + l); vv = (f32x4){bflo(w.x), bfhi(w.x), bflo(w.y), bfhi(w.y)}; }
            o = o + vv * p; }
        LDS_WAIT(); asm volatile("" ::: "memory");
    }
    const float inv = 1.f / lsum;
    store4bf((bf16*)(F.ws + WS_OLAT) + ((size_t)sm * NH + h) * 256 + 4 * l, o * inv);
}
__device__ __forceinline__ void merged_row(Frame& F, int m) {
    const bool samp = m >= MP; const int ms = m - MP, l = F.lane;
    const int t = samp ? (ms & (DSEQ - 1)) : (m & (SEQ - 1));
    const bf16* big = (const bf16*)(F.ws + WS_BIG) + (size_t)m * NBIG;
    const bf16* att = (const bf16*)(F.ws + WS_ATT) + (size_t)m * D; bf16* mo = (bf16*)(F.ws + WS_MERGED) + (size_t)m * D;
    const float* sc0 = F.state_conv + (size_t)(samp ? (ms >> 3) : 0) * 2 * D;
#pragma unroll
    for (int j = 0; j < 2; ++j) {
        const int c8 = (l + 64 * j) * 8;
        const v4u bg = *(const v4u*)(big + c8), cg = *(const v4u*)(big + 1024 + c8), xi = *(const v4u*)(big + 2048 + c8), ga = *(const v4u*)(big + 3072 + c8), gb = *(const v4u*)(big + 4096 + c8), at = *(const v4u*)(att + c8);
        v4u cg1 = {0u, 0u, 0u, 0u}, xi1 = cg1, cg2 = cg1, xi2 = cg1;
        if (t >= 1) { cg1 = *(const v4u*)(big - NBIG + 1024 + c8); xi1 = *(const v4u*)(big - NBIG + 2048 + c8); }
        if (t >= 2) { cg2 = *(const v4u*)(big - 2 * NBIG + 1024 + c8); xi2 = *(const v4u*)(big - 2 * NBIG + 2048 + c8); }
        float res[8];
#pragma unroll
        for (int e = 0; e < 8; ++e) {
            const unsigned wb = ((const unsigned*)&bg)[e >> 1], wc = ((const unsigned*)&cg)[e >> 1], wx = ((const unsigned*)&xi)[e >> 1], wa = ((const unsigned*)&ga)[e >> 1], wg = ((const unsigned*)&gb)[e >> 1], wt = ((const unsigned*)&at)[e >> 1];
            const unsigned wc1 = ((const unsigned*)&cg1)[e >> 1], wx1 = ((const unsigned*)&xi1)[e >> 1], wc2 = ((const unsigned*)&cg2)[e >> 1], wx2 = ((const unsigned*)&xi2)[e >> 1];
#define SEL(w) ((e & 1) ? bfhi(w) : bflo(w))
            const int col = c8 + e;
            const float v0 = SEL(wc) * SEL(wx);
            float v1 = SEL(wc1) * SEL(wx1), v2 = SEL(wc2) * SEL(wx2);
            if (samp) { if (t == 0) { v1 = sc0[D + col]; v2 = sc0[col]; } else if (t == 1) { v2 = sc0[D + col]; } }
            const float z = F.conv_w[col] * v2 + F.conv_w[D + col] * v1 + F.conv_w[2 * D + col] * v0;
            res[e] = sigmoid_f(SEL(wa)) * SEL(wt) + sigmoid_f(SEL(wg)) * (SEL(wb) * z);
#undef SEL
        }
        v4u o; o.x = pg8::cvt_pk_bf16(res[0], res[1]); o.y = pg8::cvt_pk_bf16(res[2], res[3]); o.z = pg8::cvt_pk_bf16(res[4], res[5]); o.w = pg8::cvt_pk_bf16(res[6], res[7]);
        *(v4u*)(mo + c8) = o;
    }
}
__device__ __forceinline__ void sample_x1_row(Frame& F, int ms, const float* g1) {
    const float* xs = F.x_s + (size_t)ms * D; const float* p1 = (const float*)(F.ws + WS_P1) + (size_t)ms * D; float* x1 = (float*)(F.ws + WS_X1) + (size_t)(MP + ms) * D;
#pragma unroll
    for (int j = 0; j < 4; ++j) { const int c4 = F.lane + 64 * j;
        f32x4 a = *((const f32x4*)p1 + c4);
#pragma unroll
        for (int kc = 1; kc < 4; ++kc) a = a + *((const f32x4*)(p1 + (size_t)kc * MS * D) + c4);
        *((f32x4*)x1 + c4) = *((const f32x4*)xs + c4) + *((const f32x4*)g1 + c4) * a; }
    asm volatile("s_waitcnt vmcnt(0)" ::: "memory");
}
__device__ __forceinline__ void final_row(Frame& F, int m) {
    float* y = F.out + O_Y + (size_t)m * D; f32x4 v[4]; float s = 0.f;
    if (m < MP) {
#pragma unroll
        for (int j = 0; j < 4; ++j) v[j] = *((const f32x4*)y + F.lane + 64 * j);
    } else {
        const int ms = m - MP; const float* x1 = (const float*)(F.ws + WS_X1) + (size_t)m * D; const float* p2 = (const float*)(F.ws + WS_P2) + (size_t)ms * D;
        const float* g2 = (const float*)(F.ws + WS_MOD) + (size_t)seq_of_row(m) * (6 * D) + 5 * D;
#pragma unroll
        for (int j = 0; j < 4; ++j) { const int c4 = F.lane + 64 * j; f32x4 a = *((const f32x4*)p2 + c4);
#pragma unroll
            for (int kc = 1; kc < 8; ++kc) a = a + *((const f32x4*)(p2 + (size_t)kc * MS * D) + c4);
            v[j] = *((const f32x4*)x1 + c4) + *((const f32x4*)g2 + c4) * a; }
    }
#pragma unroll
    for (int j = 0; j < 4; ++j) s += (v[j].x * v[j].x + v[j].y * v[j].y) + (v[j].z * v[j].z + v[j].w * v[j].w);
    const float r = 1.f / sqrtf(wave_sum(s) * (1.f / D) + EPS);
#pragma unroll
    for (int j = 0; j < 4; ++j) *((f32x4*)y + F.lane + 64 * j) = (v[j] * r) * *((const f32x4*)F.g_final + F.lane + 64 * j);
}
#define SBAR() __builtin_amdgcn_sched_barrier(0)
typedef short s16x4 __attribute__((ext_vector_type(4)));
typedef LAS s16x4* lds_s16x4p;
__device__ __forceinline__ unsigned cvtpk(float lo, float hi) { return pg8::cvt_pk_bf16(lo, hi); }
__device__ __forceinline__ bf16x8 ld_lds8(LAS unsigned char* p) { return *(const LAS bf16x8*)p; }
__device__ __forceinline__ s16x4 tr_rd(LAS unsigned char* p) { return __builtin_bit_cast(s16x4, __builtin_amdgcn_ds_read_tr16_b64_v4i16((LAS s16x4*)p)); }
__device__ __forceinline__ unsigned off_b(unsigned row, unsigned ch) { return 256u * row + 16u * (ch ^ (((row & 3) << 2) | ((row >> 2) & 3))); }
__device__ __forceinline__ unsigned off_r(unsigned row, unsigned ch) { return 128u * row + 16u * (ch ^ ((row >> 1) & 7)); }
__device__ __forceinline__ unsigned tr_addr(unsigned lane, unsigned rowbase, unsigned c, unsigned ks, unsigned t) {
    const unsigned h = lane >> 5, blk = (lane >> 4) & 1, q = (lane & 15) >> 2, p = lane & 3;
    return off_b(rowbase + 16 * ks + 8 * h + 4 * t + q, 4 * c + 2 * blk + (p >> 1)) + 8 * (p & 1);
}
constexpr float THR2 = 11.5f;
#define PK4(P, B_, OUT) do { unsigned a0 = cvtpk(P[B_+0], P[B_+1]), a1 = cvtpk(P[B_+2], P[B_+3]);                          \
        unsigned b0 = cvtpk(P[B_+4], P[B_+5]), b1 = cvtpk(P[B_+6], P[B_+7]);                                             \
        auto r0 = __builtin_amdgcn_permlane32_swap(a0, b0, false, false); auto r1 = __builtin_amdgcn_permlane32_swap(a1, b1, false, false); \
        v4u w = {r0[0], r1[0], r0[1], r1[1]}; OUT = __builtin_bit_cast(bf16x8, w); } while (0)
__device__ __forceinline__ float swap_max(float v) { auto rr = __builtin_amdgcn_permlane32_swap(__float_as_uint(v), __float_as_uint(v), false, false); return fmaxf(__uint_as_float(rr[0]), __uint_as_float(rr[1])); }
__device__ __forceinline__ float swap_sum(float v) { auto rr = __builtin_amdgcn_permlane32_swap(__float_as_uint(v), __float_as_uint(v), false, false); return __uint_as_float(rr[0]) + __uint_as_float(rr[1]); }
__device__ __forceinline__ void softmax64(f32x16& p0, f32x16& p1, float& m_reg, float& l_reg, float& alpha, bf16x8& pa0, bf16x8& pa1, bf16x8& pa2, bf16x8& pa3) {
    float pmax = p0[0];
#pragma unroll
    for (int r = 1; r < 16; ++r) pmax = fmaxf(pmax, p0[r]);
#pragma unroll
    for (int r = 0; r < 16; ++r) pmax = fmaxf(pmax, p1[r]);
    pmax = swap_max(pmax);
    float mn;
    if (__all(pmax - m_reg <= THR2)) { mn = m_reg; alpha = 1.f; } else { mn = fmaxf(m_reg, pmax); alpha = __builtin_amdgcn_exp2f(m_reg - mn); m_reg = mn; }
    float ps = 0.f;
#pragma unroll
    for (int r = 0; r < 16; ++r) { p0[r] = __builtin_amdgcn_exp2f(p0[r] - mn); ps += p0[r]; }
#pragma unroll
    for (int r = 0; r < 16; ++r) { p1[r] = __builtin_amdgcn_exp2f(p1[r] - mn); ps += p1[r]; }
    l_reg = l_reg * alpha + swap_sum(ps);
    PK4(p0, 0, pa0); PK4(p0, 8, pa1); PK4(p1, 0, pa2); PK4(p1, 8, pa3);
}
__device__ __forceinline__ void softmax32(f32x16& p0, float& m_reg, float& l_reg, float& alpha, bf16x8& pa0, bf16x8& pa1) {
    float pmax = p0[0];
#pragma unroll
    for (int r = 1; r < 16; ++r) pmax = fmaxf(pmax, p0[r]);
    pmax = swap_max(pmax);
    float mn;
    if (__all(pmax - m_reg <= THR2)) { mn = m_reg; alpha = 1.f; } else { mn = fmaxf(m_reg, pmax); alpha = __builtin_amdgcn_exp2f(m_reg - mn); m_reg = mn; }
    float ps = 0.f;
#pragma unroll
    for (int r = 0; r < 16; ++r) { p0[r] = __builtin_amdgcn_exp2f(p0[r] - mn); ps += p0[r]; }
    l_reg = l_reg * alpha + swap_sum(ps);
    PK4(p0, 0, pa0); PK4(p0, 8, pa1);
}
constexpr int PA_V = 0, PA_VB = 16384, PA_K = 2 * PA_VB, PA_KB = 24576, PA_SCR = PA_K + 2 * PA_KB;
__device__ __forceinline__ int pv_st(int k, int c) { const int kk = (k & ~0xC) | ((k & 4) << 1) | ((k & 8) >> 1); return ((kk >> 3) * 4 + (c >> 5)) * 512 + ((kk & 7) * 32 + (c & 31)) * 2; }
__device__ __forceinline__ int pv_rd_base(int lane) { return ((lane & 3) << 3) | (((lane >> 2) & 3) << 6) | (((lane >> 4) & 1) << 5) | (((lane >> 5) & 1) << 8); }
template <int VB> __device__ __forceinline__ void pa_pv_tile(f32x16* o, unsigned vb0, bf16x8 pa0, bf16x8 pa1, bf16x8 pa2, bf16x8 pa3) {
#define TRRD(dst, off) asm volatile("ds_read_b64_tr_b16 %0, %1 offset:%2" : "=&v"(dst) : "v"(vb0), "i"(off) : "memory")
#define PV_D0(d0) do { s16x4 l0, l1, l2, l3, h0, h1, h2, h3; constexpr int b_ = PA_V + VB * PA_VB + (d0) * 512;   \
        TRRD(l0, b_); TRRD(h0, b_ + 2048); TRRD(l1, b_ + 4096); TRRD(h1, b_ + 6144); TRRD(l2, b_ + 8192); TRRD(h2, b_ + 10240); TRRD(l3, b_ + 12288); TRRD(h3, b_ + 14336); \
        asm volatile("s_waitcnt lgkmcnt(0)" ::: "memory"); SBAR();   \
        o[d0] = __builtin_amdgcn_mfma_f32_32x32x16_bf16(pa0, (bf16x8){l0[0], l0[1], l0[2], l0[3], h0[0], h0[1], h0[2], h0[3]}, o[d0], 0, 0, 0);   \
        o[d0] = __builtin_amdgcn_mfma_f32_32x32x16_bf16(pa1, (bf16x8){l1[0], l1[1], l1[2], l1[3], h1[0], h1[1], h1[2], h1[3]}, o[d0], 0, 0, 0);   \
        o[d0] = __builtin_amdgcn_mfma_f32_32x32x16_bf16(pa2, (bf16x8){l2[0], l2[1], l2[2], l2[3], h2[0], h2[1], h2[2], h2[3]}, o[d0], 0, 0, 0);   \
        o[d0] = __builtin_amdgcn_mfma_f32_32x32x16_bf16(pa3, (bf16x8){l3[0], l3[1], l3[2], l3[3], h3[0], h3[1], h3[2], h3[3]}, o[d0], 0, 0, 0); } while (0)
    PV_D0(0); PV_D0(1); PV_D0(2); PV_D0(3);
#undef PV_D0
#undef TRRD
}
__device__ __forceinline__ void attn_prompt_block(Frame& F, int b, int h, int qb) {
    unsigned z_ = 0u; asm volatile("" : "+v"(z_)); const int lane = (int)__builtin_amdgcn_mbcnt_hi(~0u, __builtin_amdgcn_mbcnt_lo(~0u, z_));
    const int wid = F.wave, tid = wid * 64 + lane, r32 = lane & 31, hi = lane >> 5;
    LAS unsigned char* L = F.lds;
    const bf16* Kg = (const bf16*)(F.ws + WS_KP) + (size_t)(b * NH + h) * SEQ * 192;
    const bf16* Vg = (const bf16*)(F.ws + WS_VP) + (size_t)(b * NH + h) * SEQ * 128;
    const int row0 = b * SEQ + qb * 256 + wid * 32;
    const int qpos = qb * 256 + wid * 32 + r32;
    const int qlo = qb * 256 + wid * 32;
    const int NT = 4 * (qb + 1);
    bf16x8 qr[12];
    { const bf16* qp = (const bf16*)(F.ws + WS_QB) + (size_t)(row0 + r32) * NQ;
#pragma unroll
      for (int d0 = 0; d0 < 12; ++d0) qr[d0] = *(const bf16x8*)(qp + (d0 < 8 ? h * 128 + 16 * d0 + 8 * hi : 1024 + h * 64 + 16 * (d0 - 8) + 8 * hi)); }
    unsigned kso[3], vso[2];
#pragma unroll
    for (int i = 0; i < 3; ++i) { const unsigned p = (unsigned)(wid * 3 + i) * 64 + lane, row = p / 24, chp = p - row * 24, ch = chp ^ ((row >> 1) & 7); kso[i] = row * 192 + ch * 8; }
#pragma unroll
    for (int i = 0; i < 2; ++i) { const unsigned B_ = ((unsigned)(wid * 2 + i) * 64 + lane) * 16, st = B_ >> 9, wi = B_ & 511, kk = (st >> 2) * 8 + (wi >> 6), c = (st & 3) * 32 + ((wi & 63) >> 1);
        const unsigned k = (kk & ~0xCu) | ((kk & 4) << 1) | ((kk & 8) >> 1); vso[i] = k * 128 + c; }
#define PA_STAGE(t, bf) do { const bf16* kt = Kg + (size_t)(t) * 64 * 192; const bf16* vt = Vg + (size_t)(t) * 64 * 128;   \
        _Pragma("unroll") for (int i = 0; i < 3; ++i) __builtin_amdgcn_global_load_lds((const unsigned*)(kt + kso[i]), (LAS unsigned*)(L + PA_K + (bf) * PA_KB + (wid * 3 + i) * 1024), 16, 0, 0);   \
        _Pragma("unroll") for (int i = 0; i < 2; ++i) __builtin_amdgcn_global_load_lds((const unsigned*)(vt + vso[i]), (LAS unsigned*)(L + PA_V + (bf) * PA_VB + (wid * 2 + i) * 1024), 16, 0, 0); } while (0)
    LAS float* al_l = (LAS float*)(L + PA_SCR + wid * 256); LAS float* li_l = al_l + 32;
    const unsigned vb0 = (unsigned)pv_rd_base(lane);
    const int fx = (r32 >> 1) & 7;
    int kb4[4];
#pragma unroll
    for (int dd = 0; dd < 4; ++dd) kb4[dd] = r32 * 384 + (((2 * dd + hi) ^ fx) << 4);
    float m_reg = -1e30f, l_reg = 0.f; f32x16 o[4];
#pragma unroll
    for (int d = 0; d < 4; ++d)
#pragma unroll
        for (int r = 0; r < 16; ++r) o[d][r] = 0.f;
    PA_STAGE(0, 0); VM_WAIT();
    __syncthreads();
#define PA_STEP(t, KB) do {                                                                                                     \
        if ((t) + 1 < NT) PA_STAGE((t) + 1, (KB) ^ 1);                                                                          \
        f32x16 p0, p1;                                                                                                          \
        _Pragma("unroll") for (int r = 0; r < 16; ++r) { p0[r] = 0.f; p1[r] = 0.f; }                                            \
        _Pragma("unroll") for (int g_ = 0; g_ < 6; ++g_) { bf16x8 kf[4];                                                        \
            _Pragma("unroll") for (int dd = 0; dd < 2; ++dd) { const int d0 = 2 * g_ + dd; LAS unsigned char* a = L + PA_K + (KB) * PA_KB + kb4[d0 & 3] + (d0 >> 2) * 128; kf[2 * dd] = ld_lds8(a); kf[2 * dd + 1] = ld_lds8(a + 32 * 384); }   \
            SBAR();                                                                                                             \
            _Pragma("unroll") for (int dd = 0; dd < 2; ++dd) {                                                                  \
                p0 = __builtin_amdgcn_mfma_f32_32x32x16_bf16(kf[2 * dd], qr[2 * g_ + dd], p0, 0, 0, 0);                          \
                p1 = __builtin_amdgcn_mfma_f32_32x32x16_bf16(kf[2 * dd + 1], qr[2 * g_ + dd], p1, 0, 0, 0); }                    \
            SBAR(); }                                                                                                           \
        const int kb_ = (t) * 64;                                                                                               \
        if (kb_ + 63 > qlo) { const float NEG = -__builtin_inff();                                                              \
            _Pragma("unroll") for (int r = 0; r < 16; ++r) { const int key = kb_ + crow32(r, hi); if (key > qpos) p0[r] = NEG; if (key + 32 > qpos) p1[r] = NEG; } }   \
        float alpha; bf16x8 pa0, pa1, pa2, pa3;                                                                                 \
        softmax64(p0, p1, m_reg, l_reg, alpha, pa0, pa1, pa2, pa3);                                                             \
        if (__any(alpha < 1.f)) { if (hi == 0) al_l[r32] = alpha; LDS_WAIT();                                                    \
            _Pragma("unroll") for (int r = 0; r < 16; ++r) { const float a_ = al_l[crow32(r, hi)];                              \
                _Pragma("unroll") for (int d_ = 0; d_ < 4; ++d_) o[d_][r] *= a_; } }                                            \
        pa_pv_tile<KB>(o, vb0, pa0, pa1, pa2, pa3);                                                                             \
        VM_WAIT();                                                                                                              \
        __syncthreads(); } while (0)
    for (int t = 0; t < NT; t += 2) { PA_STEP(t, 0); PA_STEP(t + 1, 1); }
#undef PA_STEP
#undef PA_STAGE
    if (hi == 0) li_l[r32] = l_reg;
    LDS_WAIT();
    { unsigned eo = (unsigned)(4 * hi * D + r32);
      asm volatile("" : "+v"(eo));
      bf16* Ow = (bf16*)(F.ws + WS_ATT) + (size_t)row0 * D + h * 128;
#pragma unroll
      for (int r = 0; r < 16; ++r) { const int orow = crow32(r, hi); const float rl = __builtin_amdgcn_rcpf(li_l[orow]);
#pragma unroll
        for (int d0 = 0; d0 < 4; ++d0) { const float v = o[d0][r] * rl; const float vn = __shfl_xor(v, 1);
            if ((r32 & 1) == 0) *(unsigned*)(Ow + eo + ((r & 3) + 8 * (r >> 2)) * D + d0 * 32) = cvtpk(v, vn); } } }
    __syncthreads();
}
constexpr int DA_Q = 0, DA_IMG = 40960, DA_K = DA_IMG, DA_SCR = 3 * DA_IMG, DA_L1 = 16384, DA_R = 32768;
#define DA_BAR() do { asm volatile("s_waitcnt lgkmcnt(0)" ::: "memory"); __builtin_amdgcn_s_barrier(); asm volatile("" ::: "memory"); } while (0)
__device__ __forceinline__ void attn_decode_unit(Frame& F, int sb, int sp) {
    unsigned z_ = 0u; asm volatile("" : "+v"(z_)); const int lane = (int)__builtin_amdgcn_mbcnt_hi(~0u, __builtin_amdgcn_mbcnt_lo(~0u, z_));
    const int wid = F.wave, tid = wid * 64 + lane, r32 = lane & 31, hi = lane >> 5;
    LAS unsigned char* L = F.lds;
    const int* pt = F.page_table + sb * NPAGES + sp * 32;
    constexpr int NT = 64;
    { const bf16* ql = (const bf16*)(F.ws + WS_QL) + (size_t)sb * 64 * 320;
#pragma unroll
      for (int i = 0; i < 5; ++i) { const int id = tid + 512 * i, row = id / 40, ch = id - row * 40; const bf16x8 v = *(const bf16x8*)(ql + (size_t)row * 320 + ch * 8);
          const unsigned o_ = ch < 16 ? off_b(row, ch) : (ch < 32 ? DA_L1 + off_b(row, ch - 16) : DA_R + off_r(row, ch - 32));
          *(LAS bf16x8*)(L + DA_Q + o_) = v; } }
    __syncthreads();
    if (wid >= 4) {
        const unsigned lt = (unsigned)((wid - 4) * 64 + lane);
        const int ptv = pt[lane & 31];
        f32x4 cA[16], rA[4], cB[16], rB[4];
        const unsigned cvo = (lt >> 6) * 1024u + (lt & 63) * 16u, rvo = (lt >> 4) * 256u + (lt & 15) * 16u;
        unsigned wlo[4];
        { const unsigned c4 = lt & 63, row0 = lt >> 6, ch = (c4 & 31) >> 1;
#pragma unroll
          for (int v = 0; v < 4; ++v) wlo[v] = (c4 >> 5) * DA_L1 + 256u * row0 + 16u * (ch ^ (((row0 & 3) << 2) | (((row0 >> 2) + v) & 3))) + 8u * (c4 & 1); }
        const unsigned wro = DA_R + off_r(lt >> 4, (lt & 15) >> 1) + 8u * (lt & 1);
#define DA_LOAD(t, c_, r_) do { const size_t prow = (size_t)__builtin_amdgcn_readlane(ptv, (t) >> 1) * PAGE + ((t) & 1) * 64;     \
        const char* cb_ = (const char*)F.cache_ckv + prow * (KVL * 4); const char* rb_ = (const char*)F.cache_kr + prow * (ROPE * 4);   \
        _Pragma("unroll") for (int i = 0; i < 16; ++i) c_[i] = __builtin_nontemporal_load((const f32x4*)(cb_ + 4096 * i + cvo));     \
        _Pragma("unroll") for (int i = 0; i < 4; ++i) r_[i] = __builtin_nontemporal_load((const f32x4*)(rb_ + 4096 * i + rvo)); } while (0)
#define DA_WRITE(bf, c_, r_) do { LAS unsigned char* Kb = L + DA_K + (bf) * DA_IMG;                                             \
        _Pragma("unroll") for (int i = 0; i < 16; ++i) { v2u w; w.x = cvtpk(c_[i][0], c_[i][1]); w.y = cvtpk(c_[i][2], c_[i][3]); *(LAS v2u*)(Kb + wlo[i & 3] + 1024 * i) = w; }   \
        _Pragma("unroll") for (int i = 0; i < 4; ++i) { v2u w; w.x = cvtpk(r_[i][0], r_[i][1]); w.y = cvtpk(r_[i][2], r_[i][3]); *(LAS v2u*)(Kb + wro + 2048 * i) = w; } } while (0)
        DA_LOAD(0, cA, rA); DA_LOAD(1, cB, rB);
        for (int t = 0; t < NT; t += 2) {
            DA_WRITE(0, cA, rA);
            DA_LOAD(t + 2 < NT ? t + 2 : NT - 1, cA, rA);
            DA_BAR();
            DA_WRITE(1, cB, rB);
            DA_LOAD(t + 3 < NT ? t + 3 : NT - 1, cB, rB);
            DA_BAR();
        }
#undef DA_LOAD
#undef DA_WRITE
        if (sp == 1) {
            LAS unsigned char* Kb = L + DA_K; const bf16* kn = (const bf16*)(F.ws + WS_KNEW) + (size_t)sb * DSEQ * 320;
#pragma unroll
            for (int i = 0; i < 10; ++i) { const int id = lt + 256 * i, row = id / 40, ch = id - row * 40; bf16x8 v = {0, 0, 0, 0, 0, 0, 0, 0};
                if (row < DSEQ) v = *(const bf16x8*)(kn + (size_t)row * 320 + ch * 8);
                const unsigned o_ = ch < 16 ? off_b(row, ch) : (ch < 32 ? DA_L1 + off_b(row, ch - 16) : DA_R + off_r(row, ch - 32));
                *(LAS bf16x8*)(Kb + o_) = v; }
            DA_BAR();
        }
    } else {
        const int kh = wid & 1, qh = wid >> 1;
        LAS float* al_l = (LAS float*)(L + DA_SCR + wid * 256);
        const unsigned krow = 32 * kh + r32, qrow = 32 * qh + r32;
        float m_reg = -1e30f, l_reg = 0.f; f32x16 o[8];
#pragma unroll
        for (int d = 0; d < 8; ++d)
#pragma unroll
            for (int r = 0; r < 16; ++r) o[d][r] = 0.f;
#define DA_KADDR(s) ((s) < 16 ? ((s) >> 3) * DA_L1 + 256u * kr_ + 16u * ((2 * ((s) & 7) + hi) ^ xk) : DA_R + 128u * kr_ + 16u * ((2 * ((s) - 16) + hi) ^ fk))
#define DA_QADDR(s) ((s) < 16 ? ((s) >> 3) * DA_L1 + 256u * qr_ + 16u * ((2 * ((s) & 7) + hi) ^ xq) : DA_R + 128u * qr_ + 16u * ((2 * ((s) - 16) + hi) ^ fq))
#define DA_LDG(g, sl) do { kf[sl][0] = ld_lds8(Kb + DA_KADDR(2 * (g))); qf[sl][0] = ld_lds8(Qb + DA_QADDR(2 * (g))); kf[sl][1] = ld_lds8(Kb + DA_KADDR(2 * (g) + 1)); qf[sl][1] = ld_lds8(Qb + DA_QADDR(2 * (g) + 1)); } while (0)
#define DA_LDV(c, sl) do { LAS unsigned char* Vb_ = Kb + ((c) >> 2) * DA_L1;                                                     \
            va[sl][0] = tr_rd(Vb_ + tr_addr(ln_, 32 * kh, (c) & 3, 0, 0)); va[sl][1] = tr_rd(Vb_ + tr_addr(ln_, 32 * kh, (c) & 3, 0, 1));   \
            va[sl][2] = tr_rd(Vb_ + tr_addr(ln_, 32 * kh, (c) & 3, 1, 0)); va[sl][3] = tr_rd(Vb_ + tr_addr(ln_, 32 * kh, (c) & 3, 1, 1)); } while (0)
#define DA_COMPUTE(bf, MASKNEW) do { LAS unsigned char* Kb = L + DA_K + (bf) * DA_IMG; LAS unsigned char* Qb = L + DA_Q;         \
        unsigned kr_ = krow, qr_ = qrow, ln_ = lane; asm volatile("" : "+v"(kr_), "+v"(qr_), "+v"(ln_));     \
        const unsigned xk = ((kr_ & 3) << 2) | ((kr_ >> 2) & 3), xq = ((qr_ & 3) << 2) | ((qr_ >> 2) & 3), fk = (kr_ >> 1) & 7, fq = (qr_ >> 1) & 7;   \
        f32x16 p0;                                                                                                              \
        _Pragma("unroll") for (int r = 0; r < 16; ++r) p0[r] = 0.f;                                                             \
        { bf16x8 kf[2][2], qf[2][2];                           \
          DA_LDG(0, 0);                                                                                                         \
          _Pragma("unroll") for (int g_ = 0; g_ < 10; ++g_) {                                                                   \
            if (g_ + 1 < 10) DA_LDG(g_ + 1, (g_ + 1) & 1);                                                                      \
            SBAR();                                                                                                             \
            p0 = __builtin_amdgcn_mfma_f32_32x32x16_bf16(kf[g_ & 1][0], qf[g_ & 1][0], p0, 0, 0, 0);                             \
            p0 = __builtin_amdgcn_mfma_f32_32x32x16_bf16(kf[g_ & 1][1], qf[g_ & 1][1], p0, 0, 0, 0);                             \
            SBAR(); } }                                                                                                         \
        if (MASKNEW) { const float NEG = -__builtin_inff(); const int tq = (int)qrow >> 3;                                      \
            _Pragma("unroll") for (int r = 0; r < 16; ++r) { const int kk = crow32(r, hi); if (kk > tq) p0[r] = NEG; } }         \
        float alpha; bf16x8 pa0, pa1;                                                                                           \
        softmax32(p0, m_reg, l_reg, alpha, pa0, pa1);                                                                           \
        if (__any(alpha < 1.f)) { if (hi == 0) al_l[r32] = alpha; LDS_WAIT();                                                    \
            _Pragma("unroll") for (int r = 0; r < 16; ++r) { const float a_ = al_l[crow32(r, hi)];                              \
                _Pragma("unroll") for (int d_ = 0; d_ < 8; ++d_) o[d_][r] *= a_; } }                                            \
        { s16x4 va[2][4];                                                             \
          DA_LDV(0, 0);                                                                                                         \
          _Pragma("unroll") for (int c = 0; c < 8; ++c) {                                                                       \
            if (c + 1 < 8) DA_LDV(c + 1, (c + 1) & 1);                                                                          \
            SBAR();                                                                                                             \
            o[c] = __builtin_amdgcn_mfma_f32_32x32x16_bf16(pa0, (bf16x8){va[c & 1][0][0], va[c & 1][0][1], va[c & 1][0][2], va[c & 1][0][3], va[c & 1][1][0], va[c & 1][1][1], va[c & 1][1][2], va[c & 1][1][3]}, o[c], 0, 0, 0);   \
            o[c] = __builtin_amdgcn_mfma_f32_32x32x16_bf16(pa1, (bf16x8){va[c & 1][2][0], va[c & 1][2][1], va[c & 1][2][2], va[c & 1][2][3], va[c & 1][3][0], va[c & 1][3][1], va[c & 1][3][2], va[c & 1][3][3]}, o[c], 0, 0, 0);   \
            SBAR(); } } } while (0)
        for (int t = 0; t < NT; t += 2) {
            DA_BAR(); DA_COMPUTE(0, false);
            DA_BAR(); DA_COMPUTE(1, false);
        }
        if (sp == 1) { DA_BAR(); if (kh == 0) { DA_COMPUTE(0, true); } }
#undef DA_COMPUTE
#undef DA_LDG
#undef DA_LDV
#undef DA_KADDR
#undef DA_QADDR
        { unsigned l2 = (unsigned)lane; asm volatile("" : "+v"(l2));
          const unsigned e_r32 = l2 & 31, e_hi = l2 >> 5; const int pi = 2 * sp + kh;
          float* po = (float*)(F.ws + WS_PART) + ((size_t)(sb * 4 + pi) * 64 + 32 * qh) * 256;
          const unsigned eo = 4 * e_hi * 256 + e_r32;
#pragma unroll
          for (int r = 0; r < 16; ++r) {
#pragma unroll
            for (int c = 0; c < 8; ++c) po[eo + ((r & 3) + 8 * (r >> 2)) * 256 + 32 * c] = o[c][r]; }
          if (e_hi == 0) { float* ml = (float*)(F.ws + WS_ML) + ((size_t)(sb * 4 + pi) * 64 + 32 * qh + e_r32) * 2; ml[0] = m_reg; ml[1] = l_reg; } }
    }
    __syncthreads();
}
__device__ __forceinline__ void decode_combine_row(Frame& F, int row) {
    const int sb = row >> 6, q = row & 63, l = F.lane;
    const float* ml = (const float*)(F.ws + WS_ML); const float* po = (const float*)(F.ws + WS_PART);
    float mm[4], ll[4], M_ = -1e30f;
#pragma unroll
    for (int p = 0; p < 4; ++p) { const f32x2 v = *(const f32x2*)(ml + ((size_t)(sb * 4 + p) * 64 + q) * 2); mm[p] = v.x; ll[p] = v.y; M_ = fmaxf(M_, v.x); }
    float Lsum = 0.f; f32x4 acc = {0.f, 0.f, 0.f, 0.f};
#pragma unroll
    for (int p = 0; p < 4; ++p) { const float w = exp2f(mm[p] - M_); Lsum += w * ll[p]; acc = acc + *((const f32x4*)(po + ((size_t)(sb * 4 + p) * 64 + q) * 256) + l) * w; }
    store4bf((bf16*)(F.ws + WS_OLAT) + (size_t)row * 256 + 4 * l, acc * (1.f / Lsum));
}

struct Args { const void* in[22]; float* out; unsigned char* ws; int ph_lo, ph_hi; };
__global__ void __launch_bounds__(NWAVES * 64, 2) mk_fwd(Args args) {
    extern __shared__ __attribute__((aligned(16))) unsigned char lds[];
    Frame F;
    F.lds = (LAS unsigned char*)lds;
    F.MISC = (volatile LAS unsigned*)(F.lds + MISC_OFF);
    F.tid = threadIdx.x; F.lane = F.tid & 63; F.wave = __builtin_amdgcn_readfirstlane(F.tid >> 6);
    F.G = gridDim.x; F.gw = blockIdx.x * NWAVES + F.wave; F.NGW = F.G * NWAVES;
    F.ws = args.ws; F.out = args.out; F.ctl = (gu32*)(args.ws + WS_CTL);
    F.x_p = (const float*)args.in[0]; F.x_s = (const float*)args.in[1]; F.cache_ckv = (const float*)args.in[2]; F.cache_kr = (const float*)args.in[3]; F.state_conv = (const float*)args.in[4];
    F.page_table = (const int*)args.in[5]; F.c_p = (const float*)args.in[6]; F.c_s = (const float*)args.in[7]; F.w_ada = (const float*)args.in[8]; F.b_ada = (const float*)args.in[9];
    F.g_attn = (const float*)args.in[10]; F.w_in = (const float*)args.in[11]; F.g_q = (const float*)args.in[12]; F.w_q_b = (const float*)args.in[13]; F.g_kv = (const float*)args.in[14];
    F.w_kv_b = (const float*)args.in[15]; F.conv_w = (const float*)args.in[16]; F.w_o = (const float*)args.in[17]; F.g_mlp = (const float*)args.in[18]; F.w_1 = (const float*)args.in[19];
    F.w_2 = (const float*)args.in[20]; F.g_final = (const float*)args.in[21];
    for (int u = F.tid; u < (LDS_BYTES - LDSCTL_OFF) / 4; u += NWAVES * 64) ((LAS unsigned*)(F.lds + LDSCTL_OFF))[u] = 0u;
    __syncthreads();
    XcdBarrier bar; bar.bar = (unsigned*)(F.ctl + CW_BAR); bar.x = 0; bar.st = nullptr;
    if (!MK_PER_PHASE) bar = xcd_barrier_post((unsigned*)(F.ctl + CW_BAR), F.MISC + 8);
#define GRID_BAR() do { if (MK_PER_PHASE) { if (F.tid == 0) __hip_atomic_store(F.ctl + CW_TMO, 0xBADBA0u, RLX_AGENT); } else { xcd_barrier(bar); } } while (0)
    const int lo = args.ph_lo, hi = args.ph_hi;
#ifndef PH_MASK
#define PH_MASK 0xFFFFFFFFu
#endif
#define IN(k) (((PH_MASK >> (k)) & 1u) && lo <= (k) && (k) < hi)
#define BOTH(k) (IN(k) && IN((k) + 1))
#define RELANE() do { unsigned z_ = 0u; asm volatile("" : "+v"(z_)); int l_ = (int)__builtin_amdgcn_mbcnt_hi(~0u, __builtin_amdgcn_mbcnt_lo(~0u, z_)); F.lane = l_; F.tid = F.wave * 64 + l_; } while (0)
    const pg8::bf16_t* U = (const pg8::bf16_t*)(F.ws + WS_U);
    float* mod = (float*)(F.ws + WS_MOD);

    if (IN(0)) { RELANE(); p0_prologue(F); if (BOTH(0)) GRID_BAR(); }
    if (IN(1)) { RELANE();
        for (int m = F.gw; m < M; m += F.NGW) { const float* mr = mod + (size_t)seq_of_row(m) * (6 * D);
            norm_mod_row(F, m < MP ? F.x_p + (size_t)m * D : F.x_s + (size_t)(m - MP) * D, F.g_attn, mr + D, mr, (bf16*)(F.ws + WS_U) + (size_t)m * D); }
        if (BOTH(1)) GRID_BAR();
    }
    if (IN(2)) { RELANE();
        pg8::Gemm g{U, (const pg8::bf16_t*)(F.ws + WS_WIN), M, NIN, D, D, D, 0, 0, 0x7fffffff, 0}; pg8::StaticOrder S; S.init(M, NIN, F.G, (int)blockIdx.x);
        Epi<1> E{F.ws, F.x_p, F.x_s, F.out};
        pg8::gemm_phase<Epi<1>, pg8::StaticOrder, true, true>(F.lds + RING_OFF, g, S, E);
        if (BOTH(2)) GRID_BAR();
    }
    if (IN(3)) { RELANE(); for (int m = F.gw; m < M; m += F.NGW) small_row(F, m); if (BOTH(3)) GRID_BAR(); }
    if (IN(4)) { RELANE();
        { pg8::Gemm g{(const pg8::bf16_t*)(F.ws + WS_QA), (const pg8::bf16_t*)(F.ws + WS_WQB), M, NQ, QLORA, QLORA, QLORA, 0, 0, 0x7fffffff, 0}; pg8::StaticOrder S; S.init(M, NQ, F.G, (int)blockIdx.x);
          Epi<2> E{F.ws, F.x_p, F.x_s, F.out};
          pg8::gemm_phase<Epi<2>, pg8::StaticOrder, true, true>(F.lds + RING_OFF, g, S, E); }
        __syncthreads();
        { pg8::Gemm g{(const pg8::bf16_t*)(F.ws + WS_CKVN), (const pg8::bf16_t*)(F.ws + WS_WKVB), MP, 2048, KVL, KVL, KVL, 0, 0, 0x7fffffff, 0}; pg8::StaticOrder S; S.init(MP, 2048, F.G, (int)blockIdx.x);
          Epi<3> E{F.ws, F.x_p, F.x_s, F.out};
          pg8::gemm_phase<Epi<3>, pg8::StaticOrder, true, true>(F.lds + RING_OFF, g, S, E); }
        if (BOTH(4)) GRID_BAR();
    }
    if (IN(5)) { RELANE();
        pg8::Gemm g{(const pg8::bf16_t*)(F.ws + WS_QB) + (size_t)MP * NQ, (const pg8::bf16_t*)(F.ws + WS_WUK), MS, 2048, 256, NQ, 256, 128 * 2, 0, 0x7fffffff, 0}; pg8::StaticOrder S; S.init(MS, 2048, F.G, (int)blockIdx.x);
        Epi<4> E{F.ws, F.x_p, F.x_s, F.out};
        pg8::gemm_phase<Epi<4>, pg8::StaticOrder, true, true>(F.lds + RING_OFF, g, S, E);
        if (BOTH(5)) GRID_BAR();
    }
    if (IN(6)) { RELANE();
        const bool dec_first = ((blockIdx.x >> 3) & 1) != 0;
        if (dec_first) { for (int du = blockIdx.x; du < 2 * DB; du += F.G) attn_decode_unit(F, du >> 1, du & 1); }
        for (int it = blockIdx.x; it < NB * NH * 8; it += F.G) {
            const int xcd = it & 7, j = it >> 3, bh = (xcd * 4 + (j >> 3)) & 31, pr = j & 7, b = bh >> 3, h = bh & 7;
            for (int k = 0; k < 2; ++k) attn_prompt_block(F, b, h, k == 0 ? 15 - pr : pr);
        }
        if (!dec_first) { for (int du = blockIdx.x; du < 2 * DB; du += F.G) attn_decode_unit(F, du >> 1, du & 1); }
        if (BOTH(6)) GRID_BAR();
    }
    if (IN(7)) { RELANE(); for (int r = F.gw; r < MS * NH; r += F.NGW) decode_combine_row(F, r); if (BOTH(7)) GRID_BAR(); }
    if (IN(8)) { RELANE();
        pg8::Gemm g{(const pg8::bf16_t*)(F.ws + WS_OLAT), (const pg8::bf16_t*)(F.ws + WS_WKVB), MS, 2048, 256, 2048, 256, 256 * 2, 0, 0x7fffffff, 0}; pg8::StaticOrder S; S.init(MS, 2048, F.G, (int)blockIdx.x);
        Epi<5> E{F.ws, F.x_p, F.x_s, F.out};
        pg8::gemm_phase<Epi<5>, pg8::StaticOrder, true, true>(F.lds + RING_OFF, g, S, E);
        if (BOTH(8)) GRID_BAR();
    }
    if (IN(9)) { RELANE(); for (int m = F.gw; m < M; m += F.NGW) merged_row(F, m); if (BOTH(9)) GRID_BAR(); }
    if (IN(10)) { RELANE();
        { pg8::Gemm g{(const pg8::bf16_t*)(F.ws + WS_MERGED), (const pg8::bf16_t*)(F.ws + WS_WO), MP, D, D, D, D, 0, 0, 0x7fffffff, 0}; pg8::StaticOrder S; S.init(MP, D, F.G, (int)blockIdx.x);
          Epi<6> E{F.ws, F.x_p, F.x_s, F.out};
          pg8::gemm_phase<Epi<6>, pg8::StaticOrder, true, true>(F.lds + RING_OFF, g, S, E); }
        __syncthreads();
        { pg8::Gemm g{(const pg8::bf16_t*)(F.ws + WS_MERGED) + (size_t)MP * D, (const pg8::bf16_t*)(F.ws + WS_WO), MS, 4 * D, 256, D, D, 256 * 2, 2, 3, 256 * 2}; pg8::StaticOrder S; S.init(MS, 4 * D, F.G, (int)(F.G - 1 - blockIdx.x));
          Epi<9> E{F.ws, F.x_p, F.x_s, F.out};
          pg8::gemm_phase<Epi<9>, pg8::StaticOrder, true, true>(F.lds + RING_OFF, g, S, E); }
        if (BOTH(10)) GRID_BAR();
    }
    if (IN(11)) { RELANE();
        for (int m = F.gw; m < M; m += F.NGW) { const float* mr = mod + (size_t)seq_of_row(m) * (6 * D);
            if (m >= MP) sample_x1_row(F, m - MP, mr + 2 * D);
            norm_mod_row(F, (const float*)(F.ws + WS_X1) + (size_t)m * D, F.g_mlp, mr + 4 * D, mr + 3 * D, (bf16*)(F.ws + WS_U) + (size_t)m * D); }
        if (BOTH(11)) GRID_BAR();
    }
    if (IN(12)) { RELANE();
        pg8::Gemm g{U, (const pg8::bf16_t*)(F.ws + WS_W1), M, FF, D, D, D, 0, 0, 0x7fffffff, 0}; pg8::StaticOrder S; S.init(M, FF, F.G, (int)blockIdx.x);
        Epi<7> E{F.ws, F.x_p, F.x_s, F.out};
        pg8::gemm_phase<Epi<7>, pg8::StaticOrder, true, true>(F.lds + RING_OFF, g, S, E);
        if (BOTH(12)) GRID_BAR();
    }
    if (IN(13)) { RELANE();
        { pg8::Gemm g{(const pg8::bf16_t*)(F.ws + WS_HDN), (const pg8::bf16_t*)(F.ws + WS_W2), MP, D, FF, FF, FF, 0, 0, 0x7fffffff, 0}; pg8::StaticOrder S; S.init(MP, D, F.G, (int)blockIdx.x);
          Epi<8> E{F.ws, F.x_p, F.x_s, F.out};
          pg8::gemm_phase<Epi<8>, pg8::StaticOrder, true, true>(F.lds + RING_OFF, g, S, E); }
        __syncthreads();
        { pg8::Gemm g{(const pg8::bf16_t*)(F.ws + WS_HDN) + (size_t)MP * FF, (const pg8::bf16_t*)(F.ws + WS_W2), MS, 8 * D, 512, FF, FF, 512 * 2, 2, 3, 512 * 2}; pg8::StaticOrder S; S.init(MS, 8 * D, F.G, (int)(F.G - 1 - blockIdx.x));
          Epi<10> E{F.ws, F.x_p, F.x_s, F.out};
          pg8::gemm_phase<Epi<10>, pg8::StaticOrder, true, true>(F.lds + RING_OFF, g, S, E); }
        if (BOTH(13)) GRID_BAR();
    }
    if (IN(14)) { RELANE(); for (int m = F.gw; m < M; m += F.NGW) final_row(F, m); }
#undef IN
#undef BOTH
}

extern "C" void kernel_launch(void* const* d_in, const int* in_sizes, int n_in, void* d_out, int out_size, void* d_ws, size_t ws_size, hipStream_t stream) {
    static int grid = 0;
    if (grid == 0) {
        if (n_in != 22 || out_size != (int)O_END || ws_size < WS_END) { fprintf(stderr, "kernel_launch: unexpected shapes (n_in %d, out %d, ws %zu); nothing launched\n", n_in, out_size, ws_size); grid = -1; return; }
        int dev = 0, cus = 0, per_cu = 0;
        if (hipGetDevice(&dev) != hipSuccess || hipDeviceGetAttribute(&cus, hipDeviceAttributeMultiprocessorCount, dev) != hipSuccess) { grid = -1; return; }
        if (hipFuncSetAttribute((const void*)mk_fwd, hipFuncAttributeMaxDynamicSharedMemorySize, LDS_BYTES) != hipSuccess) { fprintf(stderr, "kernel_launch: hipFuncSetAttribute failed\n"); grid = -1; return; }
        if (hipOccupancyMaxActiveBlocksPerMultiprocessor(&per_cu, (const void*)mk_fwd, NWAVES * 64, LDS_BYTES) != hipSuccess || per_cu < 1) fprintf(stderr, "kernel_launch: note: occupancy query says %d\n", per_cu);
        (void)hipGetLastError();
        grid = cus;
    }
    if (grid < 0) return;
    if (hipMemsetAsync((char*)d_ws + WS_CTL, 0, CTL_ZERO_BYTES, stream) != hipSuccess) return;
    Args a{};
    for (int i = 0; i < 22; ++i) a.in[i] = d_in[i];
    a.out = (float*)d_out; a.ws = (unsigned char*)d_ws;
#if MK_PER_PHASE
    for (int p = 0; p < N_PHASES; ++p) { a.ph_lo = p; a.ph_hi = p + 1; hipLaunchKernelGGL(mk_fwd, dim3(grid), dim3(NWAVES * 64), LDS_BYTES, stream, a); }
#else
    a.ph_lo = 0; a.ph_hi = N_PHASES; hipLaunchKernelGGL(mk_fwd, dim3(grid), dim3(NWAVES * 64), LDS_BYTES, stream, a);
#endif
}
```

```cpp
#include <hip/hip_runtime.h>
#include <cstdio>
#include <cstdint>
namespace pg8 {
#define PG8_LAS __attribute__((address_space(3)))
typedef unsigned short bf16_t;
typedef short bf16x8 __attribute__((ext_vector_type(8)));
typedef float f32x4 __attribute__((ext_vector_type(4)));
typedef unsigned u32x4 __attribute__((ext_vector_type(4)));
typedef unsigned u32x2 __attribute__((ext_vector_type(2)));
constexpr int BM = 256, BK = 64, HALF = 128, HTB = HALF * BK * 2  , STAGE_BYTES = 8 * HTB, NXCD = 8, WGM = 8;

__host__ __device__ __forceinline__ int lds_byte(int r, int c) { const int st = (r >> 4) * 2 + (c >> 5), rr = r & 15, cc = c & 31, ob = rr * 64 + cc * 2; return st * 1024 + (ob ^ (((ob >> 9) & 1) << 5)); }
__host__ __device__ __forceinline__ void stage_rc(int b, int& R, int& C) { const int st = b / 1024, sb = b % 1024, swz = sb ^ (((sb >> 9) & 1) << 5); R = (st >> 1) * 16 + swz / 64; C = (st & 1) * 32 + (swz % 64) / 2; }
__host__ __device__ __forceinline__ int perm32(int rho) { const int n = rho >> 4, i = rho & 15; return 8 * (i >> 2) + 4 * n + (i & 3); }

struct Unit { int pm, pn; };
struct Gemm { const bf16_t* A; const bf16_t* Bt; int M, N, K, lda, ldb, aoffn, pn_shift, pn_mask, boffk; };

struct StaticOrder {
    int nM, nN, nwg, G, c;
    __host__ __device__ void init(int M, int N, int G_, int c_) { nM = M / BM; nN = N / BM; nwg = nM * nN; G = G_; c = c_; }
    __host__ __device__ bool next(int i, Unit& u) const {
        const long L = (long)i * G + c; if (L >= nwg) return false;
        int wgid = (int)L; { const int q = nwg / NXCD, r = nwg % NXCD, xcd = wgid % NXCD, off = wgid / NXCD; wgid = (xcd < r ? xcd * (q + 1) : r * (q + 1) + (xcd - r) * q) + off; }
        const int nig = WGM * nN, gid = wgid / nig, fm = gid * WGM, gsz = (nM - fm) < WGM ? (nM - fm) : WGM;
        u.pm = fm + ((wgid % nig) % gsz); u.pn = (wgid % nig) / gsz; return true;
    }
    __device__ __forceinline__ void a_ready(const Unit&) const {}
    __device__ __forceinline__ void done(const Unit&) const {}
};
__device__ __forceinline__ unsigned cvt_pk_bf16(float lo, float hi) { unsigned r; asm volatile("v_cvt_pk_bf16_f32 %0, %1, %2" : "=v"(r) : "v"(lo), "v"(hi)); return r; }
template <class Epi, class Sched, bool ALIGN_EPI = false, bool SP2 = false>
__device__ __forceinline__ void gemm_phase(PG8_LAS unsigned char* lds, const Gemm g, const Sched& S, const Epi& E) {
    const int tid = threadIdx.x, wid = __builtin_amdgcn_readfirstlane(tid >> 6), lane = tid & 63, wr = wid >> 2, wc = wid & 3, fr = lane & 15, fq = lane >> 4;
    const int K = g.K, nt = K / BK;
    unsigned voffA[2], voffB[2];
#pragma unroll
    for (int i = 0; i < 2; ++i) { int R, C; stage_rc(tid * 16 + i * 8192, R, C); const int Rb = Epi::PERM ? ((R & ~31) + perm32(R & 31)) : R;
        voffA[i] = (unsigned)(R * g.lda + C) * 2u; voffB[i] = (unsigned)(Rb * g.ldb + C) * 2u; }
    const size_t kstep = (size_t)(BK * 2);
    const size_t hsA = (size_t)HALF * g.lda * 2, hsB = (size_t)HALF * g.ldb * 2;
    const size_t tsA = 2 * hsA, tsB = 2 * hsB;
    const unsigned ldsw = (unsigned)wid * 1024u;
    const int aoff = lds_byte(wr * 64 + fr, fq * 8), boff = lds_byte(wc * 32 + fr, fq * 8);
#define PG8_SA(b, h) (((b) * 2 + (h)) * HTB)
#define PG8_SB(b, h) ((4 + (b) * 2 + (h)) * HTB)
#define PG8_STAGE(bufoff, gbase, voff) do { _Pragma("unroll") for (int _i = 0; _i < 2; ++_i) \
        __builtin_amdgcn_global_load_lds((const unsigned*)((const char*)(gbase) + (voff)[_i]), (PG8_LAS unsigned*)(lds + (bufoff) + ldsw + _i * 8192), 16, 0, 0); } while (0)
#define PG8_LDA(dst, b, h) do { _Pragma("unroll") for (int m = 0; m < 4; ++m) _Pragma("unroll") for (int k = 0; k < 2; ++k) dst[m][k] = *(const PG8_LAS bf16x8*)(lds + PG8_SA(b, h) + aoff + m * 2048 + k * 1024); } while (0)
#define PG8_LDB(dst, b, h) do { _Pragma("unroll") for (int n = 0; n < 2; ++n) _Pragma("unroll") for (int k = 0; k < 2; ++k) dst[n][k] = *(const PG8_LAS bf16x8*)(lds + PG8_SB(b, h) + boff + n * 2048 + k * 1024); } while (0)
#define PG8_MMA(ai, bj, At, Bt) do { __builtin_amdgcn_s_setprio(1); _Pragma("unroll") for (int m = 0; m < 4; ++m) _Pragma("unroll") for (int n = 0; n < 2; ++n) _Pragma("unroll") for (int k = 0; k < 2; ++k) \
        acc[ai][bj][m][n] = __builtin_amdgcn_mfma_f32_16x16x32_bf16(Bt[n][k], At[m][k], acc[ai][bj][m][n], 0, 0, 0); __builtin_amdgcn_s_setprio(0); } while (0)
#define PG8_WAIT_V(n) asm volatile("s_waitcnt vmcnt(" #n ")" ::: "memory")
#define PG8_WAIT_L(n) asm volatile("s_waitcnt lgkmcnt(" #n ")" ::: "memory")
#define PG8_BAR __builtin_amdgcn_s_barrier()
#define PG8_SCHED __builtin_amdgcn_sched_barrier(0)
    Unit cur, nxt; int ui = 0;
    if (!S.next(0, cur)) return;
    f32x4 acc[2][2][4][2];
#pragma unroll
    for (int a = 0; a < 2; ++a)
#pragma unroll
        for (int b = 0; b < 2; ++b)
#pragma unroll
            for (int m = 0; m < 4; ++m)
#pragma unroll
                for (int n = 0; n < 2; ++n) acc[a][b][m][n] = (f32x4){0.f, 0.f, 0.f, 0.f};
    bf16x8 At[4][2], B0[2][2], B1[2][2];
    const char* cA = (const char*)g.A + (size_t)cur.pm * tsA + (size_t)(cur.pn >> g.pn_shift) * g.aoffn; const char* cB = (const char*)g.Bt + (size_t)(cur.pn & g.pn_mask) * tsB + (size_t)(cur.pn >> g.pn_shift) * g.boffk;
    S.a_ready(cur);
    if constexpr (SP2) {
        PG8_STAGE(PG8_SB(0, 0), cB, voffB); PG8_STAGE(PG8_SB(0, 1), cB + hsB, voffB); PG8_STAGE(PG8_SA(0, 0), cA, voffA); PG8_STAGE(PG8_SA(0, 1), cA + hsA, voffA);
        if (wr == 1) PG8_BAR;
        PG8_WAIT_V(2); PG8_BAR;
        PG8_STAGE(PG8_SB(1, 0), cB + kstep, voffB); PG8_STAGE(PG8_SA(1, 0), cA + kstep, voffA); PG8_STAGE(PG8_SB(1, 1), cB + hsB + kstep, voffB);
        PG8_WAIT_V(6); PG8_BAR;
    } else {
        PG8_STAGE(PG8_SB(0, 0), cB, voffB); PG8_STAGE(PG8_SA(0, 0), cA, voffA); PG8_STAGE(PG8_SB(0, 1), cB + hsB, voffB); PG8_STAGE(PG8_SA(0, 1), cA + hsA, voffA);
        if (wr == 1) PG8_BAR;
        PG8_WAIT_V(4); PG8_BAR;
        PG8_STAGE(PG8_SB(1, 0), cB + kstep, voffB); PG8_STAGE(PG8_SA(1, 0), cA + kstep, voffA); PG8_STAGE(PG8_SB(1, 1), cB + hsB + kstep, voffB);
        PG8_WAIT_V(6); PG8_BAR;
    }
    for (;;) {
        const bool has_next = S.next(ui + 1, nxt);
        const char* nA = has_next ? (const char*)g.A + (size_t)nxt.pm * tsA + (size_t)(nxt.pn >> g.pn_shift) * g.aoffn : cA; const char* nB = has_next ? (const char*)g.Bt + (size_t)(nxt.pn & g.pn_mask) * tsB + (size_t)(nxt.pn >> g.pn_shift) * g.boffk : cB;
#pragma nounroll
        for (int t = 0; t < nt; t += 2) {
            const bool last = (t == nt - 2);
            const char* a1 = cA + (size_t)(t + 1) * kstep;
            const char* a2 = last ? nA : cA + (size_t)(t + 2) * kstep; const char* b2 = last ? nB : cB + (size_t)(t + 2) * kstep;
            const char* a3 = a2 + kstep; const char* b3 = b2 + kstep;
            if (last && has_next) S.a_ready(nxt);
            if constexpr (SP2) {
            PG8_LDB(B0, 0, 0); PG8_LDB(B1, 0, 1); PG8_SCHED; PG8_LDA(At, 0, 0); PG8_STAGE(PG8_SA(1, 1), a1 + hsA, voffA);
            PG8_WAIT_V(8); PG8_WAIT_L(0); PG8_BAR; PG8_MMA(0, 0, At, B0); PG8_MMA(0, 1, At, B1); PG8_BAR; PG8_SCHED;
            PG8_LDA(At, 0, 1); PG8_STAGE(PG8_SB(0, 0), b2, voffB); PG8_STAGE(PG8_SB(0, 1), b2 + hsB, voffB); PG8_STAGE(PG8_SA(0, 0), a2, voffA);
            PG8_WAIT_V(8); PG8_WAIT_L(0); PG8_BAR; PG8_MMA(1, 0, At, B0); PG8_MMA(1, 1, At, B1); PG8_BAR; PG8_SCHED;
            PG8_LDB(B0, 1, 0); PG8_LDB(B1, 1, 1); PG8_SCHED; PG8_LDA(At, 1, 0); PG8_STAGE(PG8_SA(0, 1), a2 + hsA, voffA);
            PG8_WAIT_V(8); PG8_WAIT_L(0); PG8_BAR; PG8_MMA(0, 0, At, B0); PG8_MMA(0, 1, At, B1); PG8_BAR; PG8_SCHED;
            PG8_LDA(At, 1, 1); PG8_STAGE(PG8_SB(1, 0), b3, voffB); PG8_STAGE(PG8_SB(1, 1), b3 + hsB, voffB); PG8_STAGE(PG8_SA(1, 0), a3, voffA);
            PG8_WAIT_V(8); PG8_WAIT_L(0); PG8_BAR; PG8_MMA(1, 0, At, B0); PG8_MMA(1, 1, At, B1); PG8_BAR; PG8_SCHED;
            } else {
            PG8_LDB(B0, 0, 0); PG8_SCHED; PG8_LDA(At, 0, 0); PG8_STAGE(PG8_SA(1, 1), a1 + hsA, voffA);
            PG8_WAIT_L(8); PG8_BAR; PG8_WAIT_L(0); PG8_MMA(0, 0, At, B0); PG8_BAR; PG8_SCHED;
            PG8_LDB(B1, 0, 1); PG8_STAGE(PG8_SB(0, 0), b2, voffB);
            PG8_BAR; PG8_WAIT_L(0); PG8_MMA(0, 1, At, B1); PG8_BAR;
            PG8_LDA(At, 0, 1); PG8_STAGE(PG8_SA(0, 0), a2, voffA);
            PG8_BAR; PG8_WAIT_L(0); PG8_MMA(1, 0, At, B0); PG8_BAR; PG8_SCHED;
            PG8_STAGE(PG8_SB(0, 1), b2 + hsB, voffB);
            PG8_WAIT_V(6); PG8_BAR; PG8_MMA(1, 1, At, B1); PG8_BAR;
            PG8_LDB(B0, 1, 0); PG8_SCHED; PG8_LDA(At, 1, 0); PG8_STAGE(PG8_SA(0, 1), a2 + hsA, voffA);
            PG8_WAIT_L(8); PG8_BAR; PG8_WAIT_L(0); PG8_MMA(0, 0, At, B0); PG8_BAR; PG8_SCHED;
            PG8_LDB(B1, 1, 1); PG8_STAGE(PG8_SB(1, 0), b3, voffB);
            PG8_BAR; PG8_WAIT_L(0); PG8_MMA(0, 1, At, B1); PG8_BAR;
            PG8_LDA(At, 1, 1); PG8_STAGE(PG8_SA(1, 0), a3, voffA);
            PG8_BAR; PG8_WAIT_L(0); PG8_MMA(1, 0, At, B0); PG8_BAR; PG8_SCHED;
            PG8_STAGE(PG8_SB(1, 1), b3 + hsB, voffB);
            PG8_WAIT_V(6); PG8_BAR; PG8_MMA(1, 1, At, B1); PG8_BAR;
            }
        }
        if constexpr (ALIGN_EPI) { if (wr == 0) PG8_BAR; }
        if constexpr (!Epi::AFTER_DRAIN) { E(acc, cur, wr, wc, fr, fq); S.done(cur); }
        if (!has_next) break;
#pragma unroll
        for (int a = 0; a < 2; ++a)
#pragma unroll
            for (int b = 0; b < 2; ++b)
#pragma unroll
                for (int m = 0; m < 4; ++m)
#pragma unroll
                    for (int n = 0; n < 2; ++n) acc[a][b][m][n] = (f32x4){0.f, 0.f, 0.f, 0.f};
        cur = nxt; cA = nA; cB = nB; ++ui;
        if constexpr (ALIGN_EPI) { if (wr == 1) PG8_BAR; }
    }
    PG8_WAIT_V(0);
    if constexpr (!ALIGN_EPI) { if (wr == 0) PG8_BAR; }
    PG8_BAR;
    if constexpr (Epi::AFTER_DRAIN) { E.fused(acc, cur, wr, wc, fr, fq, lds, wid, lane); S.done(cur); }
#undef PG8_SA
#undef PG8_SB
#undef PG8_STAGE
#undef PG8_LDA
#undef PG8_LDB
#undef PG8_MMA
#undef PG8_WAIT_V
#undef PG8_WAIT_L
#undef PG8_BAR
#undef PG8_SCHED
}}

constexpr int NWAVES = 8;
#ifndef MK_PER_PHASE
#define MK_PER_PHASE 0
#endif
constexpr int N_PHASES = 15;

constexpr int D = 1024, NB = 4, SEQ = 4096, DB = 128, DSEQ = 8, PAST = 8192, PAGE = 128, NPAGES = 64;
constexpr int NH = 8, QLORA = 384, KVL = 256, NOPE = 128, ROPE = 64, VD = 128, FF = 4096;
constexpr int MP = NB * SEQ, MS = DB * DSEQ, M = MP + MS;
constexpr int NSEQ = NB + DB;
constexpr int DIN = 5824, NIN = 5888;
constexpr int NSM = 768, NBIG = 3072, NQ = 1536;
constexpr int NPOS = SEQ + DSEQ;
constexpr float EPS = 1e-6f;
constexpr float QSCALE = 0.07216878364870322f * 1.4426950408889634f;

constexpr size_t MiB = 1u << 20;
constexpr size_t WS_CTL = 0, CTL_ZERO_BYTES = 1 * MiB;
constexpr size_t WS_MOD = 1 * MiB, WS_TAB = 5 * MiB, WS_WIN = 8 * MiB, WS_WQB = 20 * MiB, WS_WKVB = 22 * MiB, WS_WUK = 23 * MiB, WS_WO = 24 * MiB, WS_W1 = 26 * MiB, WS_W2 = 34 * MiB;
constexpr size_t WS_U = 42 * MiB, WS_SM = 76 * MiB, WS_BIG = 128 * MiB, WS_QA = 298 * MiB, WS_CKVN = 311 * MiB, WS_QB = 320 * MiB, WS_KP = 371 * MiB, WS_VP = 419 * MiB;
constexpr size_t WS_QL = 451 * MiB, WS_KNEW = 456 * MiB, WS_OLAT = 457 * MiB, WS_ATT = 461 * MiB, WS_MERGED = 495 * MiB, WS_X1 = 529 * MiB, WS_HDN = 597 * MiB, WS_PART = 733 * MiB, WS_ML = 766 * MiB, WS_P1 = 768 * MiB, WS_P2 = 784 * MiB, WS_END = 816 * MiB;
static_assert(WS_MOD + (size_t)NSEQ * 6 * D * 4 <= WS_TAB && WS_TAB + (size_t)NPOS * 32 * 8 <= WS_WIN && WS_WIN + (size_t)NIN * D * 2 <= WS_WQB && WS_WQB + (size_t)NQ * QLORA * 2 <= WS_WKVB, "ws map 1");
static_assert(WS_WKVB + (size_t)2048 * 256 * 2 <= WS_WUK && WS_WUK + (size_t)2048 * 256 * 2 <= WS_WO && WS_WO + (size_t)D * D * 2 <= WS_W1 && WS_W1 + (size_t)FF * D * 2 <= WS_W2 && WS_W2 + (size_t)FF * D * 2 <= WS_U, "ws map 2");
static_assert(WS_U + (size_t)M * D * 2 <= WS_SM && WS_SM + (size_t)M * NSM * 4 <= WS_BIG && WS_BIG + (size_t)M * NBIG * 2 <= WS_QA && WS_QA + (size_t)M * QLORA * 2 <= WS_CKVN && WS_CKVN + (size_t)M * KVL * 2 <= WS_QB, "ws map 3");
static_assert(WS_QB + (size_t)M * NQ * 2 <= WS_KP && WS_KP + (size_t)MP * NH * 192 * 2 <= WS_VP && WS_VP + (size_t)MP * NH * 128 * 2 <= WS_QL && WS_QL + (size_t)MS * NH * 320 * 2 <= WS_KNEW && WS_KNEW + (size_t)MS * 320 * 2 <= WS_OLAT, "ws map 4");
static_assert(WS_OLAT + (size_t)MS * NH * 256 * 2 <= WS_ATT && WS_ATT + (size_t)M * D * 2 <= WS_MERGED && WS_MERGED + (size_t)M * D * 2 <= WS_X1 && WS_X1 + (size_t)M * D * 4 <= WS_HDN && WS_HDN + (size_t)M * FF * 2 <= WS_PART, "ws map 5");
constexpr size_t O_Y = 0, O_CKVP = (size_t)M * D, O_KRP = O_CKVP + (size_t)MP * KVL, O_CVP = O_KRP + (size_t)MP * ROPE, O_CKVS = O_CVP + (size_t)NB * 2 * D, O_KRS = O_CKVS + (size_t)MS * KVL, O_CVS = O_KRS + (size_t)MS * ROPE, O_END = O_CVS + (size_t)DB * 2 * D;
static_assert(O_END == 23666688, "d_out size");
constexpr int CW_TMO = 0, CW_CODE = 1, CW_BAR = 4096;
constexpr int RING_OFF = 0, RING_BYTES = 131072;
constexpr int LDSCTL_OFF = RING_BYTES, MISC_OFF = LDSCTL_OFF + 320;
constexpr int LDS_BYTES = 147456;
static_assert(MISC_OFF + 128 <= LDS_BYTES, "LDS map");

#define GAS __attribute__((address_space(1)))
#define LAS __attribute__((address_space(3)))
typedef unsigned short bf16;
typedef unsigned v4u __attribute__((ext_vector_type(4)));
typedef unsigned v2u __attribute__((ext_vector_type(2)));
typedef float f32x4 __attribute__((ext_vector_type(4)));
typedef float f32x2 __attribute__((ext_vector_type(2)));
typedef float f32x16 __attribute__((ext_vector_type(16)));
typedef short bf16x8 __attribute__((ext_vector_type(8)));
typedef GAS unsigned gu32;
#define RLX_AGENT __ATOMIC_RELAXED, __HIP_MEMORY_SCOPE_AGENT
#define LDS_WAIT() asm volatile("s_waitcnt lgkmcnt(0)" ::: "memory")
#define VM_WAIT() asm volatile("s_waitcnt vmcnt(0)" ::: "memory")
__device__ __forceinline__ unsigned f2bf(float f) { unsigned u = __builtin_bit_cast(unsigned, f); return (u + 0x7fffu + ((u >> 16) & 1u)) >> 16; }
__device__ __forceinline__ unsigned pk2(float lo, float hi) { return f2bf(lo) | (f2bf(hi) << 16); }
__device__ __forceinline__ float bf2f(unsigned short b) { return __builtin_bit_cast(float, (unsigned)b << 16); }
__device__ __forceinline__ float bflo(unsigned w) { return __builtin_bit_cast(float, w << 16); }
__device__ __forceinline__ float bfhi(unsigned w) { return __builtin_bit_cast(float, w & 0xffff0000u); }
#define XB_TMO      128
#define XB_XCNT(j)  (256  + 64 * (j))
#define XB_XSUB(j)  (1280 + 64 * (j))
#define XB_XGEN(j)  (2304 + 64 * (j))
#define XB_TOP      3328
#define XB_TOPGEN   3392
#define XCD_BAR_WORDS 3456
#define XB_SPIN_CAP (1u << 18)

__device__ __forceinline__ unsigned xb_ld(unsigned* p)              { return __hip_atomic_load(p, __ATOMIC_RELAXED, __HIP_MEMORY_SCOPE_AGENT); }
__device__ __forceinline__ unsigned xb_add(unsigned* p, unsigned v) { return __hip_atomic_fetch_add(p, v, __ATOMIC_RELAXED, __HIP_MEMORY_SCOPE_AGENT); }
__device__ __forceinline__ unsigned xb_xcc_id() { return (unsigned)__builtin_amdgcn_s_getreg((3 << 11) | 20) & 0xFu; }
#define XB_SPIN(cond, bar) do { unsigned _sp = 0; while (cond) { __builtin_amdgcn_s_sleep(1); \
    if ((++_sp & 255u) == 0u) { if (xb_ld(&(bar)[XB_TMO])) break; if (_sp > XB_SPIN_CAP) { atomicAdd(&(bar)[XB_TMO], 1u); break; } } } } while (0)

struct XcdBarrier {
    unsigned* bar; unsigned x;
    volatile LAS unsigned* st;
};

__device__ __forceinline__ XcdBarrier xcd_barrier_post(unsigned* bar, volatile LAS unsigned* st) {
    XcdBarrier b; b.bar = bar; b.x = xb_xcc_id(); b.st = st;
    if (threadIdx.x == 0) (void)xb_add(&bar[XB_XCNT(b.x)], 1u);
    return b;
}
__device__ __forceinline__ void xcd_barrier_complete(unsigned* bar, unsigned x, unsigned& nloc, unsigned& nx) {
    const unsigned G = gridDim.x * gridDim.y * gridDim.z;
    unsigned sum, cnt, mine, sp = 0u;
    for (;;) {
        sum = 0u; cnt = 0u; mine = 0u;
#pragma unroll
        for (unsigned j = 0; j < 16; ++j) { const unsigned c = xb_ld(&bar[XB_XCNT(j)]); sum += c; cnt += (c > 0u) ? 1u : 0u; mine = (j == x) ? c : mine; }
        if (sum == G) break;
        __builtin_amdgcn_s_sleep(1);
        if ((++sp & 255u) == 0u) { if (xb_ld(&bar[XB_TMO])) break; if (sp > XB_SPIN_CAP) { atomicAdd(&bar[XB_TMO], 1u); break; } }
    }
    nloc = mine > 0u ? mine : 1u; nx = cnt > 0u ? cnt : 1u;
}

__device__ __forceinline__ void xcd_barrier(const XcdBarrier& b) {
    asm volatile("s_waitcnt vmcnt(0)" ::: "memory");
    __syncthreads();
    if (threadIdx.x == 0) {
        unsigned* bar = b.bar;
        __builtin_amdgcn_s_waitcnt(0);
        unsigned nloc = b.st[0], nx = b.st[1];
        if (nloc == 0u) { xcd_barrier_complete(bar, b.x, nloc, nx); b.st[0] = nloc; b.st[1] = nx; }
        const unsigned old = xb_add(&bar[XB_XSUB(b.x)], 1u);
        const unsigned gen = old / nloc;
        if (old + 1u == (gen + 1u) * nloc) {
            __builtin_amdgcn_fence(__ATOMIC_RELEASE, "agent");
            asm volatile("s_waitcnt vmcnt(0)" ::: "memory");
            const unsigned og = xb_add(&bar[XB_TOP], 1u);
            const unsigned tg = og / nx;
            if (og + 1u == (tg + 1u) * nx) xb_add(&bar[XB_TOPGEN], 1u);
            else XB_SPIN(xb_ld(&bar[XB_TOPGEN]) == tg, bar);
            __builtin_amdgcn_fence(__ATOMIC_ACQUIRE, "agent");
            xb_add(&bar[XB_XGEN(b.x)], 1u);
            asm volatile("s_waitcnt vmcnt(0)" ::: "memory");
        } else {
            XB_SPIN(xb_ld(&bar[XB_XGEN(b.x)]) == gen, bar);
            __builtin_amdgcn_fence(__ATOMIC_ACQUIRE, "agent");
            asm volatile("s_waitcnt vmcnt(0)" ::: "memory");
        }
    }
    __syncthreads();
}
struct Frame {
    LAS unsigned char* lds; volatile LAS unsigned* MISC; gu32* ctl;
    int tid, lane, wave, G, gw, NGW;
    const float *x_p, *x_s, *cache_ckv, *cache_kr, *state_conv; const int* page_table;
    const float *c_p, *c_s, *w_ada, *b_ada, *g_attn, *w_in, *g_q, *w_q_b, *g_kv, *w_kv_b, *conv_w, *w_o, *g_mlp, *w_1, *w_2, *g_final;
    float* out; unsigned char* ws;
};
__device__ const double ROPE_INV[32] = {1.0, 0.7498942093324559, 0.5623413251903491, 0.4216965034285822, 0.31622776601683794, 0.23713737056616552, 0.1778279410038923, 0.1333521432163324,
    0.1, 0.07498942093324558, 0.05623413251903491, 0.042169650342858224, 0.03162277660168379, 0.023713737056616554, 0.01778279410038923, 0.01333521432163324,
    0.01, 0.007498942093324558, 0.005623413251903491, 0.004216965034285823, 0.0031622776601683794, 0.0023713737056616554, 0.0017782794100389228, 0.001333521432163324,
    0.001, 0.0007498942093324559, 0.0005623413251903491, 0.00042169650342858224, 0.00031622776601683794, 0.00023713737056616554, 0.00017782794100389227, 0.0001333521432163324};

__device__ __forceinline__ float wave_sum(float v) {
#pragma unroll
    for (int o = 1; o < 64; o <<= 1) v += __shfl_xor(v, o);
    return v;
}
__device__ __forceinline__ float wave_max(float v) {
#pragma unroll
    for (int o = 1; o < 64; o <<= 1) v = fmaxf(v, __shfl_xor(v, o));
    return v;
}
__device__ __forceinline__ float silu_f(float x) { return x / (1.f + __expf(-x)); }
__device__ __forceinline__ float sigmoid_f(float x) { return 1.f / (1.f + __expf(-x)); }
__device__ __forceinline__ int seq_of_row(int row) { return row < MP ? (row >> 12) : NB + ((row - MP) >> 3); }
__device__ __forceinline__ int pidx_of_row(int row) { return row < MP ? (row & (SEQ - 1)) : SEQ + ((row - MP) & (DSEQ - 1)); }
__device__ __forceinline__ void store8bf(bf16* p, f32x4 a, f32x4 b) {
    v4u w; w.x = pg8::cvt_pk_bf16(a[0], a[1]); w.y = pg8::cvt_pk_bf16(a[2], a[3]); w.z = pg8::cvt_pk_bf16(b[0], b[1]); w.w = pg8::cvt_pk_bf16(b[2], b[3]);
    *(v4u*)p = w;
}
__device__ __forceinline__ void store4bf(bf16* p, f32x4 a) { v2u w; w.x = pg8::cvt_pk_bf16(a[0], a[1]); w.y = pg8::cvt_pk_bf16(a[2], a[3]); *(v2u*)p = w; }

template <int MODE> struct Epi {
    static constexpr bool PERM = true, AFTER_DRAIN = false;
    unsigned char* ws; const float* x_p; const float* x_s; float* out;
    __device__ __forceinline__ void operator()(const pg8::f32x4 (&acc)[2][2][4][2], const pg8::Unit& u, int wr, int wc, int fr, int fq) const {
        const int rowb = u.pm * 256 + wr * 64 + fr, cw = wc * 32 + 8 * fq;
#pragma unroll
        for (int ai = 0; ai < 2; ++ai)
#pragma unroll
            for (int m = 0; m < 4; ++m) {
                const int row = rowb + ai * 128 + m * 16;
#pragma unroll
                for (int bj = 0; bj < 2; ++bj) {
                    const f32x4 v0 = acc[ai][bj][m][0], v1 = acc[ai][bj][m][1];
                    const int col = u.pn * 256 + bj * 128 + cw;
                    if constexpr (MODE == 1) {
                        bf16* big = (bf16*)(ws + WS_BIG) + (size_t)row * NBIG;
                        if (u.pn < 3) { float* p = (float*)(ws + WS_SM) + (size_t)row * NSM + col; *(f32x4*)p = v0; *(f32x4*)(p + 4) = v1; }
                        else if (u.pn < 11) { store4bf(big + ((col - 768) >> 1), v0 * v1); }
                        else if (u.pn < 19) { f32x4 s; s[0] = sigmoid_f(v1[0]); s[1] = sigmoid_f(v1[1]); s[2] = sigmoid_f(v1[2]); s[3] = sigmoid_f(v1[3]);
                                              store4bf(big + 1024 + ((col - 2816) >> 1), v0 * s); }
                        else { f32x4 a, b;
#pragma unroll
                               for (int e = 0; e < 4; ++e) { a[e] = sigmoid_f(v0[e]); b[e] = sigmoid_f(v1[e]); }
                               store8bf(big + 2048 + (col - 4864), a, b); }
                    } else if constexpr (MODE == 2) {
                        bf16* qb = (bf16*)(ws + WS_QB) + (size_t)row * NQ;
                        if (u.pn < 4) { store8bf(qb + col, v0 * QSCALE, v1 * QSCALE); }
                        else {
                            const int r = col - 1024, h = r >> 6, q4 = ((r & 63) >> 3) * 4;
                            const float* tb = (const float*)(ws + WS_TAB) + ((size_t)pidx_of_row(row) * 32 + q4) * 2;
                            const f32x4 t01 = *(const f32x4*)tb, t23 = *(const f32x4*)(tb + 4);
                            f32x4 cs = {t01[0], t01[2], t23[0], t23[2]}, sn = {t01[1], t01[3], t23[1], t23[3]};
                            const f32x4 o1 = (v0 * cs - v1 * sn) * QSCALE, o2 = (v1 * cs + v0 * sn) * QSCALE;
                            store4bf(qb + 1024 + h * 64 + q4, o1); store4bf(qb + 1024 + h * 64 + 32 + q4, o2);
                            if (row >= MP) { bf16* ql = (bf16*)(ws + WS_QL) + ((size_t)(row - MP) * NH + h) * 320 + 256; store4bf(ql + q4, o1); store4bf(ql + 32 + q4, o2); }
                        }
                    } else if constexpr (MODE == 3) {
                        const size_t tok = (size_t)((row >> 12) * NH + u.pn) * SEQ + (row & (SEQ - 1));
                        if (bj == 0) store8bf((bf16*)(ws + WS_KP) + tok * 192 + cw, v0, v1);
                        else         store8bf((bf16*)(ws + WS_VP) + tok * 128 + cw, v0, v1);
                    } else if constexpr (MODE == 4) {
                        store8bf((bf16*)(ws + WS_QL) + ((size_t)row * NH + u.pn) * 320 + bj * 128 + cw, v0, v1);
                    } else if constexpr (MODE == 5) {
                        if (bj == 1) store8bf((bf16*)(ws + WS_ATT) + (size_t)(MP + row) * D + u.pn * 128 + cw, v0, v1);
                    } else if constexpr (MODE == 6 || MODE == 8) {
                        const float* g = (const float*)(ws + WS_MOD) + (size_t)seq_of_row(row) * (6 * D) + (MODE == 6 ? 2 : 5) * D + col;
                        const float* xr = (MODE == 6) ? ((row < MP ? x_p + (size_t)row * D : x_s + (size_t)(row - MP) * D) + col) : ((const float*)(ws + WS_X1) + (size_t)row * D + col);
                        float* o = (MODE == 6) ? ((float*)(ws + WS_X1) + (size_t)row * D + col) : (out + O_Y + (size_t)row * D + col);
                        const f32x4 g0 = *(const f32x4*)g, g1 = *(const f32x4*)(g + 4), x0 = *(const f32x4*)xr, x1 = *(const f32x4*)(xr + 4);
                        *(f32x4*)o = x0 + g0 * v0; *(f32x4*)(o + 4) = x1 + g1 * v1;
                    } else if constexpr (MODE == 9 || MODE == 10) {
                        float* p = (float*)(ws + (MODE == 9 ? WS_P1 : WS_P2)) + ((size_t)(u.pn >> 2) * MS + row) * D + (u.pn & 3) * 256 + bj * 128 + cw;
                        *(f32x4*)p = v0; *(f32x4*)(p + 4) = v1;
                    } else if constexpr (MODE == 7) {
                        f32x4 a = v0, b = v1;
#pragma unroll
                        for (int e = 0; e < 4; ++e) { a[e] = fmaxf(a[e], 0.f); a[e] *= a[e]; b[e] = fmaxf(b[e], 0.f); b[e] *= b[e]; }
                        store8bf((bf16*)(ws + WS_HDN) + (size_t)row * FF + col, a, b);
                    }
                }
                asm volatile("" ::: "memory");
            }
    }
};

template <int MAP> __device__ __forceinline__ int wt_row(int n) {
    if constexpr (MAP == 0) return n;
    else if constexpr (MAP == 1) {
        if (n < 704) return n;
        if (n < 1728) { const int j = n - 704;  return 768 + 2048 + 8 * (j >> 2) + (j & 3); }
        if (n < 2752) { const int j = n - 1728; return 768 + 8 * (j >> 2) + (j & 3); }
        if (n < 3776) { const int j = n - 2752; return 768 + 8 * (j >> 2) + 4 + (j & 3); }
        if (n < 4800) { const int j = n - 3776; return 768 + 4096 + j; }
        { const int j = n - 4800; return 768 + 2048 + 8 * (j >> 2) + 4 + (j & 3); } }
    else { const int h = n / 192, j = n - h * 192;
        if (j < 128) return h * 128 + j;
        const int i = j - 128, x2 = i >> 5, idx = i & 31;
        return 1024 + h * 64 + 8 * (idx >> 2) + 4 * x2 + (idx & 3); }
}
template <int MAP> __device__ __forceinline__ void transpose_item(const float* W, int K, int N, bf16* WT, const float* kscale, LAS float* scr, int item, int lane) {
    const int nblk = N / 32, kb = item / nblk, nb = item % nblk, k0 = 64 * kb, n0 = 32 * nb;
#pragma unroll 8
    for (int i = 0; i < 32; ++i) { const int kk = 2 * i + (lane >> 5); scr[kk * 33 + (lane & 31)] = W[(size_t)(k0 + kk) * N + n0 + (lane & 31)]; }
    LDS_WAIT(); asm volatile("" ::: "memory");
    const int c = lane & 7;
    float ks[8];
#pragma unroll
    for (int e = 0; e < 8; ++e) ks[e] = kscale ? kscale[k0 + 8 * c + e] : 1.f;
#pragma unroll
    for (int j = 0; j < 4; ++j) { const int n = (lane >> 3) + 8 * j; const LAS float* s = scr + (8 * c) * 33 + n;
        v4u o; o.x = pk2(s[0 * 33] * ks[0], s[1 * 33] * ks[1]); o.y = pk2(s[2 * 33] * ks[2], s[3 * 33] * ks[3]); o.z = pk2(s[4 * 33] * ks[4], s[5 * 33] * ks[5]); o.w = pk2(s[6 * 33] * ks[6], s[7 * 33] * ks[7]);
        *(GAS v4u*)(WT + (size_t)wt_row<MAP>(n0 + n) * K + k0 + 8 * c) = o; }
    LDS_WAIT(); asm volatile("" ::: "memory");
}
__device__ __forceinline__ int crow32(int r, int hi) { return (r & 3) + 8 * (r >> 2) + 4 * hi; }
__device__ __forceinline__ bf16x8 pack8f(const float* a) {
    v4u w; w.x = pg8::cvt_pk_bf16(a[0], a[1]); w.y = pg8::cvt_pk_bf16(a[2], a[3]); w.z = pg8::cvt_pk_bf16(a[4], a[5]); w.w = pg8::cvt_pk_bf16(a[6], a[7]);
    return __builtin_bit_cast(bf16x8, w);
}
__device__ __forceinline__ void adaln_task(Frame& F, int et) {
    const int e0 = et * 32, r = F.lane & 31, h = F.lane >> 5, w = F.wave;
    f32x16 acc[5];
#pragma unroll
    for (int st = 0; st < 5; ++st)
#pragma unroll
        for (int i = 0; i < 16; ++i) acc[st][i] = 0.f;
    for (int ks = 0; ks < 8; ++ks) {
        const int k0 = w * 128 + ks * 16 + 8 * h;
        float a[8];
#pragma unroll
        for (int j = 0; j < 8; ++j) a[j] = F.w_ada[(size_t)(k0 + j) * (6 * D) + e0 + r];
        const bf16x8 af = pack8f(a);
#pragma unroll
        for (int st = 0; st < 5; ++st) {
            int s = 32 * st + r; s = s < NSEQ ? s : NSEQ - 1;
            const float* cp = (s < NB ? F.c_p + (size_t)s * D : F.c_s + (size_t)(s - NB) * D) + k0;
            const f32x4 c0 = *(const f32x4*)cp, c1 = *(const f32x4*)(cp + 4);
            float b[8] = {silu_f(c0[0]), silu_f(c0[1]), silu_f(c0[2]), silu_f(c0[3]), silu_f(c1[0]), silu_f(c1[1]), silu_f(c1[2]), silu_f(c1[3])};
            acc[st] = __builtin_amdgcn_mfma_f32_32x32x16_bf16(af, pack8f(b), acc[st], 0, 0, 0);
        }
    }
    LAS float* red = (LAS float*)F.lds;
    float* mod = (float*)(F.ws + WS_MOD);
#pragma unroll
    for (int st = 0; st < 5; ++st) {
#pragma unroll
        for (int i = 0; i < 16; ++i) red[(w * 16 + i) * 64 + F.lane] = acc[st][i];
        __syncthreads();
#pragma unroll
        for (int q = 0; q < 2; ++q) {
            const int idx = F.tid + 512 * q, reg = idx >> 6, lo = idx & 63;
            float sum = 0.f;
#pragma unroll
            for (int ww = 0; ww < 8; ++ww) sum += red[ww * 1024 + idx];
            const int s = 32 * st + (lo & 31), e = e0 + crow32(reg, lo >> 5);
            if (s < NSEQ) mod[(size_t)s * (6 * D) + e] = sum + F.b_ada[e];
        }
        __syncthreads();
    }
}
__device__ __forceinline__ void p0_prologue(Frame& F) {
    for (int et = blockIdx.x; et < (6 * D) / 32; et += F.G) adaln_task(F, et);
    __syncthreads();
    LAS float* scr = (LAS float*)(F.lds + RING_OFF + F.wave * 16384);
    constexpr int I_IN = (D / 64) * (DIN / 32), I_QB = (QLORA / 64) * (NQ / 32), I_KVB = (KVL / 64) * (2048 / 32), I_O = (D / 64) * (D / 32), I_1 = (D / 64) * (FF / 32), I_2 = (FF / 64) * (D / 32);
    constexpr int NITEMS = I_IN + I_QB + I_KVB + I_O + I_1 + I_2;
    for (int it = F.gw; it < NITEMS; it += F.NGW) {
        int r = it;
        if (r < I_IN) { transpose_item<1>(F.w_in, D, DIN, (bf16*)(F.ws + WS_WIN), nullptr, scr, r, F.lane); continue; } r -= I_IN;
        if (r < I_QB) { transpose_item<2>(F.w_q_b, QLORA, NQ, (bf16*)(F.ws + WS_WQB), F.g_q, scr, r, F.lane); continue; } r -= I_QB;
        if (r < I_KVB) { transpose_item<0>(F.w_kv_b, KVL, 2048, (bf16*)(F.ws + WS_WKVB), nullptr, scr, r, F.lane); continue; } r -= I_KVB;
        if (r < I_O) { transpose_item<0>(F.w_o, D, D, (bf16*)(F.ws + WS_WO), nullptr, scr, r, F.lane); continue; } r -= I_O;
        if (r < I_1) { transpose_item<0>(F.w_1, D, FF, (bf16*)(F.ws + WS_W1), nullptr, scr, r, F.lane); continue; } r -= I_1;
        transpose_item<0>(F.w_2, FF, D, (bf16*)(F.ws + WS_W2), nullptr, scr, r, F.lane);
    }
    const int gt = F.gw * 64 + F.lane, NGT = F.NGW * 64;
    for (int i = gt; i < 64 * D / 8; i += NGT) *(v4u*)((bf16*)(F.ws + WS_WIN) + (size_t)704 * D + (size_t)i * 8) = (v4u){0u, 0u, 0u, 0u};
    for (int i = gt; i < 2048 * 256 / 8; i += NGT) {
        const int row = i >> 5, k8 = (i & 31) * 8, hh = row >> 8, c = row & 255; v4u o = {0u, 0u, 0u, 0u};
        if (k8 < 128) { const float* s = F.w_kv_b + (size_t)c * 2048 + hh * 256 + k8; const f32x4 a = *(const f32x4*)s, b = *(const f32x4*)(s + 4);
            o.x = pk2(a[0], a[1]); o.y = pk2(a[2], a[3]); o.z = pk2(b[0], b[1]); o.w = pk2(b[2], b[3]); }
        *(v4u*)((bf16*)(F.ws + WS_WUK) + (size_t)row * 256 + k8) = o;
    }
    for (int i = gt; i < NPOS * 32; i += NGT) {
        const int p = i >> 5, fi = i & 31; const double pos = (double)(p < SEQ ? p : p + (PAST - SEQ));
        const double rev = pos * ROPE_INV[fi] * 0.15915494309189535; const float fr = (float)(rev - __builtin_rint(rev));
        f32x2 cs; cs.x = __builtin_amdgcn_cosf(fr); cs.y = __builtin_amdgcn_sinf(fr);
        *((f32x2*)(F.ws + WS_TAB) + i) = cs;
    }
}
__device__ __forceinline__ void norm_mod_row(Frame& F, const float* src, const float* g, const float* sc, const float* sh, bf16* dst) {
    f32x4 v[4]; float s = 0.f;
#pragma unroll
    for (int j = 0; j < 4; ++j) { v[j] = *((const f32x4*)src + F.lane + 64 * j); s += (v[j].x * v[j].x + v[j].y * v[j].y) + (v[j].z * v[j].z + v[j].w * v[j].w); }
    const float r = 1.f / sqrtf(wave_sum(s) * (1.f / D) + EPS);
#pragma unroll
    for (int j = 0; j < 4; ++j) { const int c4 = F.lane + 64 * j; const f32x4 gg = *((const f32x4*)g + c4), ss = *((const f32x4*)sc + c4), hh = *((const f32x4*)sh + c4);
        const f32x4 o = (v[j] * r) * gg * (ss + 1.f) + hh; store4bf(dst + c4 * 4, o); }
}
__device__ __forceinline__ void small_row(Frame& F, int m) {
    const float* sm = (const float*)(F.ws + WS_SM) + (size_t)m * NSM;
    const int l = F.lane; const bool samp = m >= MP; const int ms = m - MP;
    const f32x4 qa = *((const f32x4*)sm + l); const f32x2 qb = *((const f32x2*)(sm + 256) + l);
    float s = (qa.x * qa.x + qa.y * qa.y) + (qa.z * qa.z + qa.w * qa.w) + (qb.x * qb.x + qb.y * qb.y);
    const float rq = 1.f / sqrtf(wave_sum(s) * (1.f / QLORA) + EPS);
    bf16* qo = (bf16*)(F.ws + WS_QA) + (size_t)m * QLORA;
    store4bf(qo + 4 * l, qa * rq); *(unsigned*)(qo + 256 + 2 * l) = pg8::cvt_pk_bf16(qb.x * rq, qb.y * rq);
    const f32x4 kv = *((const f32x4*)(sm + 384) + l);
    s = (kv.x * kv.x + kv.y * kv.y) + (kv.z * kv.z + kv.w * kv.w);
    const float rk = 1.f / sqrtf(wave_sum(s) * (1.f / KVL) + EPS);
    const f32x4 kn = (kv * rk) * *((const f32x4*)F.g_kv + l);
    float* ock = samp ? F.out + O_CKVS + (size_t)ms * KVL : F.out + O_CKVP + (size_t)m * KVL;
    *((f32x4*)ock + l) = kn;
    store4bf((bf16*)(F.ws + WS_CKVN) + (size_t)m * KVL + 4 * l, kn);
    if (samp) store4bf((bf16*)(F.ws + WS_KNEW) + (size_t)ms * 320 + 4 * l, kn);
    if (l < 32) {
        const float x1 = sm[640 + l], x2 = sm[672 + l];
        const f32x2 cs = *((const f32x2*)(F.ws + WS_TAB) + (size_t)pidx_of_row(m) * 32 + l);
        const float o1 = x1 * cs.x - x2 * cs.y, o2 = x2 * cs.x + x1 * cs.y;
        float* okr = samp ? F.out + O_KRS + (size_t)ms * ROPE : F.out + O_KRP + (size_t)m * ROPE;
        okr[l] = o1; okr[32 + l] = o2;
        const bf16 b1 = (bf16)f2bf(o1), b2 = (bf16)f2bf(o2);
        if (samp) { bf16* kn2 = (bf16*)(F.ws + WS_KNEW) + (size_t)ms * 320 + 256; kn2[l] = b1; kn2[32 + l] = b2; }
        else { const int b = m >> 12, t = m & (SEQ - 1);
#pragma unroll
            for (int hh = 0; hh < NH; ++hh) { bf16* kp = (bf16*)(F.ws + WS_KP) + ((size_t)(b * NH + hh) * SEQ + t) * 192 + 128; kp[l] = b1; kp[32 + l] = b2; } }
    }
    const int t = samp ? (ms & (DSEQ - 1)) : (m & (SEQ - 1)), T = samp ? DSEQ : SEQ;
    if (t >= T - 2) {
        const bf16* big = (const bf16*)(F.ws + WS_BIG) + (size_t)m * NBIG;
        float* oc = (samp ? F.out + O_CVS + (size_t)(ms >> 3) * 2 * D : F.out + O_CVP + (size_t)(m >> 12) * 2 * D) + (size_t)(t - (T - 2)) * D;
#pragma unroll
        for (int j = 0; j < 2; ++j) { const int c8 = (l + 64 * j) * 8;
            const v4u cx = *(const v4u*)(big + c8);
            f32x4 a = {bflo(cx.x), bfhi(cx.x), bflo(cx.y), bfhi(cx.y)}, b = {bflo(cx.z), bfhi(cx.z), bflo(cx.w), bfhi(cx.w)};
            *(f32x4*)(oc + c8) = a; *(f32x4*)(oc + c8 + 4) = b; }
    }
}
__device__ __forceinline__ void naive_attn_prompt_row(Frame& F, int rid) {
    const int h = rid & 7, m = rid >> 3, b = m >> 12, t = m & (SEQ - 1), l = F.lane;
    LAS float* qs = (LAS float*)(F.lds + F.wave * 8192); LAS float* sc = qs + 320;
    const bf16* qb = (const bf16*)(F.ws + WS_QB) + (size_t)m * NQ;
    qs[l] = bf2f(qb[h * 128 + l]); qs[64 + l] = bf2f(qb[h * 128 + 64 + l]); qs[128 + l] = bf2f(qb[1024 + h * 64 + l]);
    LDS_WAIT(); asm volatile("" ::: "memory");
    const bf16* K = (const bf16*)(F.ws + WS_KP) + (size_t)(b * NH + h) * SEQ * 192; const bf16* V = (const bf16*)(F.ws + WS_VP) + (size_t)(b * NH + h) * SEQ * 128;
    const int nk = t + 1; float mx = -1e30f, lsum = 0.f, o0 = 0.f, o1 = 0.f;
    for (int c0 = 0; c0 < nk; c0 += 1024) {
        const int cn = (nk - c0) < 1024 ? (nk - c0) : 1024; float cm = -1e30f;
        for (int i = l; i < cn; i += 64) { const bf16* kr = K + (size_t)(c0 + i) * 192; float s = 0.f;
#pragma unroll 4
            for (int d8 = 0; d8 < 24; ++d8) { const v4u kk = *(const v4u*)(kr + d8 * 8); const f32x4 qa = *(const LAS f32x4*)(qs + d8 * 8), qc = *(const LAS f32x4*)(qs + d8 * 8 + 4);
                s += bflo(kk.x) * qa.x + bfhi(kk.x) * qa.y + bflo(kk.y) * qa.z + bfhi(kk.y) * qa.w + bflo(kk.z) * qc.x + bfhi(kk.z) * qc.y + bflo(kk.w) * qc.z + bfhi(kk.w) * qc.w; }
            sc[i] = s; cm = fmaxf(cm, s); }
        cm = wave_max(cm); const float mn = fmaxf(mx, cm), alpha = exp2f(mx - mn); mx = mn; o0 *= alpha; o1 *= alpha; lsum *= alpha;
        float ps = 0.f;
        for (int i = l; i < cn; i += 64) { const float p = exp2f(sc[i] - mn); sc[i] = p; ps += p; }
        lsum += wave_sum(ps);
        LDS_WAIT(); asm volatile("" ::: "memory");
        for (int i = 0; i < cn; ++i) { const float p = sc[i]; const unsigned vv = *(const unsigned*)(V + (size_t)(c0 + i) * 128 + 2 * l); o0 += p * bflo(vv); o1 += p * bfhi(vv); }
        LDS_WAIT(); asm volatile("" ::: "memory");
    }
    const float inv = 1.f / lsum;
    *(unsigned*)((bf16*)(F.ws + WS_ATT) + (size_t)m * D + h * 128 + 2 * l) = pg8::cvt_pk_bf16(o0 * inv, o1 * inv);
}
__device__ __forceinline__ void naive_attn_decode_row(Frame& F, int rid) {
    const int h = rid & 7, sm = rid >> 3, sb = sm >> 3, t = sm & 7, l = F.lane;
    LAS float* qs = (LAS float*)(F.lds + F.wave * 8192); LAS float* sc = qs + 320;
    const bf16* ql = (const bf16*)(F.ws + WS_QL) + ((size_t)sm * NH + h) * 320;
#pragma unroll
    for (int j = 0; j < 5; ++j) qs[l + 64 * j] = bf2f(ql[l + 64 * j]);
    LDS_WAIT(); asm volatile("" ::: "memory");
    const int* pt = F.page_table + sb * NPAGES; const bf16* knew = (const bf16*)(F.ws + WS_KNEW) + (size_t)sb * DSEQ * 320;
    const int nk = PAST + t + 1; float mx = -1e30f, lsum = 0.f; f32x4 o = {0.f, 0.f, 0.f, 0.f};
    for (int c0 = 0; c0 < nk; c0 += 1024) {
        const int cn = (nk - c0) < 1024 ? (nk - c0) : 1024; float cm = -1e30f;
        for (int i = l; i < cn; i += 64) { const int j = c0 + i; float s = 0.f;
            if (j < PAST) { const size_t prow = (size_t)pt[j >> 7] * PAGE + (j & 127); const float* ck = F.cache_ckv + prow * KVL; const float* kr = F.cache_kr + prow * ROPE;
#pragma unroll 4
                for (int d4 = 0; d4 < 64; ++d4) { const f32x4 kk = *(const f32x4*)(ck + d4 * 4); const f32x4 qq = *(const LAS f32x4*)(qs + d4 * 4); s += kk.x * qq.x + kk.y * qq.y + kk.z * qq.z + kk.w * qq.w; }
#pragma unroll 4
                for (int d4 = 0; d4 < 16; ++d4) { const f32x4 kk = *(const f32x4*)(kr + d4 * 4); const f32x4 qq = *(const LAS f32x4*)(qs + 256 + d4 * 4); s += kk.x * qq.x + kk.y * qq.y + kk.z * qq.z + kk.w * qq.w; }
            } else { const bf16* kn = knew + (size_t)(j - PAST) * 320;
#pragma unroll 4
                for (int d8 = 0; d8 < 40; ++d8) { const v4u kk = *(const v4u*)(kn + d8 * 8); const f32x4 qa = *(const LAS f32x4*)(qs + d8 * 8), qc = *(const LAS f32x4*)(qs + d8 * 8 + 4);
                    s += bflo(kk.x) * qa.x + bfhi(kk.x) * qa.y + bflo(kk.y) * qa.z + bfhi(kk.y) * qa.w + bflo(kk.z) * qc.x + bfhi(kk.z) * qc.y + bflo(kk.w) * qc.z + bfhi(kk.w) * qc.w; }
            }
            sc[i] = s; cm = fmaxf(cm, s); }
        cm = wave_max(cm); const float mn = fmaxf(mx, cm), alpha = exp2f(mx - mn); mx = mn; o = o * alpha; lsum *= alpha;
        float ps = 0.f;
        for (int i = l; i < cn; i += 64) { const float p = exp2f(sc[i] - mn); sc[i] = p; ps += p; }
        lsum += wave_sum(ps);
        LDS_WAIT(); asm volatile("" ::: "memory");
        for (int i = 0; i < cn; ++i) { const int j = c0 + i; const float p = sc[i]; f32x4 vv;
            if (j < PAST) { const size_t prow = (size_t)pt[j >> 7] * PAGE + (j & 127); vv = *((const f32x4*)(F.cache_ckv + prow * KVL) + l); }
            else { const v2u w = *((const v2u*)(knew + (size_t)(j - PAST) * 320) + l); vv = (f32x4){bflo(w.x), bfhi(w.x), bflo(w.y), bfhi(w.y)}; }
            o = o + vv * p; }
        LDS_WAIT(); asm volatile("" ::: "memory");
    }
    const float inv = 1.f / lsum;
    store4bf((bf16*)(F.ws + WS_OLAT) + ((size_t)sm * NH + h) * 256 + 4 * l, o * inv);
}
__device__ __forceinline__ void merged_row(Frame& F, int m) {
    const bool samp = m >= MP; const int ms = m - MP, l = F.lane;
    const int t = samp ? (ms & (DSEQ - 1)) : (m & (SEQ - 1));
    const bf16* big = (const bf16*)(F.ws + WS_BIG) + (size_t)m * NBIG;
    const bf16* att = (const bf16*)(F.ws + WS_ATT) + (size_t)m * D; bf16* mo = (bf16*)(F.ws + WS_MERGED) + (size_t)m * D;
    const float* sc0 = F.state_conv + (size_t)(samp ? (ms >> 3) : 0) * 2 * D;
#pragma unroll
    for (int j = 0; j < 2; ++j) {
        const int c8 = (l + 64 * j) * 8;
        const v4u cx0 = *(const v4u*)(big + c8), bg = *(const v4u*)(big + 1024 + c8), ga = *(const v4u*)(big + 2048 + c8), at = *(const v4u*)(att + c8);
        v4u cx1 = {0u, 0u, 0u, 0u}, cx2 = cx1;
        if (t >= 1) cx1 = *(const v4u*)(big - NBIG + c8);
        if (t >= 2) cx2 = *(const v4u*)(big - 2 * NBIG + c8);
        float res[8];
#pragma unroll
        for (int e = 0; e < 8; ++e) {
            const unsigned w0 = ((const unsigned*)&cx0)[e >> 1], w1 = ((const unsigned*)&cx1)[e >> 1], w2 = ((const unsigned*)&cx2)[e >> 1], wb = ((const unsigned*)&bg)[e >> 1], wa = ((const unsigned*)&ga)[e >> 1], wt = ((const unsigned*)&at)[e >> 1];
#define SEL(w) ((e & 1) ? bfhi(w) : bflo(w))
            const int col = c8 + e;
            const float v0 = SEL(w0);
            float v1 = SEL(w1), v2 = SEL(w2);
            if (samp) { if (t == 0) { v1 = sc0[D + col]; v2 = sc0[col]; } else if (t == 1) { v2 = sc0[D + col]; } }
            const float z = F.conv_w[col] * v2 + F.conv_w[D + col] * v1 + F.conv_w[2 * D + col] * v0;
            res[e] = SEL(wa) * SEL(wt) + SEL(wb) * z;
#undef SEL
        }
        v4u o; o.x = pg8::cvt_pk_bf16(res[0], res[1]); o.y = pg8::cvt_pk_bf16(res[2], res[3]); o.z = pg8::cvt_pk_bf16(res[4], res[5]); o.w = pg8::cvt_pk_bf16(res[6], res[7]);
        *(v4u*)(mo + c8) = o;
    }
}
__device__ __forceinline__ void sample_x1_row(Frame& F, int ms, const float* g1) {
    const float* xs = F.x_s + (size_t)ms * D; const float* p1 = (const float*)(F.ws + WS_P1) + (size_t)ms * D; float* x1 = (float*)(F.ws + WS_X1) + (size_t)(MP + ms) * D;
#pragma unroll
    for (int j = 0; j < 4; ++j) { const int c4 = F.lane + 64 * j;
        f32x4 a = *((const f32x4*)p1 + c4);
#pragma unroll
        for (int kc = 1; kc < 4; ++kc) a = a + *((const f32x4*)(p1 + (size_t)kc * MS * D) + c4);
        *((f32x4*)x1 + c4) = *((const f32x4*)xs + c4) + *((const f32x4*)g1 + c4) * a; }
    asm volatile("s_waitcnt vmcnt(0)" ::: "memory");
}
__device__ __forceinline__ void final_row(Frame& F, int m) {
    float* y = F.out + O_Y + (size_t)m * D; f32x4 v[4]; float s = 0.f;
    if (m < MP) {
#pragma unroll
        for (int j = 0; j < 4; ++j) v[j] = *((const f32x4*)y + F.lane + 64 * j);
    } else {
        const int ms = m - MP; const float* x1 = (const float*)(F.ws + WS_X1) + (size_t)m * D; const float* p2 = (const float*)(F.ws + WS_P2) + (size_t)ms * D;
        const float* g2 = (const float*)(F.ws + WS_MOD) + (size_t)seq_of_row(m) * (6 * D) + 5 * D;
#pragma unroll
        for (int j = 0; j < 4; ++j) { const int c4 = F.lane + 64 * j; f32x4 a = *((const f32x4*)p2 + c4);
#pragma unroll
            for (int kc = 1; kc < 8; ++kc) a = a + *((const f32x4*)(p2 + (size_t)kc * MS * D) + c4);
            v[j] = *((const f32x4*)x1 + c4) + *((const f32x4*)g2 + c4) * a; }
    }
#pragma unroll
    for (int j = 0; j < 4; ++j) s += (v[j].x * v[j].x + v[j].y * v[j].y) + (v[j].z * v[j].z + v[j].w * v[j].w);
    const float r = 1.f / sqrtf(wave_sum(s) * (1.f / D) + EPS);
#pragma unroll
    for (int j = 0; j < 4; ++j) *((f32x4*)y + F.lane + 64 * j) = (v[j] * r) * *((const f32x4*)F.g_final + F.lane + 64 * j);
}
#define SBAR() __builtin_amdgcn_sched_barrier(0)
typedef short s16x4 __attribute__((ext_vector_type(4)));
typedef LAS s16x4* lds_s16x4p;
__device__ __forceinline__ unsigned cvtpk(float lo, float hi) { return pg8::cvt_pk_bf16(lo, hi); }
__device__ __forceinline__ bf16x8 ld_lds8(LAS unsigned char* p) { return *(const LAS bf16x8*)p; }
__device__ __forceinline__ s16x4 tr_rd(LAS unsigned char* p) { return __builtin_bit_cast(s16x4, __builtin_amdgcn_ds_read_tr16_b64_v4i16((LAS s16x4*)p)); }
__device__ __forceinline__ unsigned off_b(unsigned row, unsigned ch) { return 256u * row + 16u * (ch ^ (((row & 3) << 2) | ((row >> 2) & 3))); }
__device__ __forceinline__ unsigned off_r(unsigned row, unsigned ch) { return 128u * row + 16u * (ch ^ ((row >> 1) & 7)); }
__device__ __forceinline__ unsigned tr_addr(unsigned lane, unsigned rowbase, unsigned c, unsigned ks, unsigned t) {
    const unsigned h = lane >> 5, blk = (lane >> 4) & 1, q = (lane & 15) >> 2, p = lane & 3;
    return off_b(rowbase + 16 * ks + 8 * h + 4 * t + q, 4 * c + 2 * blk + (p >> 1)) + 8 * (p & 1);
}
constexpr float THR2 = 11.5f;
#define PK4(P, B_, OUT) do { unsigned a0 = cvtpk(P[B_+0], P[B_+1]), a1 = cvtpk(P[B_+2], P[B_+3]);                          \
        unsigned b0 = cvtpk(P[B_+4], P[B_+5]), b1 = cvtpk(P[B_+6], P[B_+7]);                                             \
        auto r0 = __builtin_amdgcn_permlane32_swap(a0, b0, false, false); auto r1 = __builtin_amdgcn_permlane32_swap(a1, b1, false, false); \
        v4u w = {r0[0], r1[0], r0[1], r1[1]}; OUT = __builtin_bit_cast(bf16x8, w); } while (0)
__device__ __forceinline__ float swap_max(float v) { auto rr = __builtin_amdgcn_permlane32_swap(__float_as_uint(v), __float_as_uint(v), false, false); return fmaxf(__uint_as_float(rr[0]), __uint_as_float(rr[1])); }
__device__ __forceinline__ float swap_sum(float v) { auto rr = __builtin_amdgcn_permlane32_swap(__float_as_uint(v), __float_as_uint(v), false, false); return __uint_as_float(rr[0]) + __uint_as_float(rr[1]); }
__device__ __forceinline__ void softmax64(f32x16& p0, f32x16& p1, float& m_reg, float& l_reg, float& alpha, bf16x8& pa0, bf16x8& pa1, bf16x8& pa2, bf16x8& pa3) {
    float pmax = p0[0];
#pragma unroll
    for (int r = 1; r < 16; ++r) pmax = fmaxf(pmax, p0[r]);
#pragma unroll
    for (int r = 0; r < 16; ++r) pmax = fmaxf(pmax, p1[r]);
    pmax = swap_max(pmax);
    float mn;
    if (__all(pmax - m_reg <= THR2)) { mn = m_reg; alpha = 1.f; } else { mn = fmaxf(m_reg, pmax); alpha = __builtin_amdgcn_exp2f(m_reg - mn); m_reg = mn; }
    float ps = 0.f;
#pragma unroll
    for (int r = 0; r < 16; ++r) { p0[r] = __builtin_amdgcn_exp2f(p0[r] - mn); ps += p0[r]; }
#pragma unroll
    for (int r = 0; r < 16; ++r) { p1[r] = __builtin_amdgcn_exp2f(p1[r] - mn); ps += p1[r]; }
    l_reg = l_reg * alpha + swap_sum(ps);
    PK4(p0, 0, pa0); PK4(p0, 8, pa1); PK4(p1, 0, pa2); PK4(p1, 8, pa3);
}
__device__ __forceinline__ void softmax32(f32x16& p0, float& m_reg, float& l_reg, float& alpha, bf16x8& pa0, bf16x8& pa1) {
    float pmax = p0[0];
#pragma unroll
    for (int r = 1; r < 16; ++r) pmax = fmaxf(pmax, p0[r]);
    pmax = swap_max(pmax);
    float mn;
    if (__all(pmax - m_reg <= THR2)) { mn = m_reg; alpha = 1.f; } else { mn = fmaxf(m_reg, pmax); alpha = __builtin_amdgcn_exp2f(m_reg - mn); m_reg = mn; }
    float ps = 0.f;
#pragma unroll
    for (int r = 0; r < 16; ++r) { p0[r] = __builtin_amdgcn_exp2f(p0[r] - mn); ps += p0[r]; }
    l_reg = l_reg * alpha + swap_sum(ps);
    PK4(p0, 0, pa0); PK4(p0, 8, pa1);
}
constexpr int PA_V = 0, PA_VB = 16384, PA_K = 2 * PA_VB, PA_KB = 24576, PA_SCR = PA_K + 2 * PA_KB;
__device__ __forceinline__ int pv_st(int k, int c) { const int kk = (k & ~0xC) | ((k & 4) << 1) | ((k & 8) >> 1); return ((kk >> 3) * 4 + (c >> 5)) * 512 + ((kk & 7) * 32 + (c & 31)) * 2; }
__device__ __forceinline__ int pv_rd_base(int lane) { return ((lane & 3) << 3) | (((lane >> 2) & 3) << 6) | (((lane >> 4) & 1) << 5) | (((lane >> 5) & 1) << 8); }
template <int VB> __device__ __forceinline__ void pa_pv_tile(f32x16* o, unsigned vb0, bf16x8 pa0, bf16x8 pa1, bf16x8 pa2, bf16x8 pa3) {
#define TRRD(dst, off) asm volatile("ds_read_b64_tr_b16 %0, %1 offset:%2" : "=&v"(dst) : "v"(vb0), "i"(off) : "memory")
#define PV_D0(d0) do { s16x4 l0, l1, l2, l3, h0, h1, h2, h3; constexpr int b_ = PA_V + VB * PA_VB + (d0) * 512;   \
        TRRD(l0, b_); TRRD(h0, b_ + 2048); TRRD(l1, b_ + 4096); TRRD(h1, b_ + 6144); TRRD(l2, b_ + 8192); TRRD(h2, b_ + 10240); TRRD(l3, b_ + 12288); TRRD(h3, b_ + 14336); \
        asm volatile("s_waitcnt lgkmcnt(0)" ::: "memory"); SBAR();   \
        o[d0] = __builtin_amdgcn_mfma_f32_32x32x16_bf16(pa0, (bf16x8){l0[0], l0[1], l0[2], l0[3], h0[0], h0[1], h0[2], h0[3]}, o[d0], 0, 0, 0);   \
        o[d0] = __builtin_amdgcn_mfma_f32_32x32x16_bf16(pa1, (bf16x8){l1[0], l1[1], l1[2], l1[3], h1[0], h1[1], h1[2], h1[3]}, o[d0], 0, 0, 0);   \
        o[d0] = __builtin_amdgcn_mfma_f32_32x32x16_bf16(pa2, (bf16x8){l2[0], l2[1], l2[2], l2[3], h2[0], h2[1], h2[2], h2[3]}, o[d0], 0, 0, 0);   \
        o[d0] = __builtin_amdgcn_mfma_f32_32x32x16_bf16(pa3, (bf16x8){l3[0], l3[1], l3[2], l3[3], h3[0], h3[1], h3[2], h3[3]}, o[d0], 0, 0, 0); } while (0)
    PV_D0(0); PV_D0(1); PV_D0(2); PV_D0(3);
#undef PV_D0
#undef TRRD
}
__device__ __forceinline__ void attn_prompt_block(Frame& F, int b, int h, int qb) {
    unsigned z_ = 0u; asm volatile("" : "+v"(z_)); const int lane = (int)__builtin_amdgcn_mbcnt_hi(~0u, __builtin_amdgcn_mbcnt_lo(~0u, z_));
    const int wid = F.wave, tid = wid * 64 + lane, r32 = lane & 31, hi = lane >> 5;
    LAS unsigned char* L = F.lds;
    const bf16* Kg = (const bf16*)(F.ws + WS_KP) + (size_t)(b * NH + h) * SEQ * 192;
    const bf16* Vg = (const bf16*)(F.ws + WS_VP) + (size_t)(b * NH + h) * SEQ * 128;
    const int row0 = b * SEQ + qb * 256 + wid * 32;
    const int qpos = qb * 256 + wid * 32 + r32;
    const int qlo = qb * 256 + wid * 32;
    const int NT = 4 * (qb + 1);
    bf16x8 qr[12];
    { const bf16* qp = (const bf16*)(F.ws + WS_QB) + (size_t)(row0 + r32) * NQ;
#pragma unroll
      for (int d0 = 0; d0 < 12; ++d0) qr[d0] = *(const bf16x8*)(qp + (d0 < 8 ? h * 128 + 16 * d0 + 8 * hi : 1024 + h * 64 + 16 * (d0 - 8) + 8 * hi)); }
    unsigned kso[3], vso[2];
#pragma unroll
    for (int i = 0; i < 3; ++i) { const unsigned p = (unsigned)(wid * 3 + i) * 64 + lane, row = p / 24, chp = p - row * 24, ch = chp ^ ((row >> 1) & 7); kso[i] = row * 192 + ch * 8; }
#pragma unroll
    for (int i = 0; i < 2; ++i) { const unsigned B_ = ((unsigned)(wid * 2 + i) * 64 + lane) * 16, st = B_ >> 9, wi = B_ & 511, kk = (st >> 2) * 8 + (wi >> 6), c = (st & 3) * 32 + ((wi & 63) >> 1);
        const unsigned k = (kk & ~0xCu) | ((kk & 4) << 1) | ((kk & 8) >> 1); vso[i] = k * 128 + c; }
#define PA_STAGE(t, bf) do { const bf16* kt = Kg + (size_t)(t) * 64 * 192; const bf16* vt = Vg + (size_t)(t) * 64 * 128;   \
        _Pragma("unroll") for (int i = 0; i < 3; ++i) __builtin_amdgcn_global_load_lds((const unsigned*)(kt + kso[i]), (LAS unsigned*)(L + PA_K + (bf) * PA_KB + (wid * 3 + i) * 1024), 16, 0, 0);   \
        _Pragma("unroll") for (int i = 0; i < 2; ++i) __builtin_amdgcn_global_load_lds((const unsigned*)(vt + vso[i]), (LAS unsigned*)(L + PA_V + (bf) * PA_VB + (wid * 2 + i) * 1024), 16, 0, 0); } while (0)
    LAS float* al_l = (LAS float*)(L + PA_SCR + wid * 256); LAS float* li_l = al_l + 32;
    const unsigned vb0 = (unsigned)pv_rd_base(lane);
    const int fx = (r32 >> 1) & 7;
    int kb4[4];
#pragma unroll
    for (int dd = 0; dd < 4; ++dd) kb4[dd] = r32 * 384 + (((2 * dd + hi) ^ fx) << 4);
    float m_reg = -1e30f, l_reg = 0.f; f32x16 o[4];
#pragma unroll
    for (int d = 0; d < 4; ++d)
#pragma unroll
        for (int r = 0; r < 16; ++r) o[d][r] = 0.f;
    PA_STAGE(0, 0); VM_WAIT();
    __syncthreads();
#define PA_STEP(t, KB) do {                                                                                                     \
        if ((t) + 1 < NT) PA_STAGE((t) + 1, (KB) ^ 1);                                                                          \
        f32x16 p0, p1;                                                                                                          \
        _Pragma("unroll") for (int r = 0; r < 16; ++r) { p0[r] = 0.f; p1[r] = 0.f; }                                            \
        _Pragma("unroll") for (int g_ = 0; g_ < 6; ++g_) { bf16x8 kf[4];                                                        \
            _Pragma("unroll") for (int dd = 0; dd < 2; ++dd) { const int d0 = 2 * g_ + dd; LAS unsigned char* a = L + PA_K + (KB) * PA_KB + kb4[d0 & 3] + (d0 >> 2) * 128; kf[2 * dd] = ld_lds8(a); kf[2 * dd + 1] = ld_lds8(a + 32 * 384); }   \
            SBAR();                                                                                                             \
            _Pragma("unroll") for (int dd = 0; dd < 2; ++dd) {                                                                  \
                p0 = __builtin_amdgcn_mfma_f32_32x32x16_bf16(kf[2 * dd], qr[2 * g_ + dd], p0, 0, 0, 0);                          \
                p1 = __builtin_amdgcn_mfma_f32_32x32x16_bf16(kf[2 * dd + 1], qr[2 * g_ + dd], p1, 0, 0, 0); }                    \
            SBAR(); }                                                                                                           \
        const int kb_ = (t) * 64;                                                                                               \
        if (kb_ + 63 > qlo) { const float NEG = -__builtin_inff();                                                              \
            _Pragma("unroll") for (int r = 0; r < 16; ++r) { const int key = kb_ + crow32(r, hi); if (key > qpos) p0[r] = NEG; if (key + 32 > qpos) p1[r] = NEG; } }   \
        float alpha; bf16x8 pa0, pa1, pa2, pa3;                                                                                 \
        softmax64(p0, p1, m_reg, l_reg, alpha, pa0, pa1, pa2, pa3);                                                             \
        if (__any(alpha < 1.f)) { if (hi == 0) al_l[r32] = alpha; LDS_WAIT();                                                    \
            _Pragma("unroll") for (int r = 0; r < 16; ++r) { const float a_ = al_l[crow32(r, hi)];                              \
                _Pragma("unroll") for (int d_ = 0; d_ < 4; ++d_) o[d_][r] *= a_; } }                                            \
        pa_pv_tile<KB>(o, vb0, pa0, pa1, pa2, pa3);                                                                             \
        VM_WAIT();                                                                                                              \
        __syncthreads(); } while (0)
    for (int t = 0; t < NT; t += 2) { PA_STEP(t, 0); PA_STEP(t + 1, 1); }
#undef PA_STEP
#undef PA_STAGE
    if (hi == 0) li_l[r32] = l_reg;
    LDS_WAIT();
    { unsigned eo = (unsigned)(4 * hi * D + r32);
      asm volatile("" : "+v"(eo));
      bf16* Ow = (bf16*)(F.ws + WS_ATT) + (size_t)row0 * D + h * 128;
#pragma unroll
      for (int r = 0; r < 16; ++r) { const int orow = crow32(r, hi); const float rl = __builtin_amdgcn_rcpf(li_l[orow]);
#pragma unroll
        for (int d0 = 0; d0 < 4; ++d0) { const float v = o[d0][r] * rl; const float vn = __shfl_xor(v, 1);
            if ((r32 & 1) == 0) *(unsigned*)(Ow + eo + ((r & 3) + 8 * (r >> 2)) * D + d0 * 32) = cvtpk(v, vn); } } }
    __syncthreads();
}
constexpr int DA_Q = 0, DA_IMG = 40960, DA_K = DA_IMG, DA_SCR = 3 * DA_IMG, DA_L1 = 16384, DA_R = 32768;
#define DA_BAR() do { asm volatile("s_waitcnt lgkmcnt(0)" ::: "memory"); __builtin_amdgcn_s_barrier(); asm volatile("" ::: "memory"); } while (0)
__device__ __forceinline__ void attn_decode_unit(Frame& F, int sb, int sp) {
    unsigned z_ = 0u; asm volatile("" : "+v"(z_)); const int lane = (int)__builtin_amdgcn_mbcnt_hi(~0u, __builtin_amdgcn_mbcnt_lo(~0u, z_));
    const int wid = F.wave, tid = wid * 64 + lane, r32 = lane & 31, hi = lane >> 5;
    LAS unsigned char* L = F.lds;
    const int* pt = F.page_table + sb * NPAGES + sp * 32;
    constexpr int NT = 64;
    { const bf16* ql = (const bf16*)(F.ws + WS_QL) + (size_t)sb * 64 * 320;
#pragma unroll
      for (int i = 0; i < 5; ++i) { const int id = tid + 512 * i, row = id / 40, ch = id - row * 40; const bf16x8 v = *(const bf16x8*)(ql + (size_t)row * 320 + ch * 8);
          const unsigned o_ = ch < 16 ? off_b(row, ch) : (ch < 32 ? DA_L1 + off_b(row, ch - 16) : DA_R + off_r(row, ch - 32));
          *(LAS bf16x8*)(L + DA_Q + o_) = v; } }
    __syncthreads();
    if (wid >= 4) {
        const unsigned lt = (unsigned)((wid - 4) * 64 + lane);
        const int ptv = pt[lane & 31];
        f32x4 cA[16], rA[4], cB[16], rB[4];
        const unsigned cvo = (lt >> 6) * 1024u + (lt & 63) * 16u, rvo = (lt >> 4) * 256u + (lt & 15) * 16u;
        unsigned wlo[4];
        { const unsigned c4 = lt & 63, row0 = lt >> 6, ch = (c4 & 31) >> 1;
#pragma unroll
          for (int v = 0; v < 4; ++v) wlo[v] = (c4 >> 5) * DA_L1 + 256u * row0 + 16u * (ch ^ (((row0 & 3) << 2) | (((row0 >> 2) + v) & 3))) + 8u * (c4 & 1); }
        const unsigned wro = DA_R + off_r(lt >> 4, (lt & 15) >> 1) + 8u * (lt & 1);
#define DA_LOAD(t, c_, r_) do { const size_t prow = (size_t)__builtin_amdgcn_readlane(ptv, (t) >> 1) * PAGE + ((t) & 1) * 64;     \
        const char* cb_ = (const char*)F.cache_ckv + prow * (KVL * 4); const char* rb_ = (const char*)F.cache_kr + prow * (ROPE * 4);   \
        _Pragma("unroll") for (int i = 0; i < 16; ++i) c_[i] = __builtin_nontemporal_load((const f32x4*)(cb_ + 4096 * i + cvo));     \
        _Pragma("unroll") for (int i = 0; i < 4; ++i) r_[i] = __builtin_nontemporal_load((const f32x4*)(rb_ + 4096 * i + rvo)); } while (0)
#define DA_WRITE(bf, c_, r_) do { LAS unsigned char* Kb = L + DA_K + (bf) * DA_IMG;                                             \
        _Pragma("unroll") for (int i = 0; i < 16; ++i) { v2u w; w.x = cvtpk(c_[i][0], c_[i][1]); w.y = cvtpk(c_[i][2], c_[i][3]); *(LAS v2u*)(Kb + wlo[i & 3] + 1024 * i) = w; }   \
        _Pragma("unroll") for (int i = 0; i < 4; ++i) { v2u w; w.x = cvtpk(r_[i][0], r_[i][1]); w.y = cvtpk(r_[i][2], r_[i][3]); *(LAS v2u*)(Kb + wro + 2048 * i) = w; } } while (0)
        DA_LOAD(0, cA, rA); DA_LOAD(1, cB, rB);
        for (int t = 0; t < NT; t += 2) {
            DA_WRITE(0, cA, rA);
            DA_LOAD(t + 2 < NT ? t + 2 : NT - 1, cA, rA);
            DA_BAR();
            DA_WRITE(1, cB, rB);
            DA_LOAD(t + 3 < NT ? t + 3 : NT - 1, cB, rB);
            DA_BAR();
        }
#undef DA_LOAD
#undef DA_WRITE
        if (sp == 1) {
            LAS unsigned char* Kb = L + DA_K; const bf16* kn = (const bf16*)(F.ws + WS_KNEW) + (size_t)sb * DSEQ * 320;
#pragma unroll
            for (int i = 0; i < 10; ++i) { const int id = lt + 256 * i, row = id / 40, ch = id - row * 40; bf16x8 v = {0, 0, 0, 0, 0, 0, 0, 0};
                if (row < DSEQ) v = *(const bf16x8*)(kn + (size_t)row * 320 + ch * 8);
                const unsigned o_ = ch < 16 ? off_b(row, ch) : (ch < 32 ? DA_L1 + off_b(row, ch - 16) : DA_R + off_r(row, ch - 32));
                *(LAS bf16x8*)(Kb + o_) = v; }
            DA_BAR();
        }
    } else {
        const int kh = wid & 1, qh = wid >> 1;
        LAS float* al_l = (LAS float*)(L + DA_SCR + wid * 256);
        const unsigned krow = 32 * kh + r32, qrow = 32 * qh + r32;
        float m_reg = -1e30f, l_reg = 0.f; f32x16 o[8];
#pragma unroll
        for (int d = 0; d < 8; ++d)
#pragma unroll
            for (int r = 0; r < 16; ++r) o[d][r] = 0.f;
#define DA_KADDR(s) ((s) < 16 ? ((s) >> 3) * DA_L1 + 256u * kr_ + 16u * ((2 * ((s) & 7) + hi) ^ xk) : DA_R + 128u * kr_ + 16u * ((2 * ((s) - 16) + hi) ^ fk))
#define DA_QADDR(s) ((s) < 16 ? ((s) >> 3) * DA_L1 + 256u * qr_ + 16u * ((2 * ((s) & 7) + hi) ^ xq) : DA_R + 128u * qr_ + 16u * ((2 * ((s) - 16) + hi) ^ fq))
#define DA_LDG(g, sl) do { kf[sl][0] = ld_lds8(Kb + DA_KADDR(2 * (g))); qf[sl][0] = ld_lds8(Qb + DA_QADDR(2 * (g))); kf[sl][1] = ld_lds8(Kb + DA_KADDR(2 * (g) + 1)); qf[sl][1] = ld_lds8(Qb + DA_QADDR(2 * (g) + 1)); } while (0)
#define DA_LDV(c, sl) do { LAS unsigned char* Vb_ = Kb + ((c) >> 2) * DA_L1;                                                     \
            va[sl][0] = tr_rd(Vb_ + tr_addr(ln_, 32 * kh, (c) & 3, 0, 0)); va[sl][1] = tr_rd(Vb_ + tr_addr(ln_, 32 * kh, (c) & 3, 0, 1));   \
            va[sl][2] = tr_rd(Vb_ + tr_addr(ln_, 32 * kh, (c) & 3, 1, 0)); va[sl][3] = tr_rd(Vb_ + tr_addr(ln_, 32 * kh, (c) & 3, 1, 1)); } while (0)
#define DA_COMPUTE(bf, MASKNEW) do { LAS unsigned char* Kb = L + DA_K + (bf) * DA_IMG; LAS unsigned char* Qb = L + DA_Q;         \
        unsigned kr_ = krow, qr_ = qrow, ln_ = lane; asm volatile("" : "+v"(kr_), "+v"(qr_), "+v"(ln_));     \
        const unsigned xk = ((kr_ & 3) << 2) | ((kr_ >> 2) & 3), xq = ((qr_ & 3) << 2) | ((qr_ >> 2) & 3), fk = (kr_ >> 1) & 7, fq = (qr_ >> 1) & 7;   \
        f32x16 p0;                                                                                                              \
        _Pragma("unroll") for (int r = 0; r < 16; ++r) p0[r] = 0.f;                                                             \
        { bf16x8 kf[2][2], qf[2][2];                           \
          DA_LDG(0, 0);                                                                                                         \
          _Pragma("unroll") for (int g_ = 0; g_ < 10; ++g_) {                                                                   \
            if (g_ + 1 < 10) DA_LDG(g_ + 1, (g_ + 1) & 1);                                                                      \
            SBAR();                                                                                                             \
            p0 = __builtin_amdgcn_mfma_f32_32x32x16_bf16(kf[g_ & 1][0], qf[g_ & 1][0], p0, 0, 0, 0);                             \
            p0 = __builtin_amdgcn_mfma_f32_32x32x16_bf16(kf[g_ & 1][1], qf[g_ & 1][1], p0, 0, 0, 0);                             \
            SBAR(); } }                                                                                                         \
        if (MASKNEW) { const float NEG = -__builtin_inff(); const int tq = (int)qrow >> 3;                                      \
            _Pragma("unroll") for (int r = 0; r < 16; ++r) { const int kk = crow32(r, hi); if (kk > tq) p0[r] = NEG; } }         \
        float alpha; bf16x8 pa0, pa1;                                                                                           \
        softmax32(p0, m_reg, l_reg, alpha, pa0, pa1);                                                                           \
        if (__any(alpha < 1.f)) { if (hi == 0) al_l[r32] = alpha; LDS_WAIT();                                                    \
            _Pragma("unroll") for (int r = 0; r < 16; ++r) { const float a_ = al_l[crow32(r, hi)];                              \
                _Pragma("unroll") for (int d_ = 0; d_ < 8; ++d_) o[d_][r] *= a_; } }                                            \
        { s16x4 va[2][4];                                                             \
          DA_LDV(0, 0);                                                                                                         \
          _Pragma("unroll") for (int c = 0; c < 8; ++c) {                                                                       \
            if (c + 1 < 8) DA_LDV(c + 1, (c + 1) & 1);                                                                          \
            SBAR();                                                                                                             \
            o[c] = __builtin_amdgcn_mfma_f32_32x32x16_bf16(pa0, (bf16x8){va[c & 1][0][0], va[c & 1][0][1], va[c & 1][0][2], va[c & 1][0][3], va[c & 1][1][0], va[c & 1][1][1], va[c & 1][1][2], va[c & 1][1][3]}, o[c], 0, 0, 0);   \
            o[c] = __builtin_amdgcn_mfma_f32_32x32x16_bf16(pa1, (bf16x8){va[c & 1][2][0], va[c & 1][2][1], va[c & 1][2][2], va[c & 1][2][3], va[c & 1][3][0], va[c & 1][3][1], va[c & 1][3][2], va[c & 1][3][3]}, o[c], 0, 0, 0);   \
            SBAR(); } } } while (0)
        for (int t = 0; t < NT; t += 2) {
            DA_BAR(); DA_COMPUTE(0, false);
            DA_BAR(); DA_COMPUTE(1, false);
        }
        if (sp == 1) { DA_BAR(); if (kh == 0) { DA_COMPUTE(0, true); } }
#undef DA_COMPUTE
#undef DA_LDG
#undef DA_LDV
#undef DA_KADDR
#undef DA_QADDR
        { unsigned l2 = (unsigned)lane; asm volatile("" : "+v"(l2));
          const unsigned e_r32 = l2 & 31, e_hi = l2 >> 5; const int pi = 2 * sp + kh;
          float* po = (float*)(F.ws + WS_PART) + ((size_t)(sb * 4 + pi) * 64 + 32 * qh) * 256;
          const unsigned eo = 4 * e_hi * 256 + e_r32;
#pragma unroll
          for (int r = 0; r < 16; ++r) {
#pragma unroll
            for (int c = 0; c < 8; ++c) po[eo + ((r & 3) + 8 * (r >> 2)) * 256 + 32 * c] = o[c][r]; }
          if (e_hi == 0) { float* ml = (float*)(F.ws + WS_ML) + ((size_t)(sb * 4 + pi) * 64 + 32 * qh + e_r32) * 2; ml[0] = m_reg; ml[1] = l_reg; } }
    }
    __syncthreads();
}
__device__ __forceinline__ void decode_combine_row(Frame& F, int row) {
    const int sb = row >> 6, q = row & 63, l = F.lane;
    const float* ml = (const float*)(F.ws + WS_ML); const float* po = (const float*)(F.ws + WS_PART);
    float mm[4], ll[4], M_ = -1e30f;
#pragma unroll
    for (int p = 0; p < 4; ++p) { const f32x2 v = *(const f32x2*)(ml + ((size_t)(sb * 4 + p) * 64 + q) * 2); mm[p] = v.x; ll[p] = v.y; M_ = fmaxf(M_, v.x); }
    float Lsum = 0.f; f32x4 acc = {0.f, 0.f, 0.f, 0.f};
#pragma unroll
    for (int p = 0; p < 4; ++p) { const float w = exp2f(mm[p] - M_); Lsum += w * ll[p]; acc = acc + *((const f32x4*)(po + ((size_t)(sb * 4 + p) * 64 + q) * 256) + l) * w; }
    store4bf((bf16*)(F.ws + WS_OLAT) + (size_t)row * 256 + 4 * l, acc * (1.f / Lsum));
}

struct Args { const void* in[22]; float* out; unsigned char* ws; int ph_lo, ph_hi; };
__global__ void __launch_bounds__(NWAVES * 64, 2) mk_fwd(Args args) {
    extern __shared__ __attribute__((aligned(16))) unsigned char lds[];
    Frame F;
    F.lds = (LAS unsigned char*)lds;
    F.MISC = (volatile LAS unsigned*)(F.lds + MISC_OFF);
    F.tid = threadIdx.x; F.lane = F.tid & 63; F.wave = __builtin_amdgcn_readfirstlane(F.tid >> 6);
    F.G = gridDim.x; F.gw = blockIdx.x * NWAVES + F.wave; F.NGW = F.G * NWAVES;
    F.ws = args.ws; F.out = args.out; F.ctl = (gu32*)(args.ws + WS_CTL);
    F.x_p = (const float*)args.in[0]; F.x_s = (const float*)args.in[1]; F.cache_ckv = (const float*)args.in[2]; F.cache_kr = (const float*)args.in[3]; F.state_conv = (const float*)args.in[4];
    F.page_table = (const int*)args.in[5]; F.c_p = (const float*)args.in[6]; F.c_s = (const float*)args.in[7]; F.w_ada = (const float*)args.in[8]; F.b_ada = (const float*)args.in[9];
    F.g_attn = (const float*)args.in[10]; F.w_in = (const float*)args.in[11]; F.g_q = (const float*)args.in[12]; F.w_q_b = (const float*)args.in[13]; F.g_kv = (const float*)args.in[14];
    F.w_kv_b = (const float*)args.in[15]; F.conv_w = (const float*)args.in[16]; F.w_o = (const float*)args.in[17]; F.g_mlp = (const float*)args.in[18]; F.w_1 = (const float*)args.in[19];
    F.w_2 = (const float*)args.in[20]; F.g_final = (const float*)args.in[21];
    for (int u = F.tid; u < (LDS_BYTES - LDSCTL_OFF) / 4; u += NWAVES * 64) ((LAS unsigned*)(F.lds + LDSCTL_OFF))[u] = 0u;
    __syncthreads();
    XcdBarrier bar; bar.bar = (unsigned*)(F.ctl + CW_BAR); bar.x = 0; bar.st = nullptr;
    if (!MK_PER_PHASE) bar = xcd_barrier_post((unsigned*)(F.ctl + CW_BAR), F.MISC + 8);
#define GRID_BAR() do { if (MK_PER_PHASE) { if (F.tid == 0) __hip_atomic_store(F.ctl + CW_TMO, 0xBADBA0u, RLX_AGENT); } else { xcd_barrier(bar); } } while (0)
    const int lo = args.ph_lo, hi = args.ph_hi;
#ifndef PH_MASK
#define PH_MASK 0xFFFFFFFFu
#endif
#define IN(k) (((PH_MASK >> (k)) & 1u) && lo <= (k) && (k) < hi)
#define BOTH(k) (IN(k) && IN((k) + 1))
#define RELANE() do { unsigned z_ = 0u; asm volatile("" : "+v"(z_)); int l_ = (int)__builtin_amdgcn_mbcnt_hi(~0u, __builtin_amdgcn_mbcnt_lo(~0u, z_)); F.lane = l_; F.tid = F.wave * 64 + l_; } while (0)
    const pg8::bf16_t* U = (const pg8::bf16_t*)(F.ws + WS_U);
    float* mod = (float*)(F.ws + WS_MOD);

    if (IN(0)) { RELANE(); p0_prologue(F); if (BOTH(0)) GRID_BAR(); }
    if (IN(1)) { RELANE();
        for (int m = F.gw; m < M; m += F.NGW) { const float* mr = mod + (size_t)seq_of_row(m) * (6 * D);
            norm_mod_row(F, m < MP ? F.x_p + (size_t)m * D : F.x_s + (size_t)(m - MP) * D, F.g_attn, mr + D, mr, (bf16*)(F.ws + WS_U) + (size_t)m * D); }
        if (BOTH(1)) GRID_BAR();
    }
    if (IN(2)) { RELANE();
        pg8::Gemm g{U, (const pg8::bf16_t*)(F.ws + WS_WIN), M, NIN, D, D, D, 0, 0, 0x7fffffff, 0}; pg8::StaticOrder S; S.init(M, NIN, F.G, (int)blockIdx.x);
        Epi<1> E{F.ws, F.x_p, F.x_s, F.out};
        pg8::gemm_phase<Epi<1>, pg8::StaticOrder, true, true>(F.lds + RING_OFF, g, S, E);
        if (BOTH(2)) GRID_BAR();
    }
    if (IN(3)) { RELANE(); for (int m = F.gw; m < M; m += F.NGW) small_row(F, m); if (BOTH(3)) GRID_BAR(); }
    if (IN(4)) { RELANE();
        { pg8::Gemm g{(const pg8::bf16_t*)(F.ws + WS_QA), (const pg8::bf16_t*)(F.ws + WS_WQB), M, NQ, QLORA, QLORA, QLORA, 0, 0, 0x7fffffff, 0}; pg8::StaticOrder S; S.init(M, NQ, F.G, (int)blockIdx.x);
          Epi<2> E{F.ws, F.x_p, F.x_s, F.out};
          pg8::gemm_phase<Epi<2>, pg8::StaticOrder, true, true>(F.lds + RING_OFF, g, S, E); }
        __syncthreads();
        { pg8::Gemm g{(const pg8::bf16_t*)(F.ws + WS_CKVN), (const pg8::bf16_t*)(F.ws + WS_WKVB), MP, 2048, KVL, KVL, KVL, 0, 0, 0x7fffffff, 0}; pg8::StaticOrder S; S.init(MP, 2048, F.G, (int)blockIdx.x);
          Epi<3> E{F.ws, F.x_p, F.x_s, F.out};
          pg8::gemm_phase<Epi<3>, pg8::StaticOrder, true, true>(F.lds + RING_OFF, g, S, E); }
        if (BOTH(4)) GRID_BAR();
    }
    if (IN(5)) { RELANE();
        pg8::Gemm g{(const pg8::bf16_t*)(F.ws + WS_QB) + (size_t)MP * NQ, (const pg8::bf16_t*)(F.ws + WS_WUK), MS, 2048, 256, NQ, 256, 128 * 2, 0, 0x7fffffff, 0}; pg8::StaticOrder S; S.init(MS, 2048, F.G, (int)blockIdx.x);
        Epi<4> E{F.ws, F.x_p, F.x_s, F.out};
        pg8::gemm_phase<Epi<4>, pg8::StaticOrder, true, true>(F.lds + RING_OFF, g, S, E);
        if (BOTH(5)) GRID_BAR();
    }
    if (IN(6)) { RELANE();
        const bool dec_first = ((blockIdx.x >> 3) & 1) != 0;
        if (dec_first) { for (int du = blockIdx.x; du < 2 * DB; du += F.G) attn_decode_unit(F, du >> 1, du & 1); }
        for (int it = blockIdx.x; it < NB * NH * 8; it += F.G) {
            const int xcd = it & 7, j = it >> 3, bh = (xcd * 4 + (j >> 3)) & 31, pr = j & 7, b = bh >> 3, h = bh & 7;
            for (int k = 0; k < 2; ++k) attn_prompt_block(F, b, h, k == 0 ? 15 - pr : pr);
        }
        if (!dec_first) { for (int du = blockIdx.x; du < 2 * DB; du += F.G) attn_decode_unit(F, du >> 1, du & 1); }
        if (BOTH(6)) GRID_BAR();
    }
    if (IN(7)) { RELANE(); for (int r = F.gw; r < MS * NH; r += F.NGW) decode_combine_row(F, r); if (BOTH(7)) GRID_BAR(); }
    if (IN(8)) { RELANE();
        pg8::Gemm g{(const pg8::bf16_t*)(F.ws + WS_OLAT), (const pg8::bf16_t*)(F.ws + WS_WKVB), MS, 2048, 256, 2048, 256, 256 * 2, 0, 0x7fffffff, 0}; pg8::StaticOrder S; S.init(MS, 2048, F.G, (int)blockIdx.x);
        Epi<5> E{F.ws, F.x_p, F.x_s, F.out};
        pg8::gemm_phase<Epi<5>, pg8::StaticOrder, true, true>(F.lds + RING_OFF, g, S, E);
        if (BOTH(8)) GRID_BAR();
    }
    if (IN(9)) { RELANE(); for (int m = F.gw; m < M; m += F.NGW) merged_row(F, m); if (BOTH(9)) GRID_BAR(); }
    if (IN(10)) { RELANE();
        { pg8::Gemm g{(const pg8::bf16_t*)(F.ws + WS_MERGED), (const pg8::bf16_t*)(F.ws + WS_WO), MP, D, D, D, D, 0, 0, 0x7fffffff, 0}; pg8::StaticOrder S; S.init(MP, D, F.G, (int)blockIdx.x);
          Epi<6> E{F.ws, F.x_p, F.x_s, F.out};
          pg8::gemm_phase<Epi<6>, pg8::StaticOrder, true, true>(F.lds + RING_OFF, g, S, E); }
        __syncthreads();
        { pg8::Gemm g{(const pg8::bf16_t*)(F.ws + WS_MERGED) + (size_t)MP * D, (const pg8::bf16_t*)(F.ws + WS_WO), MS, 4 * D, 256, D, D, 256 * 2, 2, 3, 256 * 2}; pg8::StaticOrder S; S.init(MS, 4 * D, F.G, (int)(F.G - 1 - blockIdx.x));
          Epi<9> E{F.ws, F.x_p, F.x_s, F.out};
          pg8::gemm_phase<Epi<9>, pg8::StaticOrder, true, true>(F.lds + RING_OFF, g, S, E); }
        if (BOTH(10)) GRID_BAR();
    }
    if (IN(11)) { RELANE();
        for (int m = F.gw; m < M; m += F.NGW) { const float* mr = mod + (size_t)seq_of_row(m) * (6 * D);
            if (m >= MP) sample_x1_row(F, m - MP, mr + 2 * D);
            norm_mod_row(F, (const float*)(F.ws + WS_X1) + (size_t)m * D, F.g_mlp, mr + 4 * D, mr + 3 * D, (bf16*)(F.ws + WS_U) + (size_t)m * D); }
        if (BOTH(11)) GRID_BAR();
    }
    if (IN(12)) { RELANE();
        pg8::Gemm g{U, (const pg8::bf16_t*)(F.ws + WS_W1), M, FF, D, D, D, 0, 0, 0x7fffffff, 0}; pg8::StaticOrder S; S.init(M, FF, F.G, (int)blockIdx.x);
        Epi<7> E{F.ws, F.x_p, F.x_s, F.out};
        pg8::gemm_phase<Epi<7>, pg8::StaticOrder, true, true>(F.lds + RING_OFF, g, S, E);
        if (BOTH(12)) GRID_BAR();
    }
    if (IN(13)) { RELANE();
        { pg8::Gemm g{(const pg8::bf16_t*)(F.ws + WS_HDN), (const pg8::bf16_t*)(F.ws + WS_W2), MP, D, FF, FF, FF, 0, 0, 0x7fffffff, 0}; pg8::StaticOrder S; S.init(MP, D, F.G, (int)blockIdx.x);
          Epi<8> E{F.ws, F.x_p, F.x_s, F.out};
          pg8::gemm_phase<Epi<8>, pg8::StaticOrder, true, true>(F.lds + RING_OFF, g, S, E); }
        __syncthreads();
        { pg8::Gemm g{(const pg8::bf16_t*)(F.ws + WS_HDN) + (size_t)MP * FF, (const pg8::bf16_t*)(F.ws + WS_W2), MS, 8 * D, 512, FF, FF, 512 * 2, 2, 3, 512 * 2}; pg8::StaticOrder S; S.init(MS, 8 * D, F.G, (int)(F.G - 1 - blockIdx.x));
          Epi<10> E{F.ws, F.x_p, F.x_s, F.out};
          pg8::gemm_phase<Epi<10>, pg8::StaticOrder, true, true>(F.lds + RING_OFF, g, S, E); }
        if (BOTH(13)) GRID_BAR();
    }
    if (IN(14)) { RELANE(); for (int m = F.gw; m < M; m += F.NGW) final_row(F, m); }
#undef IN
#undef BOTH
}

extern "C" void kernel_launch(void* const* d_in, const int* in_sizes, int n_in, void* d_out, int out_size, void* d_ws, size_t ws_size, hipStream_t stream) {
    static int grid = 0;
    if (grid == 0) {
        if (n_in != 22 || out_size != (int)O_END || ws_size < WS_END) { fprintf(stderr, "kernel_launch: unexpected shapes (n_in %d, out %d, ws %zu); nothing launched\n", n_in, out_size, ws_size); grid = -1; return; }
        int dev = 0, cus = 0, per_cu = 0;
        if (hipGetDevice(&dev) != hipSuccess || hipDeviceGetAttribute(&cus, hipDeviceAttributeMultiprocessorCount, dev) != hipSuccess) { grid = -1; return; }
        if (hipFuncSetAttribute((const void*)mk_fwd, hipFuncAttributeMaxDynamicSharedMemorySize, LDS_BYTES) != hipSuccess) { fprintf(stderr, "kernel_launch: hipFuncSetAttribute failed\n"); grid = -1; return; }
        if (hipOccupancyMaxActiveBlocksPerMultiprocessor(&per_cu, (const void*)mk_fwd, NWAVES * 64, LDS_BYTES) != hipSuccess || per_cu < 1) fprintf(stderr, "kernel_launch: note: occupancy query says %d\n", per_cu);
        (void)hipGetLastError();
        grid = cus;
    }
    if (grid < 0) return;
    if (hipMemsetAsync((char*)d_ws + WS_CTL, 0, CTL_ZERO_BYTES, stream) != hipSuccess) return;
    Args a{};
    for (int i = 0; i < 22; ++i) a.in[i] = d_in[i];
    a.out = (float*)d_out; a.ws = (unsigned char*)d_ws;
#if MK_PER_PHASE
    for (int p = 0; p < N_PHASES; ++p) { a.ph_lo = p; a.ph_hi = p + 1; hipLaunchKernelGGL(mk_fwd, dim3(grid), dim3(NWAVES * 64), LDS_BYTES, stream, a); }
#else
    a.ph_lo = 0; a.ph_hi = N_PHASES; hipLaunchKernelGGL(mk_fwd, dim3(grid), dim3(NWAVES * 64), LDS_BYTES, stream, a);
#endif
}
```

```cpp
#include <hip/hip_runtime.h>
#include <cstdio>
#include <cstdint>
namespace pg8 {
#define PG8_LAS __attribute__((address_space(3)))
typedef unsigned short bf16_t;
typedef short bf16x8 __attribute__((ext_vector_type(8)));
typedef float f32x4 __attribute__((ext_vector_type(4)));
typedef unsigned u32x4 __attribute__((ext_vector_type(4)));
typedef unsigned u32x2 __attribute__((ext_vector_type(2)));
constexpr int BM = 256, BK = 64, HALF = 128, HTB = HALF * BK * 2  , STAGE_BYTES = 8 * HTB, NXCD = 8, WGM = 8;

__host__ __device__ __forceinline__ int lds_byte(int r, int c) { const int st = (r >> 4) * 2 + (c >> 5), rr = r & 15, cc = c & 31, ob = rr * 64 + cc * 2; return st * 1024 + (ob ^ (((ob >> 9) & 1) << 5)); }
__host__ __device__ __forceinline__ void stage_rc(int b, int& R, int& C) { const int st = b / 1024, sb = b % 1024, swz = sb ^ (((sb >> 9) & 1) << 5); R = (st >> 1) * 16 + swz / 64; C = (st & 1) * 32 + (swz % 64) / 2; }
__host__ __device__ __forceinline__ int perm32(int rho) { const int n = rho >> 4, i = rho & 15; return 8 * (i >> 2) + 4 * n + (i & 3); }

struct Unit { int pm, pn; };
struct Gemm { const bf16_t* A; const bf16_t* Bt; int M, N, K, lda, ldb, aoffn, pn_shift, pn_mask, boffk; };

struct StaticOrder {
    int nM, nN, nwg, G, c;
    __host__ __device__ void init(int M, int N, int G_, int c_) { nM = M / BM; nN = N / BM; nwg = nM * nN; G = G_; c = c_; }
    __host__ __device__ bool next(int i, Unit& u) const {
        const long L = (long)i * G + c; if (L >= nwg) return false;
        int wgid = (int)L; { const int q = nwg / NXCD, r = nwg % NXCD, xcd = wgid % NXCD, off = wgid / NXCD; wgid = (xcd < r ? xcd * (q + 1) : r * (q + 1) + (xcd - r) * q) + off; }
        const int nig = WGM * nN, gid = wgid / nig, fm = gid * WGM, gsz = (nM - fm) < WGM ? (nM - fm) : WGM;
        u.pm = fm + ((wgid % nig) % gsz); u.pn = (wgid % nig) / gsz; return true;
    }
    __device__ __forceinline__ void a_ready(const Unit&) const {}
    __device__ __forceinline__ void done(const Unit&) const {}
};
__device__ __forceinline__ unsigned cvt_pk_bf16(float lo, float hi) { unsigned r; asm volatile("v_cvt_pk_bf16_f32 %0, %1, %2" : "=v"(r) : "v"(lo), "v"(hi)); return r; }
template <class Epi, class Sched, bool ALIGN_EPI = false, bool SP2 = false>
__device__ __forceinline__ void gemm_phase(PG8_LAS unsigned char* lds, const Gemm g, const Sched& S, const Epi& E) {
    const int tid = threadIdx.x, wid = __builtin_amdgcn_readfirstlane(tid >> 6), lane = tid & 63, wr = wid >> 2, wc = wid & 3, fr = lane & 15, fq = lane >> 4;
    const int K = g.K, nt = K / BK;
    unsigned voffA[2], voffB[2];
#pragma unroll
    for (int i = 0; i < 2; ++i) { int R, C; stage_rc(tid * 16 + i * 8192, R, C); const int Rb = Epi::PERM ? ((R & ~31) + perm32(R & 31)) : R;
        voffA[i] = (unsigned)(R * g.lda + C) * 2u; voffB[i] = (unsigned)(Rb * g.ldb + C) * 2u; }
    const size_t kstep = (size_t)(BK * 2);
    const size_t hsA = (size_t)HALF * g.lda * 2, hsB = (size_t)HALF * g.ldb * 2;
    const size_t tsA = 2 * hsA, tsB = 2 * hsB;
    const unsigned ldsw = (unsigned)wid * 1024u;
    const int aoff = lds_byte(wr * 64 + fr, fq * 8), boff = lds_byte(wc * 32 + fr, fq * 8);
#define PG8_SA(b, h) (((b) * 2 + (h)) * HTB)
#define PG8_SB(b, h) ((4 + (b) * 2 + (h)) * HTB)
#define PG8_STAGE(bufoff, gbase, voff) do { _Pragma("unroll") for (int _i = 0; _i < 2; ++_i) \
        __builtin_amdgcn_global_load_lds((const unsigned*)((const char*)(gbase) + (voff)[_i]), (PG8_LAS unsigned*)(lds + (bufoff) + ldsw + _i * 8192), 16, 0, 0); } while (0)
#define PG8_LDA(dst, b, h) do { _Pragma("unroll") for (int m = 0; m < 4; ++m) _Pragma("unroll") for (int k = 0; k < 2; ++k) dst[m][k] = *(const PG8_LAS bf16x8*)(lds + PG8_SA(b, h) + aoff + m * 2048 + k * 1024); } while (0)
#define PG8_LDB(dst, b, h) do { _Pragma("unroll") for (int n = 0; n < 2; ++n) _Pragma("unroll") for (int k = 0; k < 2; ++k) dst[n][k] = *(const PG8_LAS bf16x8*)(lds + PG8_SB(b, h) + boff + n * 2048 + k * 1024); } while (0)
#define PG8_MMA(ai, bj, At, Bt) do { __builtin_amdgcn_s_setprio(1); _Pragma("unroll") for (int m = 0; m < 4; ++m) _Pragma("unroll") for (int n = 0; n < 2; ++n) _Pragma("unroll") for (int k = 0; k < 2; ++k) \
        acc[ai][bj][m][n] = __builtin_amdgcn_mfma_f32_16x16x32_bf16(Bt[n][k], At[m][k], acc[ai][bj][m][n], 0, 0, 0); __builtin_amdgcn_s_setprio(0); } while (0)
#define PG8_WAIT_V(n) asm volatile("s_waitcnt vmcnt(" #n ")" ::: "memory")
#define PG8_WAIT_L(n) asm volatile("s_waitcnt lgkmcnt(" #n ")" ::: "memory")
#define PG8_BAR __builtin_amdgcn_s_barrier()
#define PG8_SCHED __builtin_amdgcn_sched_barrier(0)
    Unit cur, nxt; int ui = 0;
    if (!S.next(0, cur)) return;
    f32x4 acc[2][2][4][2];
#pragma unroll
    for (int a = 0; a < 2; ++a)
#pragma unroll
        for (int b = 0; b < 2; ++b)
#pragma unroll
            for (int m = 0; m < 4; ++m)
#pragma unroll
                for (int n = 0; n < 2; ++n) acc[a][b][m][n] = (f32x4){0.f, 0.f, 0.f, 0.f};
    bf16x8 At[4][2], B0[2][2], B1[2][2];
    const char* cA = (const char*)g.A + (size_t)cur.pm * tsA + (size_t)(cur.pn >> g.pn_shift) * g.aoffn; const char* cB = (const char*)g.Bt + (size_t)(cur.pn & g.pn_mask) * tsB + (size_t)(cur.pn >> g.pn_shift) * g.boffk;
    S.a_ready(cur);
    if constexpr (SP2) {
        PG8_STAGE(PG8_SB(0, 0), cB, voffB); PG8_STAGE(PG8_SB(0, 1), cB + hsB, voffB); PG8_STAGE(PG8_SA(0, 0), cA, voffA); PG8_STAGE(PG8_SA(0, 1), cA + hsA, voffA);
        if (wr == 1) PG8_BAR;
        PG8_WAIT_V(2); PG8_BAR;
        PG8_STAGE(PG8_SB(1, 0), cB + kstep, voffB); PG8_STAGE(PG8_SA(1, 0), cA + kstep, voffA); PG8_STAGE(PG8_SB(1, 1), cB + hsB + kstep, voffB);
        PG8_WAIT_V(6); PG8_BAR;
    } else {
        PG8_STAGE(PG8_SB(0, 0), cB, voffB); PG8_STAGE(PG8_SA(0, 0), cA, voffA); PG8_STAGE(PG8_SB(0, 1), cB + hsB, voffB); PG8_STAGE(PG8_SA(0, 1), cA + hsA, voffA);
        if (wr == 1) PG8_BAR;
        PG8_WAIT_V(4); PG8_BAR;
        PG8_STAGE(PG8_SB(1, 0), cB + kstep, voffB); PG8_STAGE(PG8_SA(1, 0), cA + kstep, voffA); PG8_STAGE(PG8_SB(1, 1), cB + hsB + kstep, voffB);
        PG8_WAIT_V(6); PG8_BAR;
    }
    for (;;) {
        const bool has_next = S.next(ui + 1, nxt);
        const char* nA = has_next ? (const char*)g.A + (size_t)nxt.pm * tsA + (size_t)(nxt.pn >> g.pn_shift) * g.aoffn : cA; const char* nB = has_next ? (const char*)g.Bt + (size_t)(nxt.pn & g.pn_mask) * tsB + (size_t)(nxt.pn >> g.pn_shift) * g.boffk : cB;
#pragma nounroll
        for (int t = 0; t < nt; t += 2) {
            const bool last = (t == nt - 2);
            const char* a1 = cA + (size_t)(t + 1) * kstep;
            const char* a2 = last ? nA : cA + (size_t)(t + 2) * kstep; const char* b2 = last ? nB : cB + (size_t)(t + 2) * kstep;
            const char* a3 = a2 + kstep; const char* b3 = b2 + kstep;
            if (last && has_next) S.a_ready(nxt);
            if constexpr (SP2) {
            PG8_LDB(B0, 0, 0); PG8_LDB(B1, 0, 1); PG8_SCHED; PG8_LDA(At, 0, 0); PG8_STAGE(PG8_SA(1, 1), a1 + hsA, voffA);
            PG8_WAIT_V(8); PG8_WAIT_L(0); PG8_BAR; PG8_MMA(0, 0, At, B0); PG8_MMA(0, 1, At, B1); PG8_BAR; PG8_SCHED;
            PG8_LDA(At, 0, 1); PG8_STAGE(PG8_SB(0, 0), b2, voffB); PG8_STAGE(PG8_SB(0, 1), b2 + hsB, voffB); PG8_STAGE(PG8_SA(0, 0), a2, voffA);
            PG8_WAIT_V(8); PG8_WAIT_L(0); PG8_BAR; PG8_MMA(1, 0, At, B0); PG8_MMA(1, 1, At, B1); PG8_BAR; PG8_SCHED;
            PG8_LDB(B0, 1, 0); PG8_LDB(B1, 1, 1); PG8_SCHED; PG8_LDA(At, 1, 0); PG8_STAGE(PG8_SA(0, 1), a2 + hsA, voffA);
            PG8_WAIT_V(8); PG8_WAIT_L(0); PG8_BAR; PG8_MMA(0, 0, At, B0); PG8_MMA(0, 1, At, B1); PG8_BAR; PG8_SCHED;
            PG8_LDA(At, 1, 1); PG8_STAGE(PG8_SB(1, 0), b3, voffB); PG8_STAGE(PG8_SB(1, 1), b3 + hsB, voffB); PG8_STAGE(PG8_SA(1, 0), a3, voffA);
            PG8_WAIT_V(8); PG8_WAIT_L(0); PG8_BAR; PG8_MMA(1, 0, At, B0); PG8_MMA(1, 1, At, B1); PG8_BAR; PG8_SCHED;
            } else {
            PG8_LDB(B0, 0, 0); PG8_SCHED; PG8_LDA(At, 0, 0); PG8_STAGE(PG8_SA(1, 1), a1 + hsA, voffA);
            PG8_WAIT_L(8); PG8_BAR; PG8_WAIT_L(0); PG8_MMA(0, 0, At, B0); PG8_BAR; PG8_SCHED;
            PG8_LDB(B1, 0, 1); PG8_STAGE(PG8_SB(0, 0), b2, voffB);
            PG8_BAR; PG8_WAIT_L(0); PG8_MMA(0, 1, At, B1); PG8_BAR;
            PG8_LDA(At, 0, 1); PG8_STAGE(PG8_SA(0, 0), a2, voffA);
            PG8_BAR; PG8_WAIT_L(0); PG8_MMA(1, 0, At, B0); PG8_BAR; PG8_SCHED;
            PG8_STAGE(PG8_SB(0, 1), b2 + hsB, voffB);
            PG8_WAIT_V(6); PG8_BAR; PG8_MMA(1, 1, At, B1); PG8_BAR;
            PG8_LDB(B0, 1, 0); PG8_SCHED; PG8_LDA(At, 1, 0); PG8_STAGE(PG8_SA(0, 1), a2 + hsA, voffA);
            PG8_WAIT_L(8); PG8_BAR; PG8_WAIT_L(0); PG8_MMA(0, 0, At, B0); PG8_BAR; PG8_SCHED;
            PG8_LDB(B1, 1, 1); PG8_STAGE(PG8_SB(1, 0), b3, voffB);
            PG8_BAR; PG8_WAIT_L(0); PG8_MMA(0, 1, At, B1); PG8_BAR;
            PG8_LDA(At, 1, 1); PG8_STAGE(PG8_SA(1, 0), a3, voffA);
            PG8_BAR; PG8_WAIT_L(0); PG8_MMA(1, 0, At, B0); PG8_BAR; PG8_SCHED;
            PG8_STAGE(PG8_SB(1, 1), b3 + hsB, voffB);
            PG8_WAIT_V(6); PG8_BAR; PG8_MMA(1, 1, At, B1); PG8_BAR;
            }
        }
        if constexpr (ALIGN_EPI) { if (wr == 0) PG8_BAR; }
        if constexpr (!Epi::AFTER_DRAIN) { E(acc, cur, wr, wc, fr, fq); S.done(cur); }
        if (!has_next) break;
#pragma unroll
        for (int a = 0; a < 2; ++a)
#pragma unroll
            for (int b = 0; b < 2; ++b)
#pragma unroll
                for (int m = 0; m < 4; ++m)
#pragma unroll
                    for (int n = 0; n < 2; ++n) acc[a][b][m][n] = (f32x4){0.f, 0.f, 0.f, 0.f};
        cur = nxt; cA = nA; cB = nB; ++ui;
        if constexpr (ALIGN_EPI) { if (wr == 1) PG8_BAR; }
    }
    PG8_WAIT_V(0);
    if constexpr (!ALIGN_EPI) { if (wr == 0) PG8_BAR; }
    PG8_BAR;
    if constexpr (Epi::AFTER_DRAIN) { E.fused(acc, cur, wr, wc, fr, fq, lds, wid, lane); S.done(cur); }
#undef PG8_SA
#undef PG8_SB
#undef PG8_STAGE
#undef PG8_LDA
#undef PG8_LDB
#undef PG8_MMA
#undef PG8_WAIT_V
#undef PG8_WAIT_L
#undef PG8_BAR
#undef PG8_SCHED
}}

constexpr int NWAVES = 8;
#ifndef MK_PER_PHASE
#define MK_PER_PHASE 0
#endif
constexpr int N_PHASES = 15;

constexpr int D = 1024, NB = 4, SEQ = 4096, DB = 128, DSEQ = 8, PAST = 8192, PAGE = 128, NPAGES = 64;
constexpr int NH = 8, QLORA = 384, KVL = 256, NOPE = 128, ROPE = 64, VD = 128, FF = 4096;
constexpr int MP = NB * SEQ, MS = DB * DSEQ, M = MP + MS;
constexpr int NSEQ = NB + DB;
constexpr int DIN = 5824, NIN = 5888;
constexpr int NSM = 768, NBIG = 3072, NQ = 1536;
constexpr int NPOS = SEQ + DSEQ;
constexpr float EPS = 1e-6f;
constexpr float QSCALE = 0.07216878364870322f * 1.4426950408889634f;

constexpr size_t MiB = 1u << 20;
constexpr size_t WS_CTL = 0, CTL_ZERO_BYTES = 1 * MiB;
constexpr size_t WS_MOD = 1 * MiB, WS_TAB = 5 * MiB, WS_WIN = 8 * MiB, WS_WQB = 20 * MiB, WS_WKVB = 22 * MiB, WS_WUK = 23 * MiB, WS_WO = 24 * MiB, WS_W1 = 26 * MiB, WS_W2 = 34 * MiB;
constexpr size_t WS_U = 42 * MiB, WS_SM = 76 * MiB, WS_BIG = 128 * MiB, WS_QA = 298 * MiB, WS_CKVN = 311 * MiB, WS_QB = 320 * MiB, WS_KP = 371 * MiB, WS_VP = 419 * MiB;
constexpr size_t WS_QL = 451 * MiB, WS_KNEW = 456 * MiB, WS_OLAT = 457 * MiB, WS_ATT = 461 * MiB, WS_MERGED = 495 * MiB, WS_X1 = 529 * MiB, WS_HDN = 597 * MiB, WS_PART = 733 * MiB, WS_ML = 766 * MiB, WS_P1 = 768 * MiB, WS_P2 = 784 * MiB, WS_END = 816 * MiB;
static_assert(WS_MOD + (size_t)NSEQ * 6 * D * 4 <= WS_TAB && WS_TAB + (size_t)NPOS * 32 * 8 <= WS_WIN && WS_WIN + (size_t)NIN * D * 2 <= WS_WQB && WS_WQB + (size_t)NQ * QLORA * 2 <= WS_WKVB, "ws map 1");
static_assert(WS_WKVB + (size_t)2048 * 256 * 2 <= WS_WUK && WS_WUK + (size_t)2048 * 256 * 2 <= WS_WO && WS_WO + (size_t)D * D * 2 <= WS_W1 && WS_W1 + (size_t)FF * D * 2 <= WS_W2 && WS_W2 + (size_t)FF * D * 2 <= WS_U, "ws map 2");
static_assert(WS_U + (size_t)M * D * 2 <= WS_SM && WS_SM + (size_t)M * NSM * 4 <= WS_BIG && WS_BIG + (size_t)M * NBIG * 2 <= WS_QA && WS_QA + (size_t)M * QLORA * 2 <= WS_CKVN && WS_CKVN + (size_t)M * KVL * 2 <= WS_QB, "ws map 3");
static_assert(WS_QB + (size_t)M * NQ * 2 <= WS_KP && WS_KP + (size_t)MP * NH * 192 * 2 <= WS_VP && WS_VP + (size_t)MP * NH * 128 * 2 <= WS_QL && WS_QL + (size_t)MS * NH * 320 * 2 <= WS_KNEW && WS_KNEW + (size_t)MS * 320 * 2 <= WS_OLAT, "ws map 4");
static_assert(WS_OLAT + (size_t)MS * NH * 256 * 2 <= WS_ATT && WS_ATT + (size_t)M * D * 2 <= WS_MERGED && WS_MERGED + (size_t)M * D * 2 <= WS_X1 && WS_X1 + (size_t)M * D * 4 <= WS_HDN && WS_HDN + (size_t)M * FF * 2 <= WS_PART, "ws map 5");
constexpr size_t O_Y = 0, O_CKVP = (size_t)M * D, O_KRP = O_CKVP + (size_t)MP * KVL, O_CVP = O_KRP + (size_t)MP * ROPE, O_CKVS = O_CVP + (size_t)NB * 2 * D, O_KRS = O_CKVS + (size_t)MS * KVL, O_CVS = O_KRS + (size_t)MS * ROPE, O_END = O_CVS + (size_t)DB * 2 * D;
static_assert(O_END == 23666688, "d_out size");
constexpr int CW_TMO = 0, CW_CODE = 1, CW_BAR = 4096;
constexpr int RING_OFF = 0, RING_BYTES = 131072;
constexpr int LDSCTL_OFF = RING_BYTES, MISC_OFF = LDSCTL_OFF + 320;
constexpr int LDS_BYTES = 147456;
static_assert(MISC_OFF + 128 <= LDS_BYTES, "LDS map");

#define GAS __attribute__((address_space(1)))
#define LAS __attribute__((address_space(3)))
typedef unsigned short bf16;
typedef unsigned v4u __attribute__((ext_vector_type(4)));
typedef unsigned v2u __attribute__((ext_vector_type(2)));
typedef float f32x4 __attribute__((ext_vector_type(4)));
typedef float f32x2 __attribute__((ext_vector_type(2)));
typedef float f32x16 __attribute__((ext_vector_type(16)));
typedef short bf16x8 __attribute__((ext_vector_type(8)));
typedef GAS unsigned gu32;
#define RLX_AGENT __ATOMIC_RELAXED, __HIP_MEMORY_SCOPE_AGENT
#define LDS_WAIT() asm volatile("s_waitcnt lgkmcnt(0)" ::: "memory")
#define VM_WAIT() asm volatile("s_waitcnt vmcnt(0)" ::: "memory")
__device__ __forceinline__ unsigned f2bf(float f) { unsigned u = __builtin_bit_cast(unsigned, f); return (u + 0x7fffu + ((u >> 16) & 1u)) >> 16; }
__device__ __forceinline__ unsigned pk2(float lo, float hi) { return f2bf(lo) | (f2bf(hi) << 16); }
__device__ __forceinline__ float bf2f(unsigned short b) { return __builtin_bit_cast(float, (unsigned)b << 16); }
__device__ __forceinline__ float bflo(unsigned w) { return __builtin_bit_cast(float, w << 16); }
__device__ __forceinline__ float bfhi(unsigned w) { return __builtin_bit_cast(float, w & 0xffff0000u); }
#define XB_TMO      128
#define XB_XCNT(j)  (256  + 64 * (j))
#define XB_XSUB(j)  (1280 + 64 * (j))
#define XB_XGEN(j)  (2304 + 64 * (j))
#define XB_TOP      3328
#define XB_TOPGEN   3392
#define XCD_BAR_WORDS 3456
#define XB_SPIN_CAP (1u << 18)

__device__ __forceinline__ unsigned xb_ld(unsigned* p)              { return __hip_atomic_load(p, __ATOMIC_RELAXED, __HIP_MEMORY_SCOPE_AGENT); }
__device__ __forceinline__ unsigned xb_add(unsigned* p, unsigned v) { return __hip_atomic_fetch_add(p, v, __ATOMIC_RELAXED, __HIP_MEMORY_SCOPE_AGENT); }
__device__ __forceinline__ unsigned xb_xcc_id() { return (unsigned)__builtin_amdgcn_s_getreg((3 << 11) | 20) & 0xFu; }
#define XB_SPIN(cond, bar) do { unsigned _sp = 0; while (cond) { __builtin_amdgcn_s_sleep(1); \
    if ((++_sp & 255u) == 0u) { if (xb_ld(&(bar)[XB_TMO])) break; if (_sp > XB_SPIN_CAP) { atomicAdd(&(bar)[XB_TMO], 1u); break; } } } } while (0)

struct XcdBarrier {
    unsigned* bar; unsigned x;
    volatile LAS unsigned* st;
};

__device__ __forceinline__ XcdBarrier xcd_barrier_post(unsigned* bar, volatile LAS unsigned* st) {
    XcdBarrier b; b.bar = bar; b.x = xb_xcc_id(); b.st = st;
    if (threadIdx.x == 0) (void)xb_add(&bar[XB_XCNT(b.x)], 1u);
    return b;
}
__device__ __forceinline__ void xcd_barrier_complete(unsigned* bar, unsigned x, unsigned& nloc, unsigned& nx) {
    const unsigned G = gridDim.x * gridDim.y * gridDim.z;
    unsigned sum, cnt, mine, sp = 0u;
    for (;;) {
        sum = 0u; cnt = 0u; mine = 0u;
#pragma unroll
        for (unsigned j = 0; j < 16; ++j) { const unsigned c = xb_ld(&bar[XB_XCNT(j)]); sum += c; cnt += (c > 0u) ? 1u : 0u; mine = (j == x) ? c : mine; }
        if (sum == G) break;
        __builtin_amdgcn_s_sleep(1);
        if ((++sp & 255u) == 0u) { if (xb_ld(&bar[XB_TMO])) break; if (sp > XB_SPIN_CAP) { atomicAdd(&bar[XB_TMO], 1u); break; } }
    }
    nloc = mine > 0u ? mine : 1u; nx = cnt > 0u ? cnt : 1u;
}

__device__ __forceinline__ void xcd_barrier(const XcdBarrier& b) {
    asm volatile("s_waitcnt vmcnt(0)" ::: "memory");
    __syncthreads();
    if (threadIdx.x == 0) {
        unsigned* bar = b.bar;
        __builtin_amdgcn_s_waitcnt(0);
        unsigned nloc = b.st[0], nx = b.st[1];
        if (nloc == 0u) { xcd_barrier_complete(bar, b.x, nloc, nx); b.st[0] = nloc; b.st[1] = nx; }
        const unsigned old = xb_add(&bar[XB_XSUB(b.x)], 1u);
        const unsigned gen = old / nloc;
        if (old + 1u == (gen + 1u) * nloc) {
            __builtin_amdgcn_fence(__ATOMIC_RELEASE, "agent");
            asm volatile("s_waitcnt vmcnt(0)" ::: "memory");
            const unsigned og = xb_add(&bar[XB_TOP], 1u);
            const unsigned tg = og / nx;
            if (og + 1u == (tg + 1u) * nx) xb_add(&bar[XB_TOPGEN], 1u);
            else XB_SPIN(xb_ld(&bar[XB_TOPGEN]) == tg, bar);
            __builtin_amdgcn_fence(__ATOMIC_ACQUIRE, "agent");
            xb_add(&bar[XB_XGEN(b.x)], 1u);
            asm volatile("s_waitcnt vmcnt(0)" ::: "memory");
        } else {
            XB_SPIN(xb_ld(&bar[XB_XGEN(b.x)]) == gen, bar);
            __builtin_amdgcn_fence(__ATOMIC_ACQUIRE, "agent");
            asm volatile("s_waitcnt vmcnt(0)" ::: "memory");
        }
    }
    __syncthreads();
}
struct Frame {
    LAS unsigned char* lds; volatile LAS unsigned* MISC; gu32* ctl;
    int tid, lane, wave, G, gw, NGW;
    const float *x_p, *x_s, *cache_ckv, *cache_kr, *state_conv; const int* page_table;
    const float *c_p, *c_s, *w_ada, *b_ada, *g_attn, *w_in, *g_q, *w_q_b, *g_kv, *w_kv_b, *conv_w, *w_o, *g_mlp, *w_1, *w_2, *g_final;
    float* out; unsigned char* ws;
};
__device__ const double ROPE_INV[32] = {1.0, 0.7498942093324559, 0.5623413251903491, 0.4216965034285822, 0.31622776601683794, 0.23713737056616552, 0.1778279410038923, 0.1333521432163324,
    0.1, 0.07498942093324558, 0.05623413251903491, 0.042169650342858224, 0.03162277660168379, 0.023713737056616554, 0.01778279410038923, 0.01333521432163324,
    0.01, 0.007498942093324558, 0.005623413251903491, 0.004216965034285823, 0.0031622776601683794, 0.0023713737056616554, 0.0017782794100389228, 0.001333521432163324,
    0.001, 0.0007498942093324559, 0.0005623413251903491, 0.00042169650342858224, 0.00031622776601683794, 0.00023713737056616554, 0.00017782794100389227, 0.0001333521432163324};

__device__ __forceinline__ float wave_sum(float v) {
#pragma unroll
    for (int o = 1; o < 64; o <<= 1) v += __shfl_xor(v, o);
    return v;
}
__device__ __forceinline__ float wave_max(float v) {
#pragma unroll
    for (int o = 1; o < 64; o <<= 1) v = fmaxf(v, __shfl_xor(v, o));
    return v;
}
__device__ __forceinline__ float silu_f(float x) { return x / (1.f + __expf(-x)); }
__device__ __forceinline__ float sigmoid_f(float x) { return 1.f / (1.f + __expf(-x)); }
__device__ __forceinline__ int seq_of_row(int row) { return row < MP ? (row >> 12) : NB + ((row - MP) >> 3); }
__device__ __forceinline__ int pidx_of_row(int row) { return row < MP ? (row & (SEQ - 1)) : SEQ + ((row - MP) & (DSEQ - 1)); }
__device__ __forceinline__ void store8bf(bf16* p, f32x4 a, f32x4 b) {
    v4u w; w.x = pg8::cvt_pk_bf16(a[0], a[1]); w.y = pg8::cvt_pk_bf16(a[2], a[3]); w.z = pg8::cvt_pk_bf16(b[0], b[1]); w.w = pg8::cvt_pk_bf16(b[2], b[3]);
    *(v4u*)p = w;
}
__device__ __forceinline__ void store4bf(bf16* p, f32x4 a) { v2u w; w.x = pg8::cvt_pk_bf16(a[0], a[1]); w.y = pg8::cvt_pk_bf16(a[2], a[3]); *(v2u*)p = w; }

template <int MODE> struct Epi {
    static constexpr bool PERM = true, AFTER_DRAIN = false;
    unsigned char* ws; const float* x_p; const float* x_s; float* out;
    __device__ __forceinline__ void operator()(const pg8::f32x4 (&acc)[2][2][4][2], const pg8::Unit& u, int wr, int wc, int fr, int fq) const {
        const int rowb = u.pm * 256 + wr * 64 + fr, cw = wc * 32 + 8 * fq;
#pragma unroll
        for (int ai = 0; ai < 2; ++ai)
#pragma unroll
            for (int m = 0; m < 4; ++m) {
                const int row = rowb + ai * 128 + m * 16;
#pragma unroll
                for (int bj = 0; bj < 2; ++bj) {
                    const f32x4 v0 = acc[ai][bj][m][0], v1 = acc[ai][bj][m][1];
                    const int col = u.pn * 256 + bj * 128 + cw;
                    if constexpr (MODE == 1) {
                        bf16* big = (bf16*)(ws + WS_BIG) + (size_t)row * NBIG;
                        if (u.pn < 3) { float* p = (float*)(ws + WS_SM) + (size_t)row * NSM + col; *(f32x4*)p = v0; *(f32x4*)(p + 4) = v1; }
                        else if (u.pn < 11) { store4bf(big + ((col - 768) >> 1), v0 * v1); }
                        else if (u.pn < 19) { f32x4 s; s[0] = sigmoid_f(v1[0]); s[1] = sigmoid_f(v1[1]); s[2] = sigmoid_f(v1[2]); s[3] = sigmoid_f(v1[3]);
                                              store4bf(big + 1024 + ((col - 2816) >> 1), v0 * s); }
                        else { f32x4 a, b;
#pragma unroll
                               for (int e = 0; e < 4; ++e) { a[e] = sigmoid_f(v0[e]); b[e] = sigmoid_f(v1[e]); }
                               store8bf(big + 2048 + (col - 4864), a, b); }
                    } else if constexpr (MODE == 2) {
                        bf16* qb = (bf16*)(ws + WS_QB) + (size_t)row * NQ;
                        if (u.pn < 4) { store8bf(qb + col, v0 * QSCALE, v1 * QSCALE); }
                        else {
                            const int r = col - 1024, h = r >> 6, q4 = ((r & 63) >> 3) * 4;
                            const float* tb = (const float*)(ws + WS_TAB) + ((size_t)pidx_of_row(row) * 32 + q4) * 2;
                            const f32x4 t01 = *(const f32x4*)tb, t23 = *(const f32x4*)(tb + 4);
                            f32x4 cs = {t01[0], t01[2], t23[0], t23[2]}, sn = {t01[1], t01[3], t23[1], t23[3]};
                            const f32x4 o1 = (v0 * cs - v1 * sn) * QSCALE, o2 = (v1 * cs + v0 * sn) * QSCALE;
                            store4bf(qb + 1024 + h * 64 + q4, o1); store4bf(qb + 1024 + h * 64 + 32 + q4, o2);
                            if (row >= MP) { bf16* ql = (bf16*)(ws + WS_QL) + ((size_t)(row - MP) * NH + h) * 320 + 256; store4bf(ql + q4, o1); store4bf(ql + 32 + q4, o2); }
                        }
                    } else if constexpr (MODE == 3) {
                        const size_t tok = (size_t)((row >> 12) * NH + u.pn) * SEQ + (row & (SEQ - 1));
                        if (bj == 0) store8bf((bf16*)(ws + WS_KP) + tok * 192 + cw, v0, v1);
                        else         store8bf((bf16*)(ws + WS_VP) + tok * 128 + cw, v0, v1);
                    } else if constexpr (MODE == 4) {
                        store8bf((bf16*)(ws + WS_QL) + ((size_t)row * NH + u.pn) * 320 + bj * 128 + cw, v0, v1);
                    } else if constexpr (MODE == 5) {
                        if (bj == 1) store8bf((bf16*)(ws + WS_ATT) + (size_t)(MP + row) * D + u.pn * 128 + cw, v0, v1);
                    } else if constexpr (MODE == 6 || MODE == 8) {
                        const float* g = (const float*)(ws + WS_MOD) + (size_t)seq_of_row(row) * (6 * D) + (MODE == 6 ? 2 : 5) * D + col;
                        const float* xr = (MODE == 6) ? ((row < MP ? x_p + (size_t)row * D : x_s + (size_t)(row - MP) * D) + col) : ((const float*)(ws + WS_X1) + (size_t)row * D + col);
                        float* o = (MODE == 6) ? ((float*)(ws + WS_X1) + (size_t)row * D + col) : (out + O_Y + (size_t)row * D + col);
                        const f32x4 g0 = *(const f32x4*)g, g1 = *(const f32x4*)(g + 4), x0 = *(const f32x4*)xr, x1 = *(const f32x4*)(xr + 4);
                        *(f32x4*)o = x0 + g0 * v0; *(f32x4*)(o + 4) = x1 + g1 * v1;
                    } else if constexpr (MODE == 9 || MODE == 10) {
                        float* p = (float*)(ws + (MODE == 9 ? WS_P1 : WS_P2)) + ((size_t)(u.pn >> 2) * MS + row) * D + (u.pn & 3) * 256 + bj * 128 + cw;
                        *(f32x4*)p = v0; *(f32x4*)(p + 4) = v1;
                    } else if constexpr (MODE == 7) {
                        f32x4 a = v0, b = v1;
#pragma unroll
                        for (int e = 0; e < 4; ++e) { a[e] = fmaxf(a[e], 0.f); a[e] *= a[e]; b[e] = fmaxf(b[e], 0.f); b[e] *= b[e]; }
                        store8bf((bf16*)(ws + WS_HDN) + (size_t)row * FF + col, a, b);
                    }
                }
                asm volatile("" ::: "memory");
            }
    }
};

template <int MAP> __device__ __forceinline__ int wt_row(int n) {
    if constexpr (MAP == 0) return n;
    else if constexpr (MAP == 1) {
        if (n < 704) return n;
        if (n < 1728) { const int j = n - 704;  return 768 + 2048 + 8 * (j >> 2) + (j & 3); }
        if (n < 2752) { const int j = n - 1728; return 768 + 8 * (j >> 2) + (j & 3); }
        if (n < 3776) { const int j = n - 2752; return 768 + 8 * (j >> 2) + 4 + (j & 3); }
        if (n < 4800) { const int j = n - 3776; return 768 + 4096 + j; }
        { const int j = n - 4800; return 768 + 2048 + 8 * (j >> 2) + 4 + (j & 3); } }
    else { const int h = n / 192, j = n - h * 192;
        if (j < 128) return h * 128 + j;
        const int i = j - 128, x2 = i >> 5, idx = i & 31;
        return 1024 + h * 64 + 8 * (idx >> 2) + 4 * x2 + (idx & 3); }
}
template <int MAP> __device__ __forceinline__ void transpose_item(const float* W, int K, int N, bf16* WT, const float* kscale, LAS float* scr, int item, int lane) {
    const int nblk = N / 32, kb = item / nblk, nb = item % nblk, k0 = 64 * kb, n0 = 32 * nb;
#pragma unroll 8
    for (int i = 0; i < 32; ++i) { const int kk = 2 * i + (lane >> 5); scr[kk * 33 + (lane & 31)] = W[(size_t)(k0 + kk) * N + n0 + (lane & 31)]; }
    LDS_WAIT(); asm volatile("" ::: "memory");
    const int c = lane & 7;
    float ks[8];
#pragma unroll
    for (int e = 0; e < 8; ++e) ks[e] = kscale ? kscale[k0 + 8 * c + e] : 1.f;
#pragma unroll
    for (int j = 0; j < 4; ++j) { const int n = (lane >> 3) + 8 * j; const LAS float* s = scr + (8 * c) * 33 + n;
        v4u o; o.x = pk2(s[0 * 33] * ks[0], s[1 * 33] * ks[1]); o.y = pk2(s[2 * 33] * ks[2], s[3 * 33] * ks[3]); o.z = pk2(s[4 * 33] * ks[4], s[5 * 33] * ks[5]); o.w = pk2(s[6 * 33] * ks[6], s[7 * 33] * ks[7]);
        *(GAS v4u*)(WT + (size_t)wt_row<MAP>(n0 + n) * K + k0 + 8 * c) = o; }
    LDS_WAIT(); asm volatile("" ::: "memory");
}
__device__ __forceinline__ int crow32(int r, int hi) { return (r & 3) + 8 * (r >> 2) + 4 * hi; }
__device__ __forceinline__ bf16x8 pack8f(const float* a) {
    v4u w; w.x = pg8::cvt_pk_bf16(a[0], a[1]); w.y = pg8::cvt_pk_bf16(a[2], a[3]); w.z = pg8::cvt_pk_bf16(a[4], a[5]); w.w = pg8::cvt_pk_bf16(a[6], a[7]);
    return __builtin_bit_cast(bf16x8, w);
}
__device__ __forceinline__ void adaln_task(Frame& F, int et) {
    const int e0 = et * 32, r = F.lane & 31, h = F.lane >> 5, w = F.wave;
    f32x16 acc[5];
#pragma unroll
    for (int st = 0; st < 5; ++st)
#pragma unroll
        for (int i = 0; i < 16; ++i) acc[st][i] = 0.f;
    for (int ks = 0; ks < 8; ++ks) {
        const int k0 = w * 128 + ks * 16 + 8 * h;
        float a[8];
#pragma unroll
        for (int j = 0; j < 8; ++j) a[j] = F.w_ada[(size_t)(k0 + j) * (6 * D) + e0 + r];
        const bf16x8 af = pack8f(a);
#pragma unroll
        for (int st = 0; st < 5; ++st) {
            int s = 32 * st + r; s = s < NSEQ ? s : NSEQ - 1;
            const float* cp = (s < NB ? F.c_p + (size_t)s * D : F.c_s + (size_t)(s - NB) * D) + k0;
            const f32x4 c0 = *(const f32x4*)cp, c1 = *(const f32x4*)(cp + 4);
            float b[8] = {silu_f(c0[0]), silu_f(c0[1]), silu_f(c0[2]), silu_f(c0[3]), silu_f(c1[0]), silu_f(c1[1]), silu_f(c1[2]), silu_f(c1[3])};
            acc[st] = __builtin_amdgcn_mfma_f32_32x32x16_bf16(af, pack8f(b), acc[st], 0, 0, 0);
        }
    }
    LAS float* red = (LAS float*)F.lds;
    float* mod = (float*)(F.ws + WS_MOD);
#pragma unroll
    for (int st = 0; st < 5; ++st) {
#pragma unroll
        for (int i = 0; i < 16; ++i) red[(w * 16 + i) * 64 + F.lane] = acc[st][i];
        __syncthreads();
#pragma unroll
        for (int q = 0; q < 2; ++q) {
            const int idx = F.tid + 512 * q, reg = idx >> 6, lo = idx & 63;
            float sum = 0.f;
#pragma unroll
            for (int ww = 0; ww < 8; ++ww) sum += red[ww * 1024 + idx];
            const int s = 32 * st + (lo & 31), e = e0 + crow32(reg, lo >> 5);
            if (s < NSEQ) mod[(size_t)s * (6 * D) + e] = sum + F.b_ada[e];
        }
        __syncthreads();
    }
}
__device__ __forceinline__ void p0_prologue(Frame& F) {
    for (int et = blockIdx.x; et < (6 * D) / 32; et += F.G) adaln_task(F, et);
    __syncthreads();
    LAS float* scr = (LAS float*)(F.lds + RING_OFF + F.wave * 16384);
    constexpr int I_IN = (D / 64) * (DIN / 32), I_QB = (QLORA / 64) * (NQ / 32), I_KVB = (KVL / 64) * (2048 / 32), I_O = (D / 64) * (D / 32), I_1 = (D / 64) * (FF / 32), I_2 = (FF / 64) * (D / 32);
    constexpr int NITEMS = I_IN + I_QB + I_KVB + I_O + I_1 + I_2;
    for (int it = F.gw; it < NITEMS; it += F.NGW) {
        int r = it;
        if (r < I_IN) { transpose_item<1>(F.w_in, D, DIN, (bf16*)(F.ws + WS_WIN), nullptr, scr, r, F.lane); continue; } r -= I_IN;
        if (r < I_QB) { transpose_item<2>(F.w_q_b, QLORA, NQ, (bf16*)(F.ws + WS_WQB), F.g_q, scr, r, F.lane); continue; } r -= I_QB;
        if (r < I_KVB) { transpose_item<0>(F.w_kv_b, KVL, 2048, (bf16*)(F.ws + WS_WKVB), nullptr, scr, r, F.lane); continue; } r -= I_KVB;
        if (r < I_O) { transpose_item<0>(F.w_o, D, D, (bf16*)(F.ws + WS_WO), nullptr, scr, r, F.lane); continue; } r -= I_O;
        if (r < I_1) { transpose_item<0>(F.w_1, D, FF, (bf16*)(F.ws + WS_W1), nullptr, scr, r, F.lane); continue; } r -= I_1;
        transpose_item<0>(F.w_2, FF, D, (bf16*)(F.ws + WS_W2), nullptr, scr, r, F.lane);
    }
    const int gt = F.gw * 64 + F.lane, NGT = F.NGW * 64;
    for (int i = gt; i < 64 * D / 8; i += NGT) *(v4u*)((bf16*)(F.ws + WS_WIN) + (size_t)704 * D + (size_t)i * 8) = (v4u){0u, 0u, 0u, 0u};
    for (int i = gt; i < 2048 * 256 / 8; i += NGT) {
        const int row = i >> 5, k8 = (i & 31) * 8, hh = row >> 8, c = row & 255; v4u o = {0u, 0u, 0u, 0u};
        if (k8 < 128) { const float* s = F.w_kv_b + (size_t)c * 2048 + hh * 256 + k8; const f32x4 a = *(const f32x4*)s, b = *(const f32x4*)(s + 4);
            o.x = pk2(a[0], a[1]); o.y = pk2(a[2], a[3]); o.z = pk2(b[0], b[1]); o.w = pk2(b[2], b[3]); }
        *(v4u*)((bf16*)(F.ws + WS_WUK) + (size_t)row * 256 + k8) = o;
    }
    for (int i = gt; i < NPOS * 32; i += NGT) {
        const int p = i >> 5, fi = i & 31; const double pos = (double)(p < SEQ ? p : p + (PAST - SEQ));
        const double rev = pos * ROPE_INV[fi] * 0.15915494309189535; const float fr = (float)(rev - __builtin_rint(rev));
        f32x2 cs; cs.x = __builtin_amdgcn_cosf(fr); cs.y = __builtin_amdgcn_sinf(fr);
        *((f32x2*)(F.ws + WS_TAB) + i) = cs;
    }
}
__device__ __forceinline__ void norm_mod_rows4(Frame& F, const float* src, const float* g, const float* sc, const float* sh, bf16* dst) {
    f32x4 v[4][4]; float s[4];
#pragma unroll
    for (int r = 0; r < 4; ++r)
#pragma unroll
        for (int j = 0; j < 4; ++j) v[r][j] = *((const f32x4*)(src + (size_t)r * D) + F.lane + 64 * j);
#pragma unroll
    for (int r = 0; r < 4; ++r) { s[r] = 0.f;
#pragma unroll
        for (int j = 0; j < 4; ++j) s[r] += (v[r][j].x * v[r][j].x + v[r][j].y * v[r][j].y) + (v[r][j].z * v[r][j].z + v[r][j].w * v[r][j].w);
        s[r] = 1.f / sqrtf(wave_sum(s[r]) * (1.f / D) + EPS); }
#pragma unroll
    for (int j = 0; j < 4; ++j) { const int c4 = F.lane + 64 * j; const f32x4 gg = *((const f32x4*)g + c4) * (*((const f32x4*)sc + c4) + 1.f), hh = *((const f32x4*)sh + c4);
#pragma unroll
        for (int r = 0; r < 4; ++r) store4bf(dst + (size_t)r * D + c4 * 4, (v[r][j] * s[r]) * gg + hh); }
}
__device__ __forceinline__ void small_row(Frame& F, int m) {
    const float* sm = (const float*)(F.ws + WS_SM) + (size_t)m * NSM;
    const int l = F.lane; const bool samp = m >= MP; const int ms = m - MP;
    const f32x4 qa = *((const f32x4*)sm + l); const f32x2 qb = *((const f32x2*)(sm + 256) + l);
    float s = (qa.x * qa.x + qa.y * qa.y) + (qa.z * qa.z + qa.w * qa.w) + (qb.x * qb.x + qb.y * qb.y);
    const float rq = 1.f / sqrtf(wave_sum(s) * (1.f / QLORA) + EPS);
    bf16* qo = (bf16*)(F.ws + WS_QA) + (size_t)m * QLORA;
    store4bf(qo + 4 * l, qa * rq); *(unsigned*)(qo + 256 + 2 * l) = pg8::cvt_pk_bf16(qb.x * rq, qb.y * rq);
    const f32x4 kv = *((const f32x4*)(sm + 384) + l);
    s = (kv.x * kv.x + kv.y * kv.y) + (kv.z * kv.z + kv.w * kv.w);
    const float rk = 1.f / sqrtf(wave_sum(s) * (1.f / KVL) + EPS);
    const f32x4 kn = (kv * rk) * *((const f32x4*)F.g_kv + l);
    float* ock = samp ? F.out + O_CKVS + (size_t)ms * KVL : F.out + O_CKVP + (size_t)m * KVL;
    *((f32x4*)ock + l) = kn;
    store4bf((bf16*)(F.ws + WS_CKVN) + (size_t)m * KVL + 4 * l, kn);
    if (samp) store4bf((bf16*)(F.ws + WS_KNEW) + (size_t)ms * 320 + 4 * l, kn);
    if (l < 32) {
        const float x1 = sm[640 + l], x2 = sm[672 + l];
        const f32x2 cs = *((const f32x2*)(F.ws + WS_TAB) + (size_t)pidx_of_row(m) * 32 + l);
        const float o1 = x1 * cs.x - x2 * cs.y, o2 = x2 * cs.x + x1 * cs.y;
        float* okr = samp ? F.out + O_KRS + (size_t)ms * ROPE : F.out + O_KRP + (size_t)m * ROPE;
        okr[l] = o1; okr[32 + l] = o2;
        const bf16 b1 = (bf16)f2bf(o1), b2 = (bf16)f2bf(o2);
        if (samp) { bf16* kn2 = (bf16*)(F.ws + WS_KNEW) + (size_t)ms * 320 + 256; kn2[l] = b1; kn2[32 + l] = b2; }
        else { const int b = m >> 12, t = m & (SEQ - 1);
#pragma unroll
            for (int hh = 0; hh < NH; ++hh) { bf16* kp = (bf16*)(F.ws + WS_KP) + ((size_t)(b * NH + hh) * SEQ + t) * 192 + 128; kp[l] = b1; kp[32 + l] = b2; } }
    }
    const int t = samp ? (ms & (DSEQ - 1)) : (m & (SEQ - 1)), T = samp ? DSEQ : SEQ;
    if (t >= T - 2) {
        const bf16* big = (const bf16*)(F.ws + WS_BIG) + (size_t)m * NBIG;
        float* oc = (samp ? F.out + O_CVS + (size_t)(ms >> 3) * 2 * D : F.out + O_CVP + (size_t)(m >> 12) * 2 * D) + (size_t)(t - (T - 2)) * D;
#pragma unroll
        for (int j = 0; j < 2; ++j) { const int c8 = (l + 64 * j) * 8;
            const v4u cx = *(const v4u*)(big + c8);
            f32x4 a = {bflo(cx.x), bfhi(cx.x), bflo(cx.y), bfhi(cx.y)}, b = {bflo(cx.z), bfhi(cx.z), bflo(cx.w), bfhi(cx.w)};
            *(f32x4*)(oc + c8) = a; *(f32x4*)(oc + c8 + 4) = b; }
    }
}
__device__ __forceinline__ void naive_attn_prompt_row(Frame& F, int rid) {
    const int h = rid & 7, m = rid >> 3, b = m >> 12, t = m & (SEQ - 1), l = F.lane;
    LAS float* qs = (LAS float*)(F.lds + F.wave * 8192); LAS float* sc = qs + 320;
    const bf16* qb = (const bf16*)(F.ws + WS_QB) + (size_t)m * NQ;
    qs[l] = bf2f(qb[h * 128 + l]); qs[64 + l] = bf2f(qb[h * 128 + 64 + l]); qs[128 + l] = bf2f(qb[1024 + h * 64 + l]);
    LDS_WAIT(); asm volatile("" ::: "memory");
    const bf16* K = (const bf16*)(F.ws + WS_KP) + (size_t)(b * NH + h) * SEQ * 192; const bf16* V = (const bf16*)(F.ws + WS_VP) + (size_t)(b * NH + h) * SEQ * 128;
    const int nk = t + 1; float mx = -1e30f, lsum = 0.f, o0 = 0.f, o1 = 0.f;
    for (int c0 = 0; c0 < nk; c0 += 1024) {
        const int cn = (nk - c0) < 1024 ? (nk - c0) : 1024; float cm = -1e30f;
        for (int i = l; i < cn; i += 64) { const bf16* kr = K + (size_t)(c0 + i) * 192; float s = 0.f;
#pragma unroll 4
            for (int d8 = 0; d8 < 24; ++d8) { const v4u kk = *(const v4u*)(kr + d8 * 8); const f32x4 qa = *(const LAS f32x4*)(qs + d8 * 8), qc = *(const LAS f32x4*)(qs + d8 * 8 + 4);
                s += bflo(kk.x) * qa.x + bfhi(kk.x) * qa.y + bflo(kk.y) * qa.z + bfhi(kk.y) * qa.w + bflo(kk.z) * qc.x + bfhi(kk.z) * qc.y + bflo(kk.w) * qc.z + bfhi(kk.w) * qc.w; }
            sc[i] = s; cm = fmaxf(cm, s); }
        cm = wave_max(cm); const float mn = fmaxf(mx, cm), alpha = exp2f(mx - mn); mx = mn; o0 *= alpha; o1 *= alpha; lsum *= alpha;
        float ps = 0.f;
        for (int i = l; i < cn; i += 64) { const float p = exp2f(sc[i] - mn); sc[i] = p; ps += p; }
        lsum += wave_sum(ps);
        LDS_WAIT(); asm volatile("" ::: "memory");
        for (int i = 0; i < cn; ++i) { const float p = sc[i]; const unsigned vv = *(const unsigned*)(V + (size_t)(c0 + i) * 128 + 2 * l); o0 += p * bflo(vv); o1 += p * bfhi(vv); }
        LDS_WAIT(); asm volatile("" ::: "memory");
    }
    const float inv = 1.f / lsum;
    *(unsigned*)((bf16*)(F.ws + WS_ATT) + (size_t)m * D + h * 128 + 2 * l) = pg8::cvt_pk_bf16(o0 * inv, o1 * inv);
}
__device__ __forceinline__ void naive_attn_decode_row(Frame& F, int rid) {
    const int h = rid & 7, sm = rid >> 3, sb = sm >> 3, t = sm & 7, l = F.lane;
    LAS float* qs = (LAS float*)(F.lds + F.wave * 8192); LAS float* sc = qs + 320;
    const bf16* ql = (const bf16*)(F.ws + WS_QL) + ((size_t)sm * NH + h) * 320;
#pragma unroll
    for (int j = 0; j < 5; ++j) qs[l + 64 * j] = bf2f(ql[l + 64 * j]);
    LDS_WAIT(); asm volatile("" ::: "memory");
    const int* pt = F.page_table + sb * NPAGES; const bf16* knew = (const bf16*)(F.ws + WS_KNEW) + (size_t)sb * DSEQ * 320;
    const int nk = PAST + t + 1; float mx = -1e30f, lsum = 0.f; f32x4 o = {0.f, 0.f, 0.f, 0.f};
    for (int c0 = 0; c0 < nk; c0 += 1024) {
        const int cn = (nk - c0) < 1024 ? (nk - c0) : 1024; float cm = -1e30f;
        for (int i = l; i < cn; i += 64) { const int j = c0 + i; float s = 0.f;
            if (j < PAST) { const size_t prow = (size_t)pt[j >> 7] * PAGE + (j & 127); const float* ck = F.cache_ckv + prow * KVL; const float* kr = F.cache_kr + prow * ROPE;
#pragma unroll 4
                for (int d4 = 0; d4 < 64; ++d4) { const f32x4 kk = *(const f32x4*)(ck + d4 * 4); const f32x4 qq = *(const LAS f32x4*)(qs + d4 * 4); s += kk.x * qq.x + kk.y * qq.y + kk.z * qq.z + kk.w * qq.w; }
#pragma unroll 4
                for (int d4 = 0; d4 < 16; ++d4) { const f32x4 kk = *(const f32x4*)(kr + d4 * 4); const f32x4 qq = *(const LAS f32x4*)(qs + 256 + d4 * 4); s += kk.x * qq.x + kk.y * qq.y + kk.z * qq.z + kk.w * qq.w; }
            } else { const bf16* kn = knew + (size_t)(j - PAST) * 320;
#pragma unroll 4
                for (int d8 = 0; d8 < 40; ++d8) { const v4u kk = *(const v4u*)(kn + d8 * 8); const f32x4 qa = *(const LAS f32x4*)(qs + d8 * 8), qc = *(const LAS f32x4*)(qs + d8 * 8 + 4);
                    s += bflo(kk.x) * qa.x + bfhi(kk.x) * qa.y + bflo(kk.y) * qa.z + bfhi(kk.y) * qa.w + bflo(kk.z) * qc.x + bfhi(kk.z) * qc.y + bflo(kk.w) * qc.z + bfhi(kk.w) * qc.w; }
            }
            sc[i] = s; cm = fmaxf(cm, s); }
        cm = wave_max(cm); const float mn = fmaxf(mx, cm), alpha = exp2f(mx - mn); mx = mn; o = o * alpha; lsum *= alpha;
        float ps = 0.f;
        for (int i = l; i < cn; i += 64) { const float p = exp2f(sc[i] - mn); sc[i] = p; ps += p; }
        lsum += wave_sum(ps);
        LDS_WAIT(); asm volatile("" ::: "memory");
        for (int i = 0; i < cn; ++i) { const int j = c0 + i; const float p = sc[i]; f32x4 vv;
            if (j < PAST) { const size_t prow = (size_t)pt[j >> 7] * PAGE + (j & 127); vv = *((const f32x4*)(F.cache_ckv + prow * KVL) + l); }
            else { const v2u w = *((const v2u*)(knew + (size_t)(j - PAST) * 320) + l); vv = (f32x4){bflo(w.x), bfhi(w.x), bflo(w.y), bfhi(w.y)}; }
            o = o + vv * p; }
        LDS_WAIT(); asm volatile("" ::: "memory");
    }
    const float inv = 1.f / lsum;
    store4bf((bf16*)(F.ws + WS_OLAT) + ((size_t)sm * NH + h) * 256 + 4 * l, o * inv);
}
__device__ __forceinline__ void unpack8(const v4u w, float* f) { f[0] = bflo(w.x); f[1] = bfhi(w.x); f[2] = bflo(w.y); f[3] = bfhi(w.y); f[4] = bflo(w.z); f[5] = bfhi(w.z); f[6] = bflo(w.w); f[7] = bfhi(w.w); }
__device__ __forceinline__ void merged_task(Frame& F, int task) {
    const int m0 = (task >> 1) * 4, c8 = ((task & 1) * 64 + F.lane) * 8;
    const bool samp = m0 >= MP; const int ms0 = m0 - MP;
    const int t0 = samp ? (ms0 & (DSEQ - 1)) : (m0 & (SEQ - 1));
    const bf16* big = (const bf16*)(F.ws + WS_BIG) + (size_t)m0 * NBIG + c8;
    const bf16* att = (const bf16*)(F.ws + WS_ATT) + (size_t)m0 * D + c8; bf16* mo = (bf16*)(F.ws + WS_MERGED) + (size_t)m0 * D + c8;
    v4u cxw[6], bgw[4], gaw[4], atw[4];
#pragma unroll
    for (int r = 0; r < 4; ++r) { cxw[r + 2] = *(const v4u*)(big + (size_t)r * NBIG); bgw[r] = *(const v4u*)(big + (size_t)r * NBIG + 1024); gaw[r] = *(const v4u*)(big + (size_t)r * NBIG + 2048); atw[r] = *(const v4u*)(att + (size_t)r * D); }
    float v[6][8];
    if (t0 >= 2) { cxw[0] = *(const v4u*)(big - 2 * (size_t)NBIG); cxw[1] = *(const v4u*)(big - (size_t)NBIG); unpack8(cxw[0], v[0]); unpack8(cxw[1], v[1]); }
    else if (samp) { const float* sc0 = F.state_conv + (size_t)(ms0 >> 3) * 2 * D + c8;
#pragma unroll
        for (int e = 0; e < 8; ++e) { v[0][e] = sc0[e]; v[1][e] = sc0[D + e]; } }
    else {
#pragma unroll
        for (int e = 0; e < 8; ++e) { v[0][e] = 0.f; v[1][e] = 0.f; } }
    float w0[8], w1[8], w2[8];
#pragma unroll
    for (int e = 0; e < 8; ++e) { w0[e] = F.conv_w[c8 + e]; w1[e] = F.conv_w[D + c8 + e]; w2[e] = F.conv_w[2 * D + c8 + e]; }
#pragma unroll
    for (int r = 0; r < 4; ++r) unpack8(cxw[r + 2], v[r + 2]);
#pragma unroll
    for (int r = 0; r < 4; ++r) { float bg[8], ga[8], at[8], res[8]; unpack8(bgw[r], bg); unpack8(gaw[r], ga); unpack8(atw[r], at);
#pragma unroll
        for (int e = 0; e < 8; ++e) { const float z = w0[e] * v[r][e] + w1[e] * v[r + 1][e] + w2[e] * v[r + 2][e]; res[e] = ga[e] * at[e] + bg[e] * z; }
        v4u o; o.x = pg8::cvt_pk_bf16(res[0], res[1]); o.y = pg8::cvt_pk_bf16(res[2], res[3]); o.z = pg8::cvt_pk_bf16(res[4], res[5]); o.w = pg8::cvt_pk_bf16(res[6], res[7]);
        *(v4u*)(mo + (size_t)r * D) = o; }
}
__device__ __forceinline__ void sample_x1_row(Frame& F, int ms, const float* g1) {
    const float* xs = F.x_s + (size_t)ms * D; const float* p1 = (const float*)(F.ws + WS_P1) + (size_t)ms * D; float* x1 = (float*)(F.ws + WS_X1) + (size_t)(MP + ms) * D;
#pragma unroll
    for (int j = 0; j < 4; ++j) { const int c4 = F.lane + 64 * j;
        f32x4 a = *((const f32x4*)p1 + c4);
#pragma unroll
        for (int kc = 1; kc < 4; ++kc) a = a + *((const f32x4*)(p1 + (size_t)kc * MS * D) + c4);
        *((f32x4*)x1 + c4) = *((const f32x4*)xs + c4) + *((const f32x4*)g1 + c4) * a; }
    asm volatile("s_waitcnt vmcnt(0)" ::: "memory");
}
__device__ __forceinline__ void final_rows4(Frame& F, int m0) {
    float* y = F.out + O_Y + (size_t)m0 * D; f32x4 v[4][4]; float s[4];
    if (m0 < MP) {
#pragma unroll
        for (int r = 0; r < 4; ++r)
#pragma unroll
            for (int j = 0; j < 4; ++j) v[r][j] = *((const f32x4*)(y + (size_t)r * D) + F.lane + 64 * j);
    } else {
        const int ms0 = m0 - MP; const float* x1 = (const float*)(F.ws + WS_X1) + (size_t)m0 * D; const float* p2 = (const float*)(F.ws + WS_P2) + (size_t)ms0 * D;
        const float* g2 = (const float*)(F.ws + WS_MOD) + (size_t)seq_of_row(m0) * (6 * D) + 5 * D;
#pragma unroll
        for (int r = 0; r < 4; ++r)
#pragma unroll
            for (int j = 0; j < 4; ++j) { const int c4 = F.lane + 64 * j; f32x4 a = *((const f32x4*)(p2 + (size_t)r * D) + c4);
#pragma unroll
                for (int kc = 1; kc < 8; ++kc) a = a + *((const f32x4*)(p2 + ((size_t)kc * MS + r) * D) + c4);
                v[r][j] = *((const f32x4*)(x1 + (size_t)r * D) + c4) + *((const f32x4*)g2 + c4) * a; }
    }
#pragma unroll
    for (int r = 0; r < 4; ++r) { s[r] = 0.f;
#pragma unroll
        for (int j = 0; j < 4; ++j) s[r] += (v[r][j].x * v[r][j].x + v[r][j].y * v[r][j].y) + (v[r][j].z * v[r][j].z + v[r][j].w * v[r][j].w);
        s[r] = 1.f / sqrtf(wave_sum(s[r]) * (1.f / D) + EPS); }
#pragma unroll
    for (int j = 0; j < 4; ++j) { const f32x4 gf = *((const f32x4*)F.g_final + F.lane + 64 * j);
#pragma unroll
        for (int r = 0; r < 4; ++r) *((f32x4*)(y + (size_t)r * D) + F.lane + 64 * j) = (v[r][j] * s[r]) * gf; }
}
#define SBAR() __builtin_amdgcn_sched_barrier(0)
typedef short s16x4 __attribute__((ext_vector_type(4)));
typedef LAS s16x4* lds_s16x4p;
__device__ __forceinline__ unsigned cvtpk(float lo, float hi) { return pg8::cvt_pk_bf16(lo, hi); }
__device__ __forceinline__ bf16x8 ld_lds8(LAS unsigned char* p) { return *(const LAS bf16x8*)p; }
__device__ __forceinline__ s16x4 tr_rd(LAS unsigned char* p) { return __builtin_bit_cast(s16x4, __builtin_amdgcn_ds_read_tr16_b64_v4i16((LAS s16x4*)p)); }
__device__ __forceinline__ unsigned off_b(unsigned row, unsigned ch) { return 256u * row + 16u * (ch ^ (((row & 3) << 2) | ((row >> 2) & 3))); }
__device__ __forceinline__ unsigned off_r(unsigned row, unsigned ch) { return 128u * row + 16u * (ch ^ ((row >> 1) & 7)); }
__device__ __forceinline__ unsigned tr_addr(unsigned lane, unsigned rowbase, unsigned c, unsigned ks, unsigned t) {
    const unsigned h = lane >> 5, blk = (lane >> 4) & 1, q = (lane & 15) >> 2, p = lane & 3;
    return off_b(rowbase + 16 * ks + 8 * h + 4 * t + q, 4 * c + 2 * blk + (p >> 1)) + 8 * (p & 1);
}
constexpr float THR2 = 11.5f;
#define PK4(P, B_, OUT) do { unsigned a0 = cvtpk(P[B_+0], P[B_+1]), a1 = cvtpk(P[B_+2], P[B_+3]);                          \
        unsigned b0 = cvtpk(P[B_+4], P[B_+5]), b1 = cvtpk(P[B_+6], P[B_+7]);                                             \
        auto r0 = __builtin_amdgcn_permlane32_swap(a0, b0, false, false); auto r1 = __builtin_amdgcn_permlane32_swap(a1, b1, false, false); \
        v4u w = {r0[0], r1[0], r0[1], r1[1]}; OUT = __builtin_bit_cast(bf16x8, w); } while (0)
__device__ __forceinline__ float swap_max(float v) { auto rr = __builtin_amdgcn_permlane32_swap(__float_as_uint(v), __float_as_uint(v), false, false); return fmaxf(__uint_as_float(rr[0]), __uint_as_float(rr[1])); }
__device__ __forceinline__ float swap_sum(float v) { auto rr = __builtin_amdgcn_permlane32_swap(__float_as_uint(v), __float_as_uint(v), false, false); return __uint_as_float(rr[0]) + __uint_as_float(rr[1]); }
__device__ __forceinline__ void softmax64(f32x16& p0, f32x16& p1, float& m_reg, float& l_reg, float& alpha, bf16x8& pa0, bf16x8& pa1, bf16x8& pa2, bf16x8& pa3) {
    float pmax = p0[0];
#pragma unroll
    for (int r = 1; r < 16; ++r) pmax = fmaxf(pmax, p0[r]);
#pragma unroll
    for (int r = 0; r < 16; ++r) pmax = fmaxf(pmax, p1[r]);
    pmax = swap_max(pmax);
    float mn;
    if (__all(pmax - m_reg <= THR2)) { mn = m_reg; alpha = 1.f; } else { mn = fmaxf(m_reg, pmax); alpha = __builtin_amdgcn_exp2f(m_reg - mn); m_reg = mn; }
    float ps = 0.f;
#pragma unroll
    for (int r = 0; r < 16; ++r) { p0[r] = __builtin_amdgcn_exp2f(p0[r] - mn); ps += p0[r]; }
#pragma unroll
    for (int r = 0; r < 16; ++r) { p1[r] = __builtin_amdgcn_exp2f(p1[r] - mn); ps += p1[r]; }
    l_reg = l_reg * alpha + swap_sum(ps);
    PK4(p0, 0, pa0); PK4(p0, 8, pa1); PK4(p1, 0, pa2); PK4(p1, 8, pa3);
}
__device__ __forceinline__ void softmax32(f32x16& p0, float& m_reg, float& l_reg, float& alpha, bf16x8& pa0, bf16x8& pa1) {
    float pmax = p0[0];
#pragma unroll
    for (int r = 1; r < 16; ++r) pmax = fmaxf(pmax, p0[r]);
    pmax = swap_max(pmax);
    float mn;
    if (__all(pmax - m_reg <= THR2)) { mn = m_reg; alpha = 1.f; } else { mn = fmaxf(m_reg, pmax); alpha = __builtin_amdgcn_exp2f(m_reg - mn); m_reg = mn; }
    float ps = 0.f;
#pragma unroll
    for (int r = 0; r < 16; ++r) { p0[r] = __builtin_amdgcn_exp2f(p0[r] - mn); ps += p0[r]; }
    l_reg = l_reg * alpha + swap_sum(ps);
    PK4(p0, 0, pa0); PK4(p0, 8, pa1);
}
constexpr int PA_V = 0, PA_VB = 16384, PA_K = 2 * PA_VB, PA_KB = 24576, PA_SCR = PA_K + 2 * PA_KB;
__device__ __forceinline__ int pv_st(int k, int c) { const int kk = (k & ~0xC) | ((k & 4) << 1) | ((k & 8) >> 1); return ((kk >> 3) * 4 + (c >> 5)) * 512 + ((kk & 7) * 32 + (c & 31)) * 2; }
__device__ __forceinline__ int pv_rd_base(int lane) { return ((lane & 3) << 3) | (((lane >> 2) & 3) << 6) | (((lane >> 4) & 1) << 5) | (((lane >> 5) & 1) << 8); }
template <int VB> __device__ __forceinline__ void pa_pv_tile(f32x16* o, unsigned vb0, bf16x8 pa0, bf16x8 pa1, bf16x8 pa2, bf16x8 pa3) {
#define TRRD(dst, off) asm volatile("ds_read_b64_tr_b16 %0, %1 offset:%2" : "=&v"(dst) : "v"(vb0), "i"(off) : "memory")
#define PV_RD(i, S) do { constexpr int b_ = PA_V + VB * PA_VB + ((i) >> 1) * 512 + ((i) & 1) * 8192; TRRD(S[0], b_); TRRD(S[1], b_ + 2048); TRRD(S[2], b_ + 4096); TRRD(S[3], b_ + 6144); } while (0)
#define PV_MM(i, S) do { __builtin_amdgcn_s_setprio(1);   \
        o[(i) >> 1] = __builtin_amdgcn_mfma_f32_32x32x16_bf16(((i) & 1) ? pa2 : pa0, (bf16x8){S[0][0], S[0][1], S[0][2], S[0][3], S[1][0], S[1][1], S[1][2], S[1][3]}, o[(i) >> 1], 0, 0, 0);   \
        o[(i) >> 1] = __builtin_amdgcn_mfma_f32_32x32x16_bf16(((i) & 1) ? pa3 : pa1, (bf16x8){S[2][0], S[2][1], S[2][2], S[2][3], S[3][0], S[3][1], S[3][2], S[3][3]}, o[(i) >> 1], 0, 0, 0);   \
        __builtin_amdgcn_s_setprio(0); } while (0)
#define PV_STEP(i, S, T) do { PV_RD((i) + 1, T); asm volatile("s_waitcnt lgkmcnt(4)" ::: "memory"); SBAR(); PV_MM(i, S); SBAR(); } while (0)
    s16x4 A_[4], B_[4];
    PV_RD(0, A_);
    PV_STEP(0, A_, B_); PV_STEP(1, B_, A_); PV_STEP(2, A_, B_); PV_STEP(3, B_, A_); PV_STEP(4, A_, B_); PV_STEP(5, B_, A_); PV_STEP(6, A_, B_);
    asm volatile("s_waitcnt lgkmcnt(0)" ::: "memory"); SBAR(); PV_MM(7, B_); SBAR();
#undef PV_STEP
#undef PV_MM
#undef PV_RD
#undef TRRD
}
__device__ __forceinline__ void attn_prompt_block(Frame& F, int b, int h, int qb) {
    unsigned z_ = 0u; asm volatile("" : "+v"(z_)); const int lane = (int)__builtin_amdgcn_mbcnt_hi(~0u, __builtin_amdgcn_mbcnt_lo(~0u, z_));
    const int wid = F.wave, tid = wid * 64 + lane, r32 = lane & 31, hi = lane >> 5;
    LAS unsigned char* L = F.lds;
    const bf16* Kg = (const bf16*)(F.ws + WS_KP) + (size_t)(b * NH + h) * SEQ * 192;
    const bf16* Vg = (const bf16*)(F.ws + WS_VP) + (size_t)(b * NH + h) * SEQ * 128;
    const int row0 = b * SEQ + qb * 256 + wid * 32;
    const int qpos = qb * 256 + wid * 32 + r32;
    const int qlo = qb * 256 + wid * 32;
    const int NT = 4 * (qb + 1);
    bf16x8 qr[12];
    { const bf16* qp = (const bf16*)(F.ws + WS_QB) + (size_t)(row0 + r32) * NQ;
#pragma unroll
      for (int d0 = 0; d0 < 12; ++d0) qr[d0] = *(const bf16x8*)(qp + (d0 < 8 ? h * 128 + 16 * d0 + 8 * hi : 1024 + h * 64 + 16 * (d0 - 8) + 8 * hi)); }
    unsigned kso[3], vso[2];
#pragma unroll
    for (int i = 0; i < 3; ++i) { const unsigned p = (unsigned)(wid * 3 + i) * 64 + lane, row = p / 24, chp = p - row * 24, ch = chp ^ ((row >> 1) & 7); kso[i] = row * 192 + ch * 8; }
#pragma unroll
    for (int i = 0; i < 2; ++i) { const unsigned B_ = ((unsigned)(wid * 2 + i) * 64 + lane) * 16, st = B_ >> 9, wi = B_ & 511, kk = (st >> 2) * 8 + (wi >> 6), c = (st & 3) * 32 + ((wi & 63) >> 1);
        const unsigned k = (kk & ~0xCu) | ((kk & 4) << 1) | ((kk & 8) >> 1); vso[i] = k * 128 + c; }
#define PA_STAGE(t, bf) do { const bf16* kt = Kg + (size_t)(t) * 64 * 192; const bf16* vt = Vg + (size_t)(t) * 64 * 128;   \
        _Pragma("unroll") for (int i = 0; i < 3; ++i) __builtin_amdgcn_global_load_lds((const unsigned*)(kt + kso[i]), (LAS unsigned*)(L + PA_K + (bf) * PA_KB + (wid * 3 + i) * 1024), 16, 0, 0);   \
        _Pragma("unroll") for (int i = 0; i < 2; ++i) __builtin_amdgcn_global_load_lds((const unsigned*)(vt + vso[i]), (LAS unsigned*)(L + PA_V + (bf) * PA_VB + (wid * 2 + i) * 1024), 16, 0, 0); } while (0)
    LAS float* al_l = (LAS float*)(L + PA_SCR + wid * 256); LAS float* li_l = al_l + 32;
    const unsigned vb0 = (unsigned)pv_rd_base(lane);
    const int fx = (r32 >> 1) & 7;
    int kb4[4];
#pragma unroll
    for (int dd = 0; dd < 4; ++dd) kb4[dd] = r32 * 384 + (((2 * dd + hi) ^ fx) << 4);
    float m_reg = -1e30f, l_reg = 0.f; f32x16 o[4];
#pragma unroll
    for (int d = 0; d < 4; ++d)
#pragma unroll
        for (int r = 0; r < 16; ++r) o[d][r] = 0.f;
    PA_STAGE(0, 0); VM_WAIT();
    __syncthreads();
#define PA_LDK(KB, d, sl) do { LAS unsigned char* a = L + PA_K + (KB) * PA_KB + kb4[(d) & 3] + ((d) >> 2) * 128; kf[sl][0] = ld_lds8(a); kf[sl][1] = ld_lds8(a + 32 * 384); } while (0)
#define PA_STEP(t, KB) do {                                                                                                     \
        if ((t) + 1 < NT) PA_STAGE((t) + 1, (KB) ^ 1);                                                                          \
        f32x16 p0, p1;                                                                                                          \
        _Pragma("unroll") for (int r = 0; r < 16; ++r) { p0[r] = 0.f; p1[r] = 0.f; }                                            \
        { bf16x8 kf[2][2];                                      \
          PA_LDK(KB, 0, 0);                                                                                                     \
          _Pragma("unroll") for (int d0 = 0; d0 < 12; ++d0) {                                                                   \
            if (d0 + 1 < 12) PA_LDK(KB, d0 + 1, (d0 + 1) & 1);                                                                  \
            SBAR(); __builtin_amdgcn_s_setprio(1);                                                                              \
            p0 = __builtin_amdgcn_mfma_f32_32x32x16_bf16(kf[d0 & 1][0], qr[d0], p0, 0, 0, 0);                                    \
            p1 = __builtin_amdgcn_mfma_f32_32x32x16_bf16(kf[d0 & 1][1], qr[d0], p1, 0, 0, 0);                                    \
            __builtin_amdgcn_s_setprio(0); SBAR(); } }                                                                          \
        const int kb_ = (t) * 64;                                                                                               \
        if (kb_ + 63 > qlo) { const float NEG = -__builtin_inff();                                                              \
            _Pragma("unroll") for (int r = 0; r < 16; ++r) { const int key = kb_ + crow32(r, hi); if (key > qpos) p0[r] = NEG; if (key + 32 > qpos) p1[r] = NEG; } }   \
        float alpha; bf16x8 pa0, pa1, pa2, pa3;                                                                                 \
        softmax64(p0, p1, m_reg, l_reg, alpha, pa0, pa1, pa2, pa3);                                                             \
        if (__any(alpha < 1.f)) { if (hi == 0) al_l[r32] = alpha; LDS_WAIT();                                                    \
            _Pragma("unroll") for (int r = 0; r < 16; ++r) { const float a_ = al_l[crow32(r, hi)];                              \
                _Pragma("unroll") for (int d_ = 0; d_ < 4; ++d_) o[d_][r] *= a_; } }                                            \
        pa_pv_tile<KB>(o, vb0, pa0, pa1, pa2, pa3);                                                                             \
        VM_WAIT();                                                                                                              \
        __syncthreads(); } while (0)
    for (int t = 0; t < NT; t += 2) { PA_STEP(t, 0); PA_STEP(t + 1, 1); }
#undef PA_STEP
#undef PA_LDK
#undef PA_STAGE
    if (hi == 0) li_l[r32] = l_reg;
    LDS_WAIT();
    { unsigned eo = (unsigned)(4 * hi * D + r32);
      asm volatile("" : "+v"(eo));
      bf16* Ow = (bf16*)(F.ws + WS_ATT) + (size_t)row0 * D + h * 128;
#pragma unroll
      for (int r = 0; r < 16; ++r) { const int orow = crow32(r, hi); const float rl = __builtin_amdgcn_rcpf(li_l[orow]);
#pragma unroll
        for (int d0 = 0; d0 < 4; ++d0) { const float v = o[d0][r] * rl; const float vn = __shfl_xor(v, 1);
            if ((r32 & 1) == 0) *(unsigned*)(Ow + eo + ((r & 3) + 8 * (r >> 2)) * D + d0 * 32) = cvtpk(v, vn); } } }
    __syncthreads();
}
constexpr int DA_Q = 0, DA_IMG = 40960, DA_K = DA_IMG, DA_SCR = 3 * DA_IMG, DA_L1 = 16384, DA_R = 32768;
#define DA_BAR() do { asm volatile("s_waitcnt lgkmcnt(0)" ::: "memory"); __builtin_amdgcn_s_barrier(); asm volatile("" ::: "memory"); } while (0)
__device__ __forceinline__ void attn_decode_unit(Frame& F, int sb, int sp) {
    unsigned z_ = 0u; asm volatile("" : "+v"(z_)); const int lane = (int)__builtin_amdgcn_mbcnt_hi(~0u, __builtin_amdgcn_mbcnt_lo(~0u, z_));
    const int wid = F.wave, tid = wid * 64 + lane, r32 = lane & 31, hi = lane >> 5;
    LAS unsigned char* L = F.lds;
    const int* pt = F.page_table + sb * NPAGES + sp * 32;
    constexpr int NT = 64;
    { const bf16* ql = (const bf16*)(F.ws + WS_QL) + (size_t)sb * 64 * 320;
#pragma unroll
      for (int i = 0; i < 5; ++i) { const int id = tid + 512 * i, row = id / 40, ch = id - row * 40; const bf16x8 v = *(const bf16x8*)(ql + (size_t)row * 320 + ch * 8);
          const unsigned o_ = ch < 16 ? off_b(row, ch) : (ch < 32 ? DA_L1 + off_b(row, ch - 16) : DA_R + off_r(row, ch - 32));
          *(LAS bf16x8*)(L + DA_Q + o_) = v; } }
    __syncthreads();
    if (wid >= 4) {
        const unsigned lt = (unsigned)((wid - 4) * 64 + lane);
        const int ptv = pt[lane & 31];
        f32x4 cA[16], rA[4], cB[16], rB[4];
        const unsigned cvo = (lt >> 6) * 1024u + (lt & 63) * 16u, rvo = (lt >> 4) * 256u + (lt & 15) * 16u;
        unsigned wlo[4];
        { const unsigned c4 = lt & 63, row0 = lt >> 6, ch = (c4 & 31) >> 1;
#pragma unroll
          for (int v = 0; v < 4; ++v) wlo[v] = (c4 >> 5) * DA_L1 + 256u * row0 + 16u * (ch ^ (((row0 & 3) << 2) | (((row0 >> 2) + v) & 3))) + 8u * (c4 & 1); }
        const unsigned wro = DA_R + off_r(lt >> 4, (lt & 15) >> 1) + 8u * (lt & 1);
#define DA_LOAD(t, c_, r_) do { const size_t prow = (size_t)__builtin_amdgcn_readlane(ptv, (t) >> 1) * PAGE + ((t) & 1) * 64;     \
        const char* cb_ = (const char*)F.cache_ckv + prow * (KVL * 4); const char* rb_ = (const char*)F.cache_kr + prow * (ROPE * 4);   \
        _Pragma("unroll") for (int i = 0; i < 16; ++i) c_[i] = __builtin_nontemporal_load((const f32x4*)(cb_ + 4096 * i + cvo));     \
        _Pragma("unroll") for (int i = 0; i < 4; ++i) r_[i] = __builtin_nontemporal_load((const f32x4*)(rb_ + 4096 * i + rvo)); } while (0)
#define DA_WRITE(bf, c_, r_) do { LAS unsigned char* Kb = L + DA_K + (bf) * DA_IMG;                                             \
        _Pragma("unroll") for (int i = 0; i < 16; ++i) { v2u w; w.x = cvtpk(c_[i][0], c_[i][1]); w.y = cvtpk(c_[i][2], c_[i][3]); *(LAS v2u*)(Kb + wlo[i & 3] + 1024 * i) = w; }   \
        _Pragma("unroll") for (int i = 0; i < 4; ++i) { v2u w; w.x = cvtpk(r_[i][0], r_[i][1]); w.y = cvtpk(r_[i][2], r_[i][3]); *(LAS v2u*)(Kb + wro + 2048 * i) = w; } } while (0)
        DA_LOAD(0, cA, rA); DA_LOAD(1, cB, rB);
        for (int t = 0; t < NT; t += 2) {
            DA_WRITE(0, cA, rA);
            DA_LOAD(t + 2 < NT ? t + 2 : NT - 1, cA, rA);
            DA_BAR();
            DA_WRITE(1, cB, rB);
            DA_LOAD(t + 3 < NT ? t + 3 : NT - 1, cB, rB);
            DA_BAR();
        }
#undef DA_LOAD
#undef DA_WRITE
        if (sp == 1) {
            LAS unsigned char* Kb = L + DA_K; const bf16* kn = (const bf16*)(F.ws + WS_KNEW) + (size_t)sb * DSEQ * 320;
#pragma unroll
            for (int i = 0; i < 10; ++i) { const int id = lt + 256 * i, row = id / 40, ch = id - row * 40; bf16x8 v = {0, 0, 0, 0, 0, 0, 0, 0};
                if (row < DSEQ) v = *(const bf16x8*)(kn + (size_t)row * 320 + ch * 8);
                const unsigned o_ = ch < 16 ? off_b(row, ch) : (ch < 32 ? DA_L1 + off_b(row, ch - 16) : DA_R + off_r(row, ch - 32));
                *(LAS bf16x8*)(Kb + o_) = v; }
            DA_BAR();
        }
    } else {
        const int kh = wid & 1, qh = wid >> 1;
        LAS float* al_l = (LAS float*)(L + DA_SCR + wid * 256);
        const unsigned krow = 32 * kh + r32, qrow = 32 * qh + r32;
        float m_reg = -1e30f, l_reg = 0.f; f32x16 o[8];
#pragma unroll
        for (int d = 0; d < 8; ++d)
#pragma unroll
            for (int r = 0; r < 16; ++r) o[d][r] = 0.f;
#define DA_KADDR(s) ((s) < 16 ? ((s) >> 3) * DA_L1 + 256u * kr_ + 16u * ((2 * ((s) & 7) + hi) ^ xk) : DA_R + 128u * kr_ + 16u * ((2 * ((s) - 16) + hi) ^ fk))
#define DA_QADDR(s) ((s) < 16 ? ((s) >> 3) * DA_L1 + 256u * qr_ + 16u * ((2 * ((s) & 7) + hi) ^ xq) : DA_R + 128u * qr_ + 16u * ((2 * ((s) - 16) + hi) ^ fq))
#define DA_LDG(g, sl) do { kf[sl][0] = ld_lds8(Kb + DA_KADDR(2 * (g))); qf[sl][0] = ld_lds8(Qb + DA_QADDR(2 * (g))); kf[sl][1] = ld_lds8(Kb + DA_KADDR(2 * (g) + 1)); qf[sl][1] = ld_lds8(Qb + DA_QADDR(2 * (g) + 1)); } while (0)
#define DA_LDV(c, sl) do { LAS unsigned char* Vb_ = Kb + ((c) >> 2) * DA_L1;                                                     \
            va[sl][0] = tr_rd(Vb_ + tr_addr(ln_, 32 * kh, (c) & 3, 0, 0)); va[sl][1] = tr_rd(Vb_ + tr_addr(ln_, 32 * kh, (c) & 3, 0, 1));   \
            va[sl][2] = tr_rd(Vb_ + tr_addr(ln_, 32 * kh, (c) & 3, 1, 0)); va[sl][3] = tr_rd(Vb_ + tr_addr(ln_, 32 * kh, (c) & 3, 1, 1)); } while (0)
#define DA_COMPUTE(bf, MASKNEW) do { LAS unsigned char* Kb = L + DA_K + (bf) * DA_IMG; LAS unsigned char* Qb = L + DA_Q;         \
        unsigned kr_ = krow, qr_ = qrow, ln_ = lane; asm volatile("" : "+v"(kr_), "+v"(qr_), "+v"(ln_));     \
        const unsigned xk = ((kr_ & 3) << 2) | ((kr_ >> 2) & 3), xq = ((qr_ & 3) << 2) | ((qr_ >> 2) & 3), fk = (kr_ >> 1) & 7, fq = (qr_ >> 1) & 7;   \
        f32x16 p0;                                                                                                              \
        _Pragma("unroll") for (int r = 0; r < 16; ++r) p0[r] = 0.f;                                                             \
        { bf16x8 kf[2][2], qf[2][2];                           \
          DA_LDG(0, 0);                                                                                                         \
          _Pragma("unroll") for (int g_ = 0; g_ < 10; ++g_) {                                                                   \
            if (g_ + 1 < 10) DA_LDG(g_ + 1, (g_ + 1) & 1);                                                                      \
            SBAR();                                                                                                             \
            p0 = __builtin_amdgcn_mfma_f32_32x32x16_bf16(kf[g_ & 1][0], qf[g_ & 1][0], p0, 0, 0, 0);                             \
            p0 = __builtin_amdgcn_mfma_f32_32x32x16_bf16(kf[g_ & 1][1], qf[g_ & 1][1], p0, 0, 0, 0);                             \
            SBAR(); } }                                                                                                         \
        if (MASKNEW) { const float NEG = -__builtin_inff(); const int tq = (int)qrow >> 3;                                      \
            _Pragma("unroll") for (int r = 0; r < 16; ++r) { const int kk = crow32(r, hi); if (kk > tq) p0[r] = NEG; } }         \
        float alpha; bf16x8 pa0, pa1;                                                                                           \
        softmax32(p0, m_reg, l_reg, alpha, pa0, pa1);                                                                           \
        if (__any(alpha < 1.f)) { if (hi == 0) al_l[r32] = alpha; LDS_WAIT();                                                    \
            _Pragma("unroll") for (int r = 0; r < 16; ++r) { const float a_ = al_l[crow32(r, hi)];                              \
                _Pragma("unroll") for (int d_ = 0; d_ < 8; ++d_) o[d_][r] *= a_; } }                                            \
        { s16x4 va[2][4];                                                             \
          DA_LDV(0, 0);                                                                                                         \
          _Pragma("unroll") for (int c = 0; c < 8; ++c) {                                                                       \
            if (c + 1 < 8) DA_LDV(c + 1, (c + 1) & 1);                                                                          \
            SBAR();                                                                                                             \
            o[c] = __builtin_amdgcn_mfma_f32_32x32x16_bf16(pa0, (bf16x8){va[c & 1][0][0], va[c & 1][0][1], va[c & 1][0][2], va[c & 1][0][3], va[c & 1][1][0], va[c & 1][1][1], va[c & 1][1][2], va[c & 1][1][3]}, o[c], 0, 0, 0);   \
            o[c] = __builtin_amdgcn_mfma_f32_32x32x16_bf16(pa1, (bf16x8){va[c & 1][2][0], va[c & 1][2][1], va[c & 1][2][2], va[c & 1][2][3], va[c & 1][3][0], va[c & 1][3][1], va[c & 1][3][2], va[c & 1][3][3]}, o[c], 0, 0, 0);   \
            SBAR(); } } } while (0)
        for (int t = 0; t < NT; t += 2) {
            DA_BAR(); DA_COMPUTE(0, false);
            DA_BAR(); DA_COMPUTE(1, false);
        }
        if (sp == 1) { DA_BAR(); if (kh == 0) { DA_COMPUTE(0, true); } }
#undef DA_COMPUTE
#undef DA_LDG
#undef DA_LDV
#undef DA_KADDR
#undef DA_QADDR
        { unsigned l2 = (unsigned)lane; asm volatile("" : "+v"(l2));
          const unsigned e_r32 = l2 & 31, e_hi = l2 >> 5; const int pi = 2 * sp + kh;
          float* po = (float*)(F.ws + WS_PART) + ((size_t)(sb * 4 + pi) * 64 + 32 * qh) * 256;
          const unsigned eo = 4 * e_hi * 256 + e_r32;
#pragma unroll
          for (int r = 0; r < 16; ++r) {
#pragma unroll
            for (int c = 0; c < 8; ++c) po[eo + ((r & 3) + 8 * (r >> 2)) * 256 + 32 * c] = o[c][r]; }
          if (e_hi == 0) { float* ml = (float*)(F.ws + WS_ML) + ((size_t)(sb * 4 + pi) * 64 + 32 * qh + e_r32) * 2; ml[0] = m_reg; ml[1] = l_reg; } }
    }
    __syncthreads();
}
__device__ __forceinline__ void decode_combine_row(Frame& F, int row) {
    const int sb = row >> 6, q = row & 63, l = F.lane;
    const float* ml = (const float*)(F.ws + WS_ML); const float* po = (const float*)(F.ws + WS_PART);
    float mm[4], ll[4], M_ = -1e30f;
#pragma unroll
    for (int p = 0; p < 4; ++p) { const f32x2 v = *(const f32x2*)(ml + ((size_t)(sb * 4 + p) * 64 + q) * 2); mm[p] = v.x; ll[p] = v.y; M_ = fmaxf(M_, v.x); }
    float Lsum = 0.f; f32x4 acc = {0.f, 0.f, 0.f, 0.f};
#pragma unroll
    for (int p = 0; p < 4; ++p) { const float w = exp2f(mm[p] - M_); Lsum += w * ll[p]; acc = acc + *((const f32x4*)(po + ((size_t)(sb * 4 + p) * 64 + q) * 256) + l) * w; }
    store4bf((bf16*)(F.ws + WS_OLAT) + (size_t)row * 256 + 4 * l, acc * (1.f / Lsum));
}

struct Args { const void* in[22]; float* out; unsigned char* ws; int ph_lo, ph_hi; };
__global__ void __launch_bounds__(NWAVES * 64, 2) mk_fwd(Args args) {
    extern __shared__ __attribute__((aligned(16))) unsigned char lds[];
    Frame F;
    F.lds = (LAS unsigned char*)lds;
    F.MISC = (volatile LAS unsigned*)(F.lds + MISC_OFF);
    F.tid = threadIdx.x; F.lane = F.tid & 63; F.wave = __builtin_amdgcn_readfirstlane(F.tid >> 6);
    F.G = gridDim.x; F.gw = blockIdx.x * NWAVES + F.wave; F.NGW = F.G * NWAVES;
    F.ws = args.ws; F.out = args.out; F.ctl = (gu32*)(args.ws + WS_CTL);
    F.x_p = (const float*)args.in[0]; F.x_s = (const float*)args.in[1]; F.cache_ckv = (const float*)args.in[2]; F.cache_kr = (const float*)args.in[3]; F.state_conv = (const float*)args.in[4];
    F.page_table = (const int*)args.in[5]; F.c_p = (const float*)args.in[6]; F.c_s = (const float*)args.in[7]; F.w_ada = (const float*)args.in[8]; F.b_ada = (const float*)args.in[9];
    F.g_attn = (const float*)args.in[10]; F.w_in = (const float*)args.in[11]; F.g_q = (const float*)args.in[12]; F.w_q_b = (const float*)args.in[13]; F.g_kv = (const float*)args.in[14];
    F.w_kv_b = (const float*)args.in[15]; F.conv_w = (const float*)args.in[16]; F.w_o = (const float*)args.in[17]; F.g_mlp = (const float*)args.in[18]; F.w_1 = (const float*)args.in[19];
    F.w_2 = (const float*)args.in[20]; F.g_final = (const float*)args.in[21];
    for (int u = F.tid; u < (LDS_BYTES - LDSCTL_OFF) / 4; u += NWAVES * 64) ((LAS unsigned*)(F.lds + LDSCTL_OFF))[u] = 0u;
    __syncthreads();
    XcdBarrier bar; bar.bar = (unsigned*)(F.ctl + CW_BAR); bar.x = 0; bar.st = nullptr;
    if (!MK_PER_PHASE) bar = xcd_barrier_post((unsigned*)(F.ctl + CW_BAR), F.MISC + 8);
#define GRID_BAR() do { if (MK_PER_PHASE) { if (F.tid == 0) __hip_atomic_store(F.ctl + CW_TMO, 0xBADBA0u, RLX_AGENT); } else { xcd_barrier(bar); } } while (0)
    const int lo = args.ph_lo, hi = args.ph_hi;
#ifndef PH_MASK
#define PH_MASK 0xFFFFFFFFu
#endif
#define IN(k) (((PH_MASK >> (k)) & 1u) && lo <= (k) && (k) < hi)
#define BOTH(k) (IN(k) && IN((k) + 1))
#define RELANE() do { unsigned z_ = 0u; asm volatile("" : "+v"(z_)); int l_ = (int)__builtin_amdgcn_mbcnt_hi(~0u, __builtin_amdgcn_mbcnt_lo(~0u, z_)); F.lane = l_; F.tid = F.wave * 64 + l_; } while (0)
    const pg8::bf16_t* U = (const pg8::bf16_t*)(F.ws + WS_U);
    float* mod = (float*)(F.ws + WS_MOD);

    if (IN(0)) { RELANE(); p0_prologue(F); if (BOTH(0)) GRID_BAR(); }
    if (IN(1)) { RELANE();
        for (int m = F.gw * 4; m < M; m += F.NGW * 4) { const float* mr = mod + (size_t)seq_of_row(m) * (6 * D);
            norm_mod_rows4(F, m < MP ? F.x_p + (size_t)m * D : F.x_s + (size_t)(m - MP) * D, F.g_attn, mr + D, mr, (bf16*)(F.ws + WS_U) + (size_t)m * D); }
        if (BOTH(1)) GRID_BAR();
    }
    if (IN(2)) { RELANE();
        pg8::Gemm g{U, (const pg8::bf16_t*)(F.ws + WS_WIN), M, NIN, D, D, D, 0, 0, 0x7fffffff, 0}; pg8::StaticOrder S; S.init(M, NIN, F.G, (int)blockIdx.x);
        Epi<1> E{F.ws, F.x_p, F.x_s, F.out};
        pg8::gemm_phase<Epi<1>, pg8::StaticOrder, true, true>(F.lds + RING_OFF, g, S, E);
        if (BOTH(2)) GRID_BAR();
    }
    if (IN(3)) { RELANE(); for (int m = F.gw; m < M; m += F.NGW) small_row(F, m); if (BOTH(3)) GRID_BAR(); }
    if (IN(4)) { RELANE();
        { pg8::Gemm g{(const pg8::bf16_t*)(F.ws + WS_QA), (const pg8::bf16_t*)(F.ws + WS_WQB), M, NQ, QLORA, QLORA, QLORA, 0, 0, 0x7fffffff, 0}; pg8::StaticOrder S; S.init(M, NQ, F.G, (int)blockIdx.x);
          Epi<2> E{F.ws, F.x_p, F.x_s, F.out};
          pg8::gemm_phase<Epi<2>, pg8::StaticOrder, true, true>(F.lds + RING_OFF, g, S, E); }
        __syncthreads();
        { pg8::Gemm g{(const pg8::bf16_t*)(F.ws + WS_CKVN), (const pg8::bf16_t*)(F.ws + WS_WKVB), MP, 2048, KVL, KVL, KVL, 0, 0, 0x7fffffff, 0}; pg8::StaticOrder S; S.init(MP, 2048, F.G, (int)blockIdx.x);
          Epi<3> E{F.ws, F.x_p, F.x_s, F.out};
          pg8::gemm_phase<Epi<3>, pg8::StaticOrder, true, true>(F.lds + RING_OFF, g, S, E); }
        if (BOTH(4)) GRID_BAR();
    }
    if (IN(5)) { RELANE();
        pg8::Gemm g{(const pg8::bf16_t*)(F.ws + WS_QB) + (size_t)MP * NQ, (const pg8::bf16_t*)(F.ws + WS_WUK), MS, 2048, 256, NQ, 256, 128 * 2, 0, 0x7fffffff, 0}; pg8::StaticOrder S; S.init(MS, 2048, F.G, (int)blockIdx.x);
        Epi<4> E{F.ws, F.x_p, F.x_s, F.out};
        pg8::gemm_phase<Epi<4>, pg8::StaticOrder, true, true>(F.lds + RING_OFF, g, S, E);
        if (BOTH(5)) GRID_BAR();
    }
    if (IN(6)) { RELANE();
        const bool dec_first = ((blockIdx.x >> 3) & 1) != 0;
        if (dec_first) { for (int du = blockIdx.x; du < 2 * DB; du += F.G) attn_decode_unit(F, du >> 1, du & 1); }
        for (int it = blockIdx.x; it < NB * NH * 8; it += F.G) {
            const int xcd = it & 7, j = it >> 3, bh = (xcd * 4 + (j >> 3)) & 31, pr = j & 7, b = bh >> 3, h = bh & 7;
            for (int k = 0; k < 2; ++k) attn_prompt_block(F, b, h, k == 0 ? 15 - pr : pr);
        }
        if (!dec_first) { for (int du = blockIdx.x; du < 2 * DB; du += F.G) attn_decode_unit(F, du >> 1, du & 1); }
        if (BOTH(6)) GRID_BAR();
    }
    if (IN(7)) { RELANE(); for (int r = F.gw; r < MS * NH; r += F.NGW) decode_combine_row(F, r); if (BOTH(7)) GRID_BAR(); }
    if (IN(8)) { RELANE();
        pg8::Gemm g{(const pg8::bf16_t*)(F.ws + WS_OLAT), (const pg8::bf16_t*)(F.ws + WS_WKVB), MS, 2048, 256, 2048, 256, 256 * 2, 0, 0x7fffffff, 0}; pg8::StaticOrder S; S.init(MS, 2048, F.G, (int)blockIdx.x);
        Epi<5> E{F.ws, F.x_p, F.x_s, F.out};
        pg8::gemm_phase<Epi<5>, pg8::StaticOrder, true, true>(F.lds + RING_OFF, g, S, E);
        if (BOTH(8)) GRID_BAR();
    }
    if (IN(9)) { RELANE(); for (int tk = F.gw; tk < (M / 4) * 2; tk += F.NGW) merged_task(F, tk); if (BOTH(9)) GRID_BAR(); }
    if (IN(10)) { RELANE();
        { pg8::Gemm g{(const pg8::bf16_t*)(F.ws + WS_MERGED), (const pg8::bf16_t*)(F.ws + WS_WO), MP, D, D, D, D, 0, 0, 0x7fffffff, 0}; pg8::StaticOrder S; S.init(MP, D, F.G, (int)blockIdx.x);
          Epi<6> E{F.ws, F.x_p, F.x_s, F.out};
          pg8::gemm_phase<Epi<6>, pg8::StaticOrder, true, true>(F.lds + RING_OFF, g, S, E); }
        __syncthreads();
        { pg8::Gemm g{(const pg8::bf16_t*)(F.ws + WS_MERGED) + (size_t)MP * D, (const pg8::bf16_t*)(F.ws + WS_WO), MS, 4 * D, 256, D, D, 256 * 2, 2, 3, 256 * 2}; pg8::StaticOrder S; S.init(MS, 4 * D, F.G, (int)(F.G - 1 - blockIdx.x));
          Epi<9> E{F.ws, F.x_p, F.x_s, F.out};
          pg8::gemm_phase<Epi<9>, pg8::StaticOrder, true, true>(F.lds + RING_OFF, g, S, E); }
        if (BOTH(10)) GRID_BAR();
    }
    if (IN(11)) { RELANE();
        for (int m = F.gw * 4; m < M; m += F.NGW * 4) { const float* mr = mod + (size_t)seq_of_row(m) * (6 * D);
            if (m >= MP) { for (int r = 0; r < 4; ++r) sample_x1_row(F, m - MP + r, mr + 2 * D); }
            norm_mod_rows4(F, (const float*)(F.ws + WS_X1) + (size_t)m * D, F.g_mlp, mr + 4 * D, mr + 3 * D, (bf16*)(F.ws + WS_U) + (size_t)m * D); }
        if (BOTH(11)) GRID_BAR();
    }
    if (IN(12)) { RELANE();
        pg8::Gemm g{U, (const pg8::bf16_t*)(F.ws + WS_W1), M, FF, D, D, D, 0, 0, 0x7fffffff, 0}; pg8::StaticOrder S; S.init(M, FF, F.G, (int)blockIdx.x);
        Epi<7> E{F.ws, F.x_p, F.x_s, F.out};
        pg8::gemm_phase<Epi<7>, pg8::StaticOrder, true, true>(F.lds + RING_OFF, g, S, E);
        if (BOTH(12)) GRID_BAR();
    }
    if (IN(13)) { RELANE();
        { pg8::Gemm g{(const pg8::bf16_t*)(F.ws + WS_HDN), (const pg8::bf16_t*)(F.ws + WS_W2), MP, D, FF, FF, FF, 0, 0, 0x7fffffff, 0}; pg8::StaticOrder S; S.init(MP, D, F.G, (int)blockIdx.x);
          Epi<8> E{F.ws, F.x_p, F.x_s, F.out};
          pg8::gemm_phase<Epi<8>, pg8::StaticOrder, true, true>(F.lds + RING_OFF, g, S, E); }
        __syncthreads();
        { pg8::Gemm g{(const pg8::bf16_t*)(F.ws + WS_HDN) + (size_t)MP * FF, (const pg8::bf16_t*)(F.ws + WS_W2), MS, 8 * D, 512, FF, FF, 512 * 2, 2, 3, 512 * 2}; pg8::StaticOrder S; S.init(MS, 8 * D, F.G, (int)(F.G - 1 - blockIdx.x));
          Epi<10> E{F.ws, F.x_p, F.x_s, F.out};
          pg8::gemm_phase<Epi<10>, pg8::StaticOrder, true, true>(F.lds + RING_OFF, g, S, E); }
        if (BOTH(13)) GRID_BAR();
    }
    if (IN(14)) { RELANE(); for (int m = F.gw * 4; m < M; m += F.NGW * 4) final_rows4(F, m); }
#undef IN
#undef BOTH
}

extern "C" void kernel_launch(void* const* d_in, const int* in_sizes, int n_in, void* d_out, int out_size, void* d_ws, size_t ws_size, hipStream_t stream) {
    static int grid = 0;
    if (grid == 0) {
        if (n_in != 22 || out_size != (int)O_END || ws_size < WS_END) { fprintf(stderr, "kernel_launch: unexpected shapes (n_in %d, out %d, ws %zu); nothing launched\n", n_in, out_size, ws_size); grid = -1; return; }
        int dev = 0, cus = 0, per_cu = 0;
        if (hipGetDevice(&dev) != hipSuccess || hipDeviceGetAttribute(&cus, hipDeviceAttributeMultiprocessorCount, dev) != hipSuccess) { grid = -1; return; }
        if (hipFuncSetAttribute((const void*)mk_fwd, hipFuncAttributeMaxDynamicSharedMemorySize, LDS_BYTES) != hipSuccess) { fprintf(stderr, "kernel_launch: hipFuncSetAttribute failed\n"); grid = -1; return; }
        if (hipOccupancyMaxActiveBlocksPerMultiprocessor(&per_cu, (const void*)mk_fwd, NWAVES * 64, LDS_BYTES) != hipSuccess || per_cu < 1) fprintf(stderr, "kernel_launch: note: occupancy query says %d\n", per_cu);
        (void)hipGetLastError();
        grid = cus;
    }
    if (grid < 0) return;
    if (hipMemsetAsync((char*)d_ws + WS_CTL, 0, CTL_ZERO_BYTES, stream) != hipSuccess) return;
    Args a{};
    for (int i = 0; i < 22; ++i) a.in[i] = d_in[i];
    a.out = (float*)d_out; a.ws = (unsigned char*)d_ws;
#if MK_PER_PHASE
    for (int p = 0; p < N_PHASES; ++p) { a.ph_lo = p; a.ph_hi = p + 1; hipLaunchKernelGGL(mk_fwd, dim3(grid), dim3(NWAVES * 64), LDS_BYTES, stream, a); }
#else
    a.ph_lo = 0; a.ph_hi = N_PHASES; hipLaunchKernelGGL(mk_fwd, dim3(grid), dim3(NWAVES * 64), LDS_BYTES, stream, a);
#endif
}
```

```cpp
#include <hip/hip_runtime.h>
#include <cstdio>
#include <cstdint>
namespace pg8 {
#define PG8_LAS __attribute__((address_space(3)))
typedef unsigned short bf16_t;
typedef short bf16x8 __attribute__((ext_vector_type(8)));
typedef float f32x4 __attribute__((ext_vector_type(4)));
typedef unsigned u32x4 __attribute__((ext_vector_type(4)));
typedef unsigned u32x2 __attribute__((ext_vector_type(2)));
constexpr int BM = 256, BK = 64, HALF = 128, HTB = HALF * BK * 2  , STAGE_BYTES = 8 * HTB, NXCD = 8, WGM = 8;

__host__ __device__ __forceinline__ int lds_byte(int r, int c) { const int st = (r >> 4) * 2 + (c >> 5), rr = r & 15, cc = c & 31, ob = rr * 64 + cc * 2; return st * 1024 + (ob ^ (((ob >> 9) & 1) << 5)); }
__host__ __device__ __forceinline__ void stage_rc(int b, int& R, int& C) { const int st = b / 1024, sb = b % 1024, swz = sb ^ (((sb >> 9) & 1) << 5); R = (st >> 1) * 16 + swz / 64; C = (st & 1) * 32 + (swz % 64) / 2; }
__host__ __device__ __forceinline__ int perm32(int rho) { const int n = rho >> 4, i = rho & 15; return 8 * (i >> 2) + 4 * n + (i & 3); }

struct Unit { int pm, pn; };
struct Gemm { const bf16_t* A; const bf16_t* Bt; int M, N, K, lda, ldb, aoffn, pn_shift, pn_mask, boffk; };

struct StaticOrder {
    int nM, nN, nwg, G, c;
    __host__ __device__ void init(int M, int N, int G_, int c_) { nM = M / BM; nN = N / BM; nwg = nM * nN; G = G_; c = c_; }
    __host__ __device__ bool next(int i, Unit& u) const {
        const long L = (long)i * G + c; if (L >= nwg) return false;
        int wgid = (int)L; { const int q = nwg / NXCD, r = nwg % NXCD, xcd = wgid % NXCD, off = wgid / NXCD; wgid = (xcd < r ? xcd * (q + 1) : r * (q + 1) + (xcd - r) * q) + off; }
        const int nig = WGM * nN, gid = wgid / nig, fm = gid * WGM, gsz = (nM - fm) < WGM ? (nM - fm) : WGM;
        u.pm = fm + ((wgid % nig) % gsz); u.pn = (wgid % nig) / gsz; return true;
    }
    __device__ __forceinline__ void a_ready(const Unit&) const {}
    __device__ __forceinline__ void done(const Unit&) const {}
};
__device__ __forceinline__ unsigned cvt_pk_bf16(float lo, float hi) { unsigned r; asm volatile("v_cvt_pk_bf16_f32 %0, %1, %2" : "=v"(r) : "v"(lo), "v"(hi)); return r; }
template <class Epi, class Sched, bool ALIGN_EPI = false, bool SP2 = false>
__device__ __forceinline__ void gemm_phase(PG8_LAS unsigned char* lds, const Gemm g, const Sched& S, const Epi& E) {
    const int tid = threadIdx.x, wid = __builtin_amdgcn_readfirstlane(tid >> 6), lane = tid & 63, wr = wid >> 2, wc = wid & 3, fr = lane & 15, fq = lane >> 4;
    const int K = g.K, nt = K / BK;
    unsigned voffA[2], voffB[2];
#pragma unroll
    for (int i = 0; i < 2; ++i) { int R, C; stage_rc(tid * 16 + i * 8192, R, C); const int Rb = Epi::PERM ? ((R & ~31) + perm32(R & 31)) : R;
        voffA[i] = (unsigned)(R * g.lda + C) * 2u; voffB[i] = (unsigned)(Rb * g.ldb + C) * 2u; }
    const size_t kstep = (size_t)(BK * 2);
    const size_t hsA = (size_t)HALF * g.lda * 2, hsB = (size_t)HALF * g.ldb * 2;
    const size_t tsA = 2 * hsA, tsB = 2 * hsB;
    const unsigned ldsw = (unsigned)wid * 1024u;
    const int aoff = lds_byte(wr * 64 + fr, fq * 8), boff = lds_byte(wc * 32 + fr, fq * 8);
#define PG8_SA(b, h) (((b) * 2 + (h)) * HTB)
#define PG8_SB(b, h) ((4 + (b) * 2 + (h)) * HTB)
#define PG8_STAGE(bufoff, gbase, voff) do { _Pragma("unroll") for (int _i = 0; _i < 2; ++_i) \
        __builtin_amdgcn_global_load_lds((const unsigned*)((const char*)(gbase) + (voff)[_i]), (PG8_LAS unsigned*)(lds + (bufoff) + ldsw + _i * 8192), 16, 0, 0); } while (0)
#define PG8_LDA(dst, b, h) do { _Pragma("unroll") for (int m = 0; m < 4; ++m) _Pragma("unroll") for (int k = 0; k < 2; ++k) dst[m][k] = *(const PG8_LAS bf16x8*)(lds + PG8_SA(b, h) + aoff + m * 2048 + k * 1024); } while (0)
#define PG8_LDB(dst, b, h) do { _Pragma("unroll") for (int n = 0; n < 2; ++n) _Pragma("unroll") for (int k = 0; k < 2; ++k) dst[n][k] = *(const PG8_LAS bf16x8*)(lds + PG8_SB(b, h) + boff + n * 2048 + k * 1024); } while (0)
#define PG8_MMA(ai, bj, At, Bt) do { __builtin_amdgcn_s_setprio(1); _Pragma("unroll") for (int m = 0; m < 4; ++m) _Pragma("unroll") for (int n = 0; n < 2; ++n) _Pragma("unroll") for (int k = 0; k < 2; ++k) \
        acc[ai][bj][m][n] = __builtin_amdgcn_mfma_f32_16x16x32_bf16(Bt[n][k], At[m][k], acc[ai][bj][m][n], 0, 0, 0); __builtin_amdgcn_s_setprio(0); } while (0)
#define PG8_WAIT_V(n) asm volatile("s_waitcnt vmcnt(" #n ")" ::: "memory")
#define PG8_WAIT_L(n) asm volatile("s_waitcnt lgkmcnt(" #n ")" ::: "memory")
#define PG8_BAR __builtin_amdgcn_s_barrier()
#define PG8_SCHED __builtin_amdgcn_sched_barrier(0)
    Unit cur, nxt; int ui = 0;
    if (!S.next(0, cur)) return;
    f32x4 acc[2][2][4][2];
#pragma unroll
    for (int a = 0; a < 2; ++a)
#pragma unroll
        for (int b = 0; b < 2; ++b)
#pragma unroll
            for (int m = 0; m < 4; ++m)
#pragma unroll
                for (int n = 0; n < 2; ++n) acc[a][b][m][n] = (f32x4){0.f, 0.f, 0.f, 0.f};
    bf16x8 At[4][2], B0[2][2], B1[2][2];
    const char* cA = (const char*)g.A + (size_t)cur.pm * tsA + (size_t)(cur.pn >> g.pn_shift) * g.aoffn; const char* cB = (const char*)g.Bt + (size_t)(cur.pn & g.pn_mask) * tsB + (size_t)(cur.pn >> g.pn_shift) * g.boffk;
    S.a_ready(cur);
    if constexpr (SP2) {
        PG8_STAGE(PG8_SB(0, 0), cB, voffB); PG8_STAGE(PG8_SB(0, 1), cB + hsB, voffB); PG8_STAGE(PG8_SA(0, 0), cA, voffA); PG8_STAGE(PG8_SA(0, 1), cA + hsA, voffA);
        if (wr == 1) PG8_BAR;
        PG8_WAIT_V(2); PG8_BAR;
        PG8_STAGE(PG8_SB(1, 0), cB + kstep, voffB); PG8_STAGE(PG8_SA(1, 0), cA + kstep, voffA); PG8_STAGE(PG8_SB(1, 1), cB + hsB + kstep, voffB);
        PG8_WAIT_V(6); PG8_BAR;
    } else {
        PG8_STAGE(PG8_SB(0, 0), cB, voffB); PG8_STAGE(PG8_SA(0, 0), cA, voffA); PG8_STAGE(PG8_SB(0, 1), cB + hsB, voffB); PG8_STAGE(PG8_SA(0, 1), cA + hsA, voffA);
        if (wr == 1) PG8_BAR;
        PG8_WAIT_V(4); PG8_BAR;
        PG8_STAGE(PG8_SB(1, 0), cB + kstep, voffB); PG8_STAGE(PG8_SA(1, 0), cA + kstep, voffA); PG8_STAGE(PG8_SB(1, 1), cB + hsB + kstep, voffB);
        PG8_WAIT_V(6); PG8_BAR;
    }
    for (;;) {
        const bool has_next = S.next(ui + 1, nxt);
        const char* nA = has_next ? (const char*)g.A + (size_t)nxt.pm * tsA + (size_t)(nxt.pn >> g.pn_shift) * g.aoffn : cA; const char* nB = has_next ? (const char*)g.Bt + (size_t)(nxt.pn & g.pn_mask) * tsB + (size_t)(nxt.pn >> g.pn_shift) * g.boffk : cB;
#pragma nounroll
        for (int t = 0; t < nt; t += 2) {
            const bool last = (t == nt - 2);
            const char* a1 = cA + (size_t)(t + 1) * kstep;
            const char* a2 = last ? nA : cA + (size_t)(t + 2) * kstep; const char* b2 = last ? nB : cB + (size_t)(t + 2) * kstep;
            const char* a3 = a2 + kstep; const char* b3 = b2 + kstep;
            if (last && has_next) S.a_ready(nxt);
            if constexpr (SP2) {
            PG8_LDB(B0, 0, 0); PG8_LDB(B1, 0, 1); PG8_SCHED; PG8_LDA(At, 0, 0); PG8_STAGE(PG8_SA(1, 1), a1 + hsA, voffA);
            PG8_WAIT_V(8); PG8_WAIT_L(0); PG8_BAR; PG8_MMA(0, 0, At, B0); PG8_MMA(0, 1, At, B1); PG8_BAR; PG8_SCHED;
            PG8_LDA(At, 0, 1); PG8_STAGE(PG8_SB(0, 0), b2, voffB); PG8_STAGE(PG8_SB(0, 1), b2 + hsB, voffB); PG8_STAGE(PG8_SA(0, 0), a2, voffA);
            PG8_WAIT_V(8); PG8_WAIT_L(0); PG8_BAR; PG8_MMA(1, 0, At, B0); PG8_MMA(1, 1, At, B1); PG8_BAR; PG8_SCHED;
            PG8_LDB(B0, 1, 0); PG8_LDB(B1, 1, 1); PG8_SCHED; PG8_LDA(At, 1, 0); PG8_STAGE(PG8_SA(0, 1), a2 + hsA, voffA);
            PG8_WAIT_V(8); PG8_WAIT_L(0); PG8_BAR; PG8_MMA(0, 0, At, B0); PG8_MMA(0, 1, At, B1); PG8_BAR; PG8_SCHED;
            PG8_LDA(At, 1, 1); PG8_STAGE(PG8_SB(1, 0), b3, voffB); PG8_STAGE(PG8_SB(1, 1), b3 + hsB, voffB); PG8_STAGE(PG8_SA(1, 0), a3, voffA);
            PG8_WAIT_V(8); PG8_WAIT_L(0); PG8_BAR; PG8_MMA(1, 0, At, B0); PG8_MMA(1, 1, At, B1); PG8_BAR; PG8_SCHED;
            } else {
            PG8_LDB(B0, 0, 0); PG8_SCHED; PG8_LDA(At, 0, 0); PG8_STAGE(PG8_SA(1, 1), a1 + hsA, voffA);
            PG8_WAIT_L(8); PG8_BAR; PG8_WAIT_L(0); PG8_MMA(0, 0, At, B0); PG8_BAR; PG8_SCHED;
            PG8_LDB(B1, 0, 1); PG8_STAGE(PG8_SB(0, 0), b2, voffB);
            PG8_BAR; PG8_WAIT_L(0); PG8_MMA(0, 1, At, B1); PG8_BAR;
            PG8_LDA(At, 0, 1); PG8_STAGE(PG8_SA(0, 0), a2, voffA);
            PG8_BAR; PG8_WAIT_L(0); PG8_MMA(1, 0, At, B0); PG8_BAR; PG8_SCHED;
            PG8_STAGE(PG8_SB(0, 1), b2 + hsB, voffB);
            PG8_WAIT_V(6); PG8_BAR; PG8_MMA(1, 1, At, B1); PG8_BAR;
            PG8_LDB(B0, 1, 0); PG8_SCHED; PG8_LDA(At, 1, 0); PG8_STAGE(PG8_SA(0, 1), a2 + hsA, voffA);
            PG8_WAIT_L(8); PG8_BAR; PG8_WAIT_L(0); PG8_MMA(0, 0, At, B0); PG8_BAR; PG8_SCHED;
            PG8_LDB(B1, 1, 1); PG8_STAGE(PG8_SB(1, 0), b3, voffB);
            PG8_BAR; PG8_WAIT_L(0); PG8_MMA(0, 1, At, B1); PG8_BAR;
            PG8_LDA(At, 1, 1); PG8_STAGE(PG8_SA(1, 0), a3, voffA);
            PG8_BAR; PG8_WAIT_L(0); PG8_MMA(1, 0, At, B0); PG8_BAR; PG8_SCHED;
            PG8_STAGE(PG8_SB(1, 1), b3 + hsB, voffB);
            PG8_WAIT_V(6); PG8_BAR; PG8_MMA(1, 1, At, B1); PG8_BAR;
            }
        }
        if constexpr (ALIGN_EPI) { if (wr == 0) PG8_BAR; }
        if constexpr (!Epi::AFTER_DRAIN) { E(acc, cur, wr, wc, fr, fq); S.done(cur); }
        if (!has_next) break;
#pragma unroll
        for (int a = 0; a < 2; ++a)
#pragma unroll
            for (int b = 0; b < 2; ++b)
#pragma unroll
                for (int m = 0; m < 4; ++m)
#pragma unroll
                    for (int n = 0; n < 2; ++n) acc[a][b][m][n] = (f32x4){0.f, 0.f, 0.f, 0.f};
        cur = nxt; cA = nA; cB = nB; ++ui;
        if constexpr (ALIGN_EPI) { if (wr == 1) PG8_BAR; }
    }
    PG8_WAIT_V(0);
    if constexpr (!ALIGN_EPI) { if (wr == 0) PG8_BAR; }
    PG8_BAR;
    if constexpr (Epi::AFTER_DRAIN) { E.fused(acc, cur, wr, wc, fr, fq, lds, wid, lane); S.done(cur); }
#undef PG8_SA
#undef PG8_SB
#undef PG8_STAGE
#undef PG8_LDA
#undef PG8_LDB
#undef PG8_MMA
#undef PG8_WAIT_V
#undef PG8_WAIT_L
#undef PG8_BAR
#undef PG8_SCHED
}}

constexpr int NWAVES = 8;
#ifndef MK_PER_PHASE
#define MK_PER_PHASE 0
#endif
constexpr int N_PHASES = 16;

constexpr int D = 1024, NB = 4, SEQ = 4096, DB = 128, DSEQ = 8, PAST = 8192, PAGE = 128, NPAGES = 64;
constexpr int NH = 8, QLORA = 384, KVL = 256, NOPE = 128, ROPE = 64, VD = 128, FF = 4096;
constexpr int MP = NB * SEQ, MS = DB * DSEQ, M = MP + MS;
constexpr int NSEQ = NB + DB;
constexpr int DIN = 5824, NIN = 5888;
constexpr int NSM = 768, NBIG = 3072, NQ = 1536;
constexpr int NPOS = SEQ + DSEQ;
constexpr float EPS = 1e-6f;
constexpr float QSCALE = 0.07216878364870322f * 1.4426950408889634f;

constexpr size_t MiB = 1u << 20;
constexpr size_t WS_CTL = 0, CTL_ZERO_BYTES = 1 * MiB;
constexpr size_t WS_MOD = 1 * MiB, WS_TAB = 5 * MiB, WS_SILU = 7 * MiB, WS_WIN = 8 * MiB, WS_WQB = 20 * MiB, WS_WKVB = 22 * MiB, WS_WUK = 23 * MiB, WS_WO = 24 * MiB, WS_W1 = 26 * MiB, WS_W2 = 34 * MiB;
constexpr size_t WS_U = 42 * MiB, WS_SM = 76 * MiB, WS_BIG = 128 * MiB, WS_QA = 298 * MiB, WS_CKVN = 311 * MiB, WS_QB = 320 * MiB, WS_KP = 371 * MiB, WS_VP = 419 * MiB;
constexpr size_t WS_QL = 451 * MiB, WS_KNEW = 456 * MiB, WS_OLAT = 457 * MiB, WS_ATT = 461 * MiB, WS_MERGED = 495 * MiB, WS_X1 = 529 * MiB, WS_HDN = 597 * MiB, WS_PART = 733 * MiB, WS_ML = 766 * MiB, WS_P1 = 768 * MiB, WS_P2 = 784 * MiB, WS_END = 816 * MiB;
static_assert(WS_MOD + (size_t)NSEQ * 6 * D * 4 <= WS_TAB && WS_TAB + (size_t)NPOS * 32 * 8 <= WS_WIN && WS_WIN + (size_t)NIN * D * 2 <= WS_WQB && WS_WQB + (size_t)NQ * QLORA * 2 <= WS_WKVB, "ws map 1");
static_assert(WS_WKVB + (size_t)2048 * 256 * 2 <= WS_WUK && WS_WUK + (size_t)2048 * 256 * 2 <= WS_WO && WS_WO + (size_t)D * D * 2 <= WS_W1 && WS_W1 + (size_t)FF * D * 2 <= WS_W2 && WS_W2 + (size_t)FF * D * 2 <= WS_U, "ws map 2");
static_assert(WS_U + (size_t)M * D * 2 <= WS_SM && WS_SM + (size_t)M * NSM * 4 <= WS_BIG && WS_BIG + (size_t)M * NBIG * 2 <= WS_QA && WS_QA + (size_t)M * QLORA * 2 <= WS_CKVN && WS_CKVN + (size_t)M * KVL * 2 <= WS_QB, "ws map 3");
static_assert(WS_QB + (size_t)M * NQ * 2 <= WS_KP && WS_KP + (size_t)MP * NH * 192 * 2 <= WS_VP && WS_VP + (size_t)MP * NH * 128 * 2 <= WS_QL && WS_QL + (size_t)MS * NH * 320 * 2 <= WS_KNEW && WS_KNEW + (size_t)MS * 320 * 2 <= WS_OLAT, "ws map 4");
static_assert(WS_OLAT + (size_t)MS * NH * 256 * 2 <= WS_ATT && WS_ATT + (size_t)M * D * 2 <= WS_MERGED && WS_MERGED + (size_t)M * D * 2 <= WS_X1 && WS_X1 + (size_t)M * D * 4 <= WS_HDN && WS_HDN + (size_t)M * FF * 2 <= WS_PART, "ws map 5");
constexpr size_t O_Y = 0, O_CKVP = (size_t)M * D, O_KRP = O_CKVP + (size_t)MP * KVL, O_CVP = O_KRP + (size_t)MP * ROPE, O_CKVS = O_CVP + (size_t)NB * 2 * D, O_KRS = O_CKVS + (size_t)MS * KVL, O_CVS = O_KRS + (size_t)MS * ROPE, O_END = O_CVS + (size_t)DB * 2 * D;
static_assert(O_END == 23666688, "d_out size");
constexpr int CW_TMO = 0, CW_CODE = 1, CW_BAR = 4096;
constexpr int RING_OFF = 0, RING_BYTES = 131072;
constexpr int LDSCTL_OFF = RING_BYTES, MISC_OFF = LDSCTL_OFF + 320;
constexpr int LDS_BYTES = 147456;
static_assert(MISC_OFF + 128 <= LDS_BYTES, "LDS map");

#define GAS __attribute__((address_space(1)))
#define LAS __attribute__((address_space(3)))
typedef unsigned short bf16;
typedef unsigned v4u __attribute__((ext_vector_type(4)));
typedef unsigned v2u __attribute__((ext_vector_type(2)));
typedef float f32x4 __attribute__((ext_vector_type(4)));
typedef float f32x2 __attribute__((ext_vector_type(2)));
typedef float f32x16 __attribute__((ext_vector_type(16)));
typedef short bf16x8 __attribute__((ext_vector_type(8)));
typedef GAS unsigned gu32;
#define RLX_AGENT __ATOMIC_RELAXED, __HIP_MEMORY_SCOPE_AGENT
#define LDS_WAIT() asm volatile("s_waitcnt lgkmcnt(0)" ::: "memory")
#define VM_WAIT() asm volatile("s_waitcnt vmcnt(0)" ::: "memory")
__device__ __forceinline__ unsigned f2bf(float f) { unsigned u = __builtin_bit_cast(unsigned, f); return (u + 0x7fffu + ((u >> 16) & 1u)) >> 16; }
__device__ __forceinline__ unsigned pk2(float lo, float hi) { return f2bf(lo) | (f2bf(hi) << 16); }
__device__ __forceinline__ float bf2f(unsigned short b) { return __builtin_bit_cast(float, (unsigned)b << 16); }
__device__ __forceinline__ float bflo(unsigned w) { return __builtin_bit_cast(float, w << 16); }
__device__ __forceinline__ float bfhi(unsigned w) { return __builtin_bit_cast(float, w & 0xffff0000u); }
#define XB_TMO      128
#define XB_XCNT(j)  (256  + 64 * (j))
#define XB_XSUB(j)  (1280 + 64 * (j))
#define XB_XGEN(j)  (2304 + 64 * (j))
#define XB_TOP      3328
#define XB_TOPGEN   3392
#define XCD_BAR_WORDS 3456
#define XB_SPIN_CAP (1u << 18)

__device__ __forceinline__ unsigned xb_ld(unsigned* p)              { return __hip_atomic_load(p, __ATOMIC_RELAXED, __HIP_MEMORY_SCOPE_AGENT); }
__device__ __forceinline__ unsigned xb_add(unsigned* p, unsigned v) { return __hip_atomic_fetch_add(p, v, __ATOMIC_RELAXED, __HIP_MEMORY_SCOPE_AGENT); }
__device__ __forceinline__ unsigned xb_xcc_id() { return (unsigned)__builtin_amdgcn_s_getreg((3 << 11) | 20) & 0xFu; }
#define XB_SPIN(cond, bar) do { unsigned _sp = 0; while (cond) { __builtin_amdgcn_s_sleep(1); \
    if ((++_sp & 255u) == 0u) { if (xb_ld(&(bar)[XB_TMO])) break; if (_sp > XB_SPIN_CAP) { atomicAdd(&(bar)[XB_TMO], 1u); break; } } } } while (0)

struct XcdBarrier {
    unsigned* bar; unsigned x;
    volatile LAS unsigned* st;
};

__device__ __forceinline__ XcdBarrier xcd_barrier_post(unsigned* bar, volatile LAS unsigned* st) {
    XcdBarrier b; b.bar = bar; b.x = xb_xcc_id(); b.st = st;
    if (threadIdx.x == 0) (void)xb_add(&bar[XB_XCNT(b.x)], 1u);
    return b;
}
__device__ __forceinline__ void xcd_barrier_complete(unsigned* bar, unsigned x, unsigned& nloc, unsigned& nx) {
    const unsigned G = gridDim.x * gridDim.y * gridDim.z;
    unsigned sum, cnt, mine, sp = 0u;
    for (;;) {
        sum = 0u; cnt = 0u; mine = 0u;
#pragma unroll
        for (unsigned j = 0; j < 16; ++j) { const unsigned c = xb_ld(&bar[XB_XCNT(j)]); sum += c; cnt += (c > 0u) ? 1u : 0u; mine = (j == x) ? c : mine; }
        if (sum == G) break;
        __builtin_amdgcn_s_sleep(1);
        if ((++sp & 255u) == 0u) { if (xb_ld(&bar[XB_TMO])) break; if (sp > XB_SPIN_CAP) { atomicAdd(&bar[XB_TMO], 1u); break; } }
    }
    nloc = mine > 0u ? mine : 1u; nx = cnt > 0u ? cnt : 1u;
}

__device__ __forceinline__ void xcd_barrier(const XcdBarrier& b) {
    asm volatile("s_waitcnt vmcnt(0)" ::: "memory");
    __syncthreads();
    if (threadIdx.x == 0) {
        unsigned* bar = b.bar;
        __builtin_amdgcn_s_waitcnt(0);
        unsigned nloc = b.st[0], nx = b.st[1];
        if (nloc == 0u) { xcd_barrier_complete(bar, b.x, nloc, nx); b.st[0] = nloc; b.st[1] = nx; }
        const unsigned old = xb_add(&bar[XB_XSUB(b.x)], 1u);
        const unsigned gen = old / nloc;
        if (old + 1u == (gen + 1u) * nloc) {
            __builtin_amdgcn_fence(__ATOMIC_RELEASE, "agent");
            asm volatile("s_waitcnt vmcnt(0)" ::: "memory");
            const unsigned og = xb_add(&bar[XB_TOP], 1u);
            const unsigned tg = og / nx;
            if (og + 1u == (tg + 1u) * nx) xb_add(&bar[XB_TOPGEN], 1u);
            else XB_SPIN(xb_ld(&bar[XB_TOPGEN]) == tg, bar);
            __builtin_amdgcn_fence(__ATOMIC_ACQUIRE, "agent");
            xb_add(&bar[XB_XGEN(b.x)], 1u);
            asm volatile("s_waitcnt vmcnt(0)" ::: "memory");
        } else {
            XB_SPIN(xb_ld(&bar[XB_XGEN(b.x)]) == gen, bar);
            __builtin_amdgcn_fence(__ATOMIC_ACQUIRE, "agent");
            asm volatile("s_waitcnt vmcnt(0)" ::: "memory");
        }
    }
    __syncthreads();
}
struct Frame {
    LAS unsigned char* lds; volatile LAS unsigned* MISC; gu32* ctl;
    int tid, lane, wave, G, gw, NGW;
    const float *x_p, *x_s, *cache_ckv, *cache_kr, *state_conv; const int* page_table;
    const float *c_p, *c_s, *w_ada, *b_ada, *g_attn, *w_in, *g_q, *w_q_b, *g_kv, *w_kv_b, *conv_w, *w_o, *g_mlp, *w_1, *w_2, *g_final;
    float* out; unsigned char* ws;
};
__device__ const double ROPE_INV[32] = {1.0, 0.7498942093324559, 0.5623413251903491, 0.4216965034285822, 0.31622776601683794, 0.23713737056616552, 0.1778279410038923, 0.1333521432163324,
    0.1, 0.07498942093324558, 0.05623413251903491, 0.042169650342858224, 0.03162277660168379, 0.023713737056616554, 0.01778279410038923, 0.01333521432163324,
    0.01, 0.007498942093324558, 0.005623413251903491, 0.004216965034285823, 0.0031622776601683794, 0.0023713737056616554, 0.0017782794100389228, 0.001333521432163324,
    0.001, 0.0007498942093324559, 0.0005623413251903491, 0.00042169650342858224, 0.00031622776601683794, 0.00023713737056616554, 0.00017782794100389227, 0.0001333521432163324};

__device__ __forceinline__ float wave_sum(float v) {
#pragma unroll
    for (int o = 1; o < 64; o <<= 1) v += __shfl_xor(v, o);
    return v;
}
__device__ __forceinline__ float wave_max(float v) {
#pragma unroll
    for (int o = 1; o < 64; o <<= 1) v = fmaxf(v, __shfl_xor(v, o));
    return v;
}
__device__ __forceinline__ float silu_f(float x) { return x / (1.f + __expf(-x)); }
__device__ __forceinline__ float sigmoid_f(float x) { return 1.f / (1.f + __expf(-x)); }
__device__ __forceinline__ int seq_of_row(int row) { return row < MP ? (row >> 12) : NB + ((row - MP) >> 3); }
__device__ __forceinline__ int pidx_of_row(int row) { return row < MP ? (row & (SEQ - 1)) : SEQ + ((row - MP) & (DSEQ - 1)); }
__device__ __forceinline__ void store8bf(bf16* p, f32x4 a, f32x4 b) {
    v4u w; w.x = pg8::cvt_pk_bf16(a[0], a[1]); w.y = pg8::cvt_pk_bf16(a[2], a[3]); w.z = pg8::cvt_pk_bf16(b[0], b[1]); w.w = pg8::cvt_pk_bf16(b[2], b[3]);
    *(v4u*)p = w;
}
__device__ __forceinline__ void store4bf(bf16* p, f32x4 a) { v2u w; w.x = pg8::cvt_pk_bf16(a[0], a[1]); w.y = pg8::cvt_pk_bf16(a[2], a[3]); *(v2u*)p = w; }

template <int MODE> struct Epi {
    static constexpr bool PERM = true, AFTER_DRAIN = false;
    unsigned char* ws; const float* x_p; const float* x_s; float* out;
    __device__ __forceinline__ void operator()(const pg8::f32x4 (&acc)[2][2][4][2], const pg8::Unit& u, int wr, int wc, int fr, int fq) const {
        const int rowb = u.pm * 256 + wr * 64 + fr, cw = wc * 32 + 8 * fq;
#pragma unroll
        for (int ai = 0; ai < 2; ++ai)
#pragma unroll
            for (int m = 0; m < 4; ++m) {
                const int row = rowb + ai * 128 + m * 16;
#pragma unroll
                for (int bj = 0; bj < 2; ++bj) {
                    const f32x4 v0 = acc[ai][bj][m][0], v1 = acc[ai][bj][m][1];
                    const int col = u.pn * 256 + bj * 128 + cw;
                    if constexpr (MODE == 1) {
                        bf16* big = (bf16*)(ws + WS_BIG) + (size_t)row * NBIG;
                        if (u.pn < 3) { float* p = (float*)(ws + WS_SM) + (size_t)row * NSM + col; *(f32x4*)p = v0; *(f32x4*)(p + 4) = v1; }
                        else if (u.pn < 11) { store4bf(big + ((col - 768) >> 1), v0 * v1); }
                        else if (u.pn < 19) { f32x4 s; s[0] = sigmoid_f(v1[0]); s[1] = sigmoid_f(v1[1]); s[2] = sigmoid_f(v1[2]); s[3] = sigmoid_f(v1[3]);
                                              store4bf(big + 1024 + ((col - 2816) >> 1), v0 * s); }
                        else { f32x4 a, b;
#pragma unroll
                               for (int e = 0; e < 4; ++e) { a[e] = sigmoid_f(v0[e]); b[e] = sigmoid_f(v1[e]); }
                               store8bf(big + 2048 + (col - 4864), a, b); }
                    } else if constexpr (MODE == 2) {
                        bf16* qb = (bf16*)(ws + WS_QB) + (size_t)row * NQ;
                        if (u.pn < 4) { store8bf(qb + col, v0 * QSCALE, v1 * QSCALE); }
                        else {
                            const int r = col - 1024, h = r >> 6, q4 = ((r & 63) >> 3) * 4;
                            const float* tb = (const float*)(ws + WS_TAB) + ((size_t)pidx_of_row(row) * 32 + q4) * 2;
                            const f32x4 t01 = *(const f32x4*)tb, t23 = *(const f32x4*)(tb + 4);
                            f32x4 cs = {t01[0], t01[2], t23[0], t23[2]}, sn = {t01[1], t01[3], t23[1], t23[3]};
                            const f32x4 o1 = (v0 * cs - v1 * sn) * QSCALE, o2 = (v1 * cs + v0 * sn) * QSCALE;
                            store4bf(qb + 1024 + h * 64 + q4, o1); store4bf(qb + 1024 + h * 64 + 32 + q4, o2);
                            if (row >= MP) { bf16* ql = (bf16*)(ws + WS_QL) + ((size_t)(row - MP) * NH + h) * 320 + 256; store4bf(ql + q4, o1); store4bf(ql + 32 + q4, o2); }
                        }
                    } else if constexpr (MODE == 3) {
                        const size_t tok = (size_t)((row >> 12) * NH + u.pn) * SEQ + (row & (SEQ - 1));
                        if (bj == 0) store8bf((bf16*)(ws + WS_KP) + tok * 192 + cw, v0, v1);
                        else         store8bf((bf16*)(ws + WS_VP) + tok * 128 + cw, v0, v1);
                    } else if constexpr (MODE == 4) {
                        store8bf((bf16*)(ws + WS_QL) + ((size_t)row * NH + u.pn) * 320 + bj * 128 + cw, v0, v1);
                    } else if constexpr (MODE == 5) {
                        if (bj == 1) store8bf((bf16*)(ws + WS_ATT) + (size_t)(MP + row) * D + u.pn * 128 + cw, v0, v1);
                    } else if constexpr (MODE == 6 || MODE == 8) {
                        const float* g = (const float*)(ws + WS_MOD) + (size_t)seq_of_row(row) * (6 * D) + (MODE == 6 ? 2 : 5) * D + col;
                        const float* xr = (MODE == 6) ? ((row < MP ? x_p + (size_t)row * D : x_s + (size_t)(row - MP) * D) + col) : ((const float*)(ws + WS_X1) + (size_t)row * D + col);
                        float* o = (MODE == 6) ? ((float*)(ws + WS_X1) + (size_t)row * D + col) : (out + O_Y + (size_t)row * D + col);
                        const f32x4 g0 = *(const f32x4*)g, g1 = *(const f32x4*)(g + 4), x0 = *(const f32x4*)xr, x1 = *(const f32x4*)(xr + 4);
                        *(f32x4*)o = x0 + g0 * v0; *(f32x4*)(o + 4) = x1 + g1 * v1;
                    } else if constexpr (MODE == 9 || MODE == 10) {
                        float* p = (float*)(ws + (MODE == 9 ? WS_P1 : WS_P2)) + ((size_t)(u.pn >> 2) * MS + row) * D + (u.pn & 3) * 256 + bj * 128 + cw;
                        *(f32x4*)p = v0; *(f32x4*)(p + 4) = v1;
                    } else if constexpr (MODE == 7) {
                        f32x4 a = v0, b = v1;
#pragma unroll
                        for (int e = 0; e < 4; ++e) { a[e] = fmaxf(a[e], 0.f); a[e] *= a[e]; b[e] = fmaxf(b[e], 0.f); b[e] *= b[e]; }
                        store8bf((bf16*)(ws + WS_HDN) + (size_t)row * FF + col, a, b);
                    }
                }
                asm volatile("" ::: "memory");
            }
    }
};

template <int MAP> __device__ __forceinline__ int wt_row(int n) {
    if constexpr (MAP == 0) return n;
    else if constexpr (MAP == 1) {
        if (n < 704) return n;
        if (n < 1728) { const int j = n - 704;  return 768 + 2048 + 8 * (j >> 2) + (j & 3); }
        if (n < 2752) { const int j = n - 1728; return 768 + 8 * (j >> 2) + (j & 3); }
        if (n < 3776) { const int j = n - 2752; return 768 + 8 * (j >> 2) + 4 + (j & 3); }
        if (n < 4800) { const int j = n - 3776; return 768 + 4096 + j; }
        { const int j = n - 4800; return 768 + 2048 + 8 * (j >> 2) + 4 + (j & 3); } }
    else { const int h = n / 192, j = n - h * 192;
        if (j < 128) return h * 128 + j;
        const int i = j - 128, x2 = i >> 5, idx = i & 31;
        return 1024 + h * 64 + 8 * (idx >> 2) + 4 * x2 + (idx & 3); }
}
template <int MAP> __device__ __forceinline__ void transpose_item(const float* W, int K, int N, bf16* WT, const float* kscale, LAS float* scr, int item, int lane) {
    const int nblk = N / 32, kb = item / nblk, nb = item % nblk, k0 = 64 * kb, n0 = 32 * nb;
#pragma unroll 8
    for (int i = 0; i < 32; ++i) { const int kk = 2 * i + (lane >> 5); scr[kk * 33 + (lane & 31)] = W[(size_t)(k0 + kk) * N + n0 + (lane & 31)]; }
    LDS_WAIT(); asm volatile("" ::: "memory");
    const int c = lane & 7;
    float ks[8];
#pragma unroll
    for (int e = 0; e < 8; ++e) ks[e] = kscale ? kscale[k0 + 8 * c + e] : 1.f;
#pragma unroll
    for (int j = 0; j < 4; ++j) { const int n = (lane >> 3) + 8 * j; const LAS float* s = scr + (8 * c) * 33 + n;
        v4u o; o.x = pk2(s[0 * 33] * ks[0], s[1 * 33] * ks[1]); o.y = pk2(s[2 * 33] * ks[2], s[3 * 33] * ks[3]); o.z = pk2(s[4 * 33] * ks[4], s[5 * 33] * ks[5]); o.w = pk2(s[6 * 33] * ks[6], s[7 * 33] * ks[7]);
        *(GAS v4u*)(WT + (size_t)wt_row<MAP>(n0 + n) * K + k0 + 8 * c) = o; }
    LDS_WAIT(); asm volatile("" ::: "memory");
}
__device__ __forceinline__ int crow32(int r, int hi) { return (r & 3) + 8 * (r >> 2) + 4 * hi; }
__device__ __forceinline__ bf16x8 pack8f(const float* a) {
    v4u w; w.x = pg8::cvt_pk_bf16(a[0], a[1]); w.y = pg8::cvt_pk_bf16(a[2], a[3]); w.z = pg8::cvt_pk_bf16(a[4], a[5]); w.w = pg8::cvt_pk_bf16(a[6], a[7]);
    return __builtin_bit_cast(bf16x8, w);
}
__device__ __forceinline__ void adaln_task(Frame& F, int et) {
    const int e0 = et * 32, r = F.lane & 31, h = F.lane >> 5, w = F.wave;
    f32x16 acc[5];
#pragma unroll
    for (int st = 0; st < 5; ++st)
#pragma unroll
        for (int i = 0; i < 16; ++i) acc[st][i] = 0.f;
    const bf16x8* sil = (const bf16x8*)(F.ws + WS_SILU) + (size_t)(w * 8) * 64 + F.lane;
    float aA[8], aB[8]; bf16x8 bA[5], bB[5];
#define ADA_LOAD(ks, a_, b_) do { const int k0_ = w * 128 + (ks) * 16 + 8 * h;                                         \
        _Pragma("unroll") for (int j = 0; j < 8; ++j) a_[j] = F.w_ada[(size_t)(k0_ + j) * (6 * D) + e0 + r];            \
        _Pragma("unroll") for (int st = 0; st < 5; ++st) b_[st] = sil[((size_t)st * 64 + (ks)) * 64]; } while (0)
#define ADA_COMP(a_, b_) do { const bf16x8 af = pack8f(a_);                                                              \
        _Pragma("unroll") for (int st = 0; st < 5; ++st) acc[st] = __builtin_amdgcn_mfma_f32_32x32x16_bf16(af, b_[st], acc[st], 0, 0, 0); } while (0)
    ADA_LOAD(0, aA, bA);
#pragma nounroll
    for (int ks = 0; ks < 8; ks += 2) {
        ADA_LOAD(ks + 1, aB, bB);
        __builtin_amdgcn_sched_barrier(0);
        ADA_COMP(aA, bA);
        __builtin_amdgcn_sched_barrier(0);
        ADA_LOAD(ks + 2 < 8 ? ks + 2 : 7, aA, bA);
        __builtin_amdgcn_sched_barrier(0);
        ADA_COMP(aB, bB);
        __builtin_amdgcn_sched_barrier(0);
    }
#undef ADA_LOAD
#undef ADA_COMP
    LAS float* red = (LAS float*)F.lds;
    float* mod = (float*)(F.ws + WS_MOD);
#pragma unroll
    for (int st = 0; st < 5; ++st) {
#pragma unroll
        for (int i = 0; i < 16; ++i) red[(w * 16 + i) * 64 + F.lane] = acc[st][i];
        __syncthreads();
#pragma unroll
        for (int q = 0; q < 2; ++q) {
            const int idx = F.tid + 512 * q, reg = idx >> 6, lo = idx & 63;
            float sum = 0.f;
#pragma unroll
            for (int ww = 0; ww < 8; ++ww) sum += red[ww * 1024 + idx];
            const int s = 32 * st + (lo & 31), e = e0 + crow32(reg, lo >> 5);
            if (s < NSEQ) mod[(size_t)s * (6 * D) + e] = sum + F.b_ada[e];
        }
        __syncthreads();
    }
}
struct TItem { const float* W; bf16* WT; const float* ks; int K, N, map, item; };
__device__ __forceinline__ int wt_row_rt(int map, int n) { return map == 0 ? n : (map == 1 ? wt_row<1>(n) : wt_row<2>(n)); }
__device__ __forceinline__ void ti_load(const TItem& d, int lane, float (&r)[32]) {
    const int nblk = d.N / 32, kb = d.item / nblk, nb = d.item - kb * nblk; const float* s = d.W + (size_t)(64 * kb + (lane >> 5)) * d.N + 32 * nb + (lane & 31);
#pragma unroll
    for (int i = 0; i < 32; ++i) r[i] = s[(size_t)(2 * i) * d.N];
}
__device__ __forceinline__ void ti_to_lds(const float (&r)[32], LAS float* scr, int lane) {
#pragma unroll
    for (int i = 0; i < 32; ++i) scr[(2 * i + (lane >> 5)) * 33 + (lane & 31)] = r[i];
    LDS_WAIT(); asm volatile("" ::: "memory");
}
__device__ __forceinline__ void ti_store(const TItem& d, LAS float* scr, int lane) {
    const int nblk = d.N / 32, kb = d.item / nblk, nb = d.item - kb * nblk, k0 = 64 * kb, n0 = 32 * nb, c = lane & 7;
    float ks[8];
#pragma unroll
    for (int e = 0; e < 8; ++e) ks[e] = d.ks ? d.ks[k0 + 8 * c + e] : 1.f;
#pragma unroll
    for (int j = 0; j < 4; ++j) { const int n = (lane >> 3) + 8 * j; const LAS float* s = scr + (8 * c) * 33 + n;
        v4u o; o.x = pk2(s[0 * 33] * ks[0], s[1 * 33] * ks[1]); o.y = pk2(s[2 * 33] * ks[2], s[3 * 33] * ks[3]); o.z = pk2(s[4 * 33] * ks[4], s[5 * 33] * ks[5]); o.w = pk2(s[6 * 33] * ks[6], s[7 * 33] * ks[7]);
        *(GAS v4u*)(d.WT + (size_t)wt_row_rt(d.map, n0 + n) * d.K + k0 + 8 * c) = o; }
    LDS_WAIT(); asm volatile("" ::: "memory");
}
__device__ __forceinline__ void p0_prologue(Frame& F) {
    constexpr int NADA = 1 << 30;
    LAS float* scr = (LAS float*)(F.lds + RING_OFF + F.wave * 16384);
    constexpr int I_IN = (D / 64) * (DIN / 32), I_QB = (QLORA / 64) * (NQ / 32), I_KVB = (KVL / 64) * (2048 / 32), I_O = (D / 64) * (D / 32), I_1 = (D / 64) * (FF / 32), I_2 = (FF / 64) * (D / 32);
    constexpr int NITEMS = I_IN + I_QB + I_KVB + I_O + I_1 + I_2;
    const int nfree = F.G > NADA ? (F.G - NADA) * NWAVES : 0;
    const int XTRA = 4;
    const int nx = nfree * XTRA < NITEMS ? nfree * XTRA : 0;
    const int fw = ((int)blockIdx.x - NADA) * NWAVES + F.wave;
#define TI_NEXT(k) ((fw >= 0 && nx > 0) ? ((k) < XTRA ? fw + nfree * (k) : nx + F.gw + ((k) - XTRA) * F.NGW) : nx + F.gw + (k) * F.NGW)
#define TI_DECODE(d, it_) do { int r_ = (it_); \
        if (r_ < I_IN) { d = TItem{F.w_in, (bf16*)(F.ws + WS_WIN), nullptr, D, DIN, 1, r_}; } else { r_ -= I_IN; \
        if (r_ < I_QB) { d = TItem{F.w_q_b, (bf16*)(F.ws + WS_WQB), F.g_q, QLORA, NQ, 2, r_}; } else { r_ -= I_QB; \
        if (r_ < I_KVB) { d = TItem{F.w_kv_b, (bf16*)(F.ws + WS_WKVB), nullptr, KVL, 2048, 0, r_}; } else { r_ -= I_KVB; \
        if (r_ < I_O) { d = TItem{F.w_o, (bf16*)(F.ws + WS_WO), nullptr, D, D, 0, r_}; } else { r_ -= I_O; \
        if (r_ < I_1) { d = TItem{F.w_1, (bf16*)(F.ws + WS_W1), nullptr, D, FF, 0, r_}; } else { r_ -= I_1; \
        d = TItem{F.w_2, (bf16*)(F.ws + WS_W2), nullptr, FF, D, 0, r_}; } } } } } } while (0)
    { int k = 0; int it = TI_NEXT(0);
      if (it < NITEMS) {
        TItem cur; TI_DECODE(cur, it); float ra[32]; ti_load(cur, F.lane, ra);
        for (;;) {
            ti_to_lds(ra, scr, F.lane);
            ++k; const int nit = TI_NEXT(k); const bool more = nit < NITEMS; TItem nxt = cur;
            if (more) { TI_DECODE(nxt, nit); ti_load(nxt, F.lane, ra); }
            ti_store(cur, scr, F.lane);
            if (!more) break;
            cur = nxt;
        } } }
#undef TI_NEXT
#undef TI_DECODE
    const int gt = F.gw * 64 + F.lane, NGT = F.NGW * 64;
    for (int i = gt; i < 64 * D / 8; i += NGT) *(v4u*)((bf16*)(F.ws + WS_WIN) + (size_t)704 * D + (size_t)i * 8) = (v4u){0u, 0u, 0u, 0u};
    for (int i = gt; i < 2048 * 256 / 8; i += NGT) {
        const int row = i >> 5, k8 = (i & 31) * 8, hh = row >> 8, c = row & 255; v4u o = {0u, 0u, 0u, 0u};
        if (k8 < 128) { const float* s = F.w_kv_b + (size_t)c * 2048 + hh * 256 + k8; const f32x4 a = *(const f32x4*)s, b = *(const f32x4*)(s + 4);
            o.x = pk2(a[0], a[1]); o.y = pk2(a[2], a[3]); o.z = pk2(b[0], b[1]); o.w = pk2(b[2], b[3]); }
        *(v4u*)((bf16*)(F.ws + WS_WUK) + (size_t)row * 256 + k8) = o;
    }
    for (int i = gt; i < 5 * 64 * 64; i += NGT) {
        const int ln = i & 63, ksg = (i >> 6) & 63, st = i >> 12, s = 32 * st + (ln & 31); v4u o = {0u, 0u, 0u, 0u};
        if (s < NSEQ) { const float* cp = (s < NB ? F.c_p + (size_t)s * D : F.c_s + (size_t)(s - NB) * D) + 16 * ksg + 8 * (ln >> 5); const f32x4 a = *(const f32x4*)cp, b = *(const f32x4*)(cp + 4);
            o.x = pg8::cvt_pk_bf16(silu_f(a[0]), silu_f(a[1])); o.y = pg8::cvt_pk_bf16(silu_f(a[2]), silu_f(a[3])); o.z = pg8::cvt_pk_bf16(silu_f(b[0]), silu_f(b[1])); o.w = pg8::cvt_pk_bf16(silu_f(b[2]), silu_f(b[3])); }
        *((v4u*)(F.ws + WS_SILU) + i) = o;
    }
    for (int i = gt; i < NPOS * 32; i += NGT) {
        const int p = i >> 5, fi = i & 31; const double pos = (double)(p < SEQ ? p : p + (PAST - SEQ));
        const double rev = pos * ROPE_INV[fi] * 0.15915494309189535; const float fr = (float)(rev - __builtin_rint(rev));
        f32x2 cs; cs.x = __builtin_amdgcn_cosf(fr); cs.y = __builtin_amdgcn_sinf(fr);
        *((f32x2*)(F.ws + WS_TAB) + i) = cs;
    }
}
__device__ __forceinline__ void norm_mod_rows4(Frame& F, const float* src, const float* g, const float* sc, const float* sh, bf16* dst) {
    f32x4 v[4][4]; float s[4];
#pragma unroll
    for (int r = 0; r < 4; ++r)
#pragma unroll
        for (int j = 0; j < 4; ++j) v[r][j] = *((const f32x4*)(src + (size_t)r * D) + F.lane + 64 * j);
#pragma unroll
    for (int r = 0; r < 4; ++r) { s[r] = 0.f;
#pragma unroll
        for (int j = 0; j < 4; ++j) s[r] += (v[r][j].x * v[r][j].x + v[r][j].y * v[r][j].y) + (v[r][j].z * v[r][j].z + v[r][j].w * v[r][j].w);
        s[r] = 1.f / sqrtf(wave_sum(s[r]) * (1.f / D) + EPS); }
#pragma unroll
    for (int j = 0; j < 4; ++j) { const int c4 = F.lane + 64 * j; const f32x4 gg = *((const f32x4*)g + c4) * (*((const f32x4*)sc + c4) + 1.f), hh = *((const f32x4*)sh + c4);
#pragma unroll
        for (int r = 0; r < 4; ++r) store4bf(dst + (size_t)r * D + c4 * 4, (v[r][j] * s[r]) * gg + hh); }
}
__device__ __forceinline__ void small_row(Frame& F, int m) {
    const float* sm = (const float*)(F.ws + WS_SM) + (size_t)m * NSM;
    const int l = F.lane; const bool samp = m >= MP; const int ms = m - MP;
    const f32x4 qa = *((const f32x4*)sm + l); const f32x2 qb = *((const f32x2*)(sm + 256) + l);
    float s = (qa.x * qa.x + qa.y * qa.y) + (qa.z * qa.z + qa.w * qa.w) + (qb.x * qb.x + qb.y * qb.y);
    const float rq = 1.f / sqrtf(wave_sum(s) * (1.f / QLORA) + EPS);
    bf16* qo = (bf16*)(F.ws + WS_QA) + (size_t)m * QLORA;
    store4bf(qo + 4 * l, qa * rq); *(unsigned*)(qo + 256 + 2 * l) = pg8::cvt_pk_bf16(qb.x * rq, qb.y * rq);
    const f32x4 kv = *((const f32x4*)(sm + 384) + l);
    s = (kv.x * kv.x + kv.y * kv.y) + (kv.z * kv.z + kv.w * kv.w);
    const float rk = 1.f / sqrtf(wave_sum(s) * (1.f / KVL) + EPS);
    const f32x4 kn = (kv * rk) * *((const f32x4*)F.g_kv + l);
    float* ock = samp ? F.out + O_CKVS + (size_t)ms * KVL : F.out + O_CKVP + (size_t)m * KVL;
    *((f32x4*)ock + l) = kn;
    store4bf((bf16*)(F.ws + WS_CKVN) + (size_t)m * KVL + 4 * l, kn);
    if (samp) store4bf((bf16*)(F.ws + WS_KNEW) + (size_t)ms * 320 + 4 * l, kn);
    if (l < 32) {
        const float x1 = sm[640 + l], x2 = sm[672 + l];
        const f32x2 cs = *((const f32x2*)(F.ws + WS_TAB) + (size_t)pidx_of_row(m) * 32 + l);
        const float o1 = x1 * cs.x - x2 * cs.y, o2 = x2 * cs.x + x1 * cs.y;
        float* okr = samp ? F.out + O_KRS + (size_t)ms * ROPE : F.out + O_KRP + (size_t)m * ROPE;
        okr[l] = o1; okr[32 + l] = o2;
        const bf16 b1 = (bf16)f2bf(o1), b2 = (bf16)f2bf(o2);
        if (samp) { bf16* kn2 = (bf16*)(F.ws + WS_KNEW) + (size_t)ms * 320 + 256; kn2[l] = b1; kn2[32 + l] = b2; }
        else { const int b = m >> 12, t = m & (SEQ - 1);
#pragma unroll
            for (int hh = 0; hh < NH; ++hh) { bf16* kp = (bf16*)(F.ws + WS_KP) + ((size_t)(b * NH + hh) * SEQ + t) * 192 + 128; kp[l] = b1; kp[32 + l] = b2; } }
    }
    const int t = samp ? (ms & (DSEQ - 1)) : (m & (SEQ - 1)), T = samp ? DSEQ : SEQ;
    if (t >= T - 2) {
        const bf16* big = (const bf16*)(F.ws + WS_BIG) + (size_t)m * NBIG;
        float* oc = (samp ? F.out + O_CVS + (size_t)(ms >> 3) * 2 * D : F.out + O_CVP + (size_t)(m >> 12) * 2 * D) + (size_t)(t - (T - 2)) * D;
#pragma unroll
        for (int j = 0; j < 2; ++j) { const int c8 = (l + 64 * j) * 8;
            const v4u cx = *(const v4u*)(big + c8);
            f32x4 a = {bflo(cx.x), bfhi(cx.x), bflo(cx.y), bfhi(cx.y)}, b = {bflo(cx.z), bfhi(cx.z), bflo(cx.w), bfhi(cx.w)};
            *(f32x4*)(oc + c8) = a; *(f32x4*)(oc + c8 + 4) = b; }
    }
}
__device__ __forceinline__ void naive_attn_prompt_row(Frame& F, int rid) {
    const int h = rid & 7, m = rid >> 3, b = m >> 12, t = m & (SEQ - 1), l = F.lane;
    LAS float* qs = (LAS float*)(F.lds + F.wave * 8192); LAS float* sc = qs + 320;
    const bf16* qb = (const bf16*)(F.ws + WS_QB) + (size_t)m * NQ;
    qs[l] = bf2f(qb[h * 128 + l]); qs[64 + l] = bf2f(qb[h * 128 + 64 + l]); qs[128 + l] = bf2f(qb[1024 + h * 64 + l]);
    LDS_WAIT(); asm volatile("" ::: "memory");
    const bf16* K = (const bf16*)(F.ws + WS_KP) + (size_t)(b * NH + h) * SEQ * 192; const bf16* V = (const bf16*)(F.ws + WS_VP) + (size_t)(b * NH + h) * SEQ * 128;
    const int nk = t + 1; float mx = -1e30f, lsum = 0.f, o0 = 0.f, o1 = 0.f;
    for (int c0 = 0; c0 < nk; c0 += 1024) {
        const int cn = (nk - c0) < 1024 ? (nk - c0) : 1024; float cm = -1e30f;
        for (int i = l; i < cn; i += 64) { const bf16* kr = K + (size_t)(c0 + i) * 192; float s = 0.f;
#pragma unroll 4
            for (int d8 = 0; d8 < 24; ++d8) { const v4u kk = *(const v4u*)(kr + d8 * 8); const f32x4 qa = *(const LAS f32x4*)(qs + d8 * 8), qc = *(const LAS f32x4*)(qs + d8 * 8 + 4);
                s += bflo(kk.x) * qa.x + bfhi(kk.x) * qa.y + bflo(kk.y) * qa.z + bfhi(kk.y) * qa.w + bflo(kk.z) * qc.x + bfhi(kk.z) * qc.y + bflo(kk.w) * qc.z + bfhi(kk.w) * qc.w; }
            sc[i] = s; cm = fmaxf(cm, s); }
        cm = wave_max(cm); const float mn = fmaxf(mx, cm), alpha = exp2f(mx - mn); mx = mn; o0 *= alpha; o1 *= alpha; lsum *= alpha;
        float ps = 0.f;
        for (int i = l; i < cn; i += 64) { const float p = exp2f(sc[i] - mn); sc[i] = p; ps += p; }
        lsum += wave_sum(ps);
        LDS_WAIT(); asm volatile("" ::: "memory");
        for (int i = 0; i < cn; ++i) { const float p = sc[i]; const unsigned vv = *(const unsigned*)(V + (size_t)(c0 + i) * 128 + 2 * l); o0 += p * bflo(vv); o1 += p * bfhi(vv); }
        LDS_WAIT(); asm volatile("" ::: "memory");
    }
    const float inv = 1.f / lsum;
    *(unsigned*)((bf16*)(F.ws + WS_ATT) + (size_t)m * D + h * 128 + 2 * l) = pg8::cvt_pk_bf16(o0 * inv, o1 * inv);
}
__device__ __forceinline__ void naive_attn_decode_row(Frame& F, int rid) {
    const int h = rid & 7, sm = rid >> 3, sb = sm >> 3, t = sm & 7, l = F.lane;
    LAS float* qs = (LAS float*)(F.lds + F.wave * 8192); LAS float* sc = qs + 320;
    const bf16* ql = (const bf16*)(F.ws + WS_QL) + ((size_t)sm * NH + h) * 320;
#pragma unroll
    for (int j = 0; j < 5; ++j) qs[l + 64 * j] = bf2f(ql[l + 64 * j]);
    LDS_WAIT(); asm volatile("" ::: "memory");
    const int* pt = F.page_table + sb * NPAGES; const bf16* knew = (const bf16*)(F.ws + WS_KNEW) + (size_t)sb * DSEQ * 320;
    const int nk = PAST + t + 1; float mx = -1e30f, lsum = 0.f; f32x4 o = {0.f, 0.f, 0.f, 0.f};
    for (int c0 = 0; c0 < nk; c0 += 1024) {
        const int cn = (nk - c0) < 1024 ? (nk - c0) : 1024; float cm = -1e30f;
        for (int i = l; i < cn; i += 64) { const int j = c0 + i; float s = 0.f;
            if (j < PAST) { const size_t prow = (size_t)pt[j >> 7] * PAGE + (j & 127); const float* ck = F.cache_ckv + prow * KVL; const float* kr = F.cache_kr + prow * ROPE;
#pragma unroll 4
                for (int d4 = 0; d4 < 64; ++d4) { const f32x4 kk = *(const f32x4*)(ck + d4 * 4); const f32x4 qq = *(const LAS f32x4*)(qs + d4 * 4); s += kk.x * qq.x + kk.y * qq.y + kk.z * qq.z + kk.w * qq.w; }
#pragma unroll 4
                for (int d4 = 0; d4 < 16; ++d4) { const f32x4 kk = *(const f32x4*)(kr + d4 * 4); const f32x4 qq = *(const LAS f32x4*)(qs + 256 + d4 * 4); s += kk.x * qq.x + kk.y * qq.y + kk.z * qq.z + kk.w * qq.w; }
            } else { const bf16* kn = knew + (size_t)(j - PAST) * 320;
#pragma unroll 4
                for (int d8 = 0; d8 < 40; ++d8) { const v4u kk = *(const v4u*)(kn + d8 * 8); const f32x4 qa = *(const LAS f32x4*)(qs + d8 * 8), qc = *(const LAS f32x4*)(qs + d8 * 8 + 4);
                    s += bflo(kk.x) * qa.x + bfhi(kk.x) * qa.y + bflo(kk.y) * qa.z + bfhi(kk.y) * qa.w + bflo(kk.z) * qc.x + bfhi(kk.z) * qc.y + bflo(kk.w) * qc.z + bfhi(kk.w) * qc.w; }
            }
            sc[i] = s; cm = fmaxf(cm, s); }
        cm = wave_max(cm); const float mn = fmaxf(mx, cm), alpha = exp2f(mx - mn); mx = mn; o = o * alpha; lsum *= alpha;
        float ps = 0.f;
        for (int i = l; i < cn; i += 64) { const float p = exp2f(sc[i] - mn); sc[i] = p; ps += p; }
        lsum += wave_sum(ps);
        LDS_WAIT(); asm volatile("" ::: "memory");
        for (int i = 0; i < cn; ++i) { const int j = c0 + i; const float p = sc[i]; f32x4 vv;
            if (j < PAST) { const size_t prow = (size_t)pt[j >> 7] * PAGE + (j & 127); vv = *((const f32x4*)(F.cache_ckv + prow * KVL) + l); }
            else { const v2u w = *((const v2u*)(knew + (size_t)(j - PAST) * 320) + l); vv = (f32x4){bflo(w.x), bfhi(w.x), bflo(w.y), bfhi(w.y)}; }
            o = o + vv * p; }
        LDS_WAIT(); asm volatile("" ::: "memory");
    }
    const float inv = 1.f / lsum;
    store4bf((bf16*)(F.ws + WS_OLAT) + ((size_t)sm * NH + h) * 256 + 4 * l, o * inv);
}
__device__ __forceinline__ void unpack8(const v4u w, float* f) { f[0] = bflo(w.x); f[1] = bfhi(w.x); f[2] = bflo(w.y); f[3] = bfhi(w.y); f[4] = bflo(w.z); f[5] = bfhi(w.z); f[6] = bflo(w.w); f[7] = bfhi(w.w); }
__device__ __forceinline__ void merged_task(Frame& F, int task) {
    const int m0 = (task >> 1) * 4, c8 = ((task & 1) * 64 + F.lane) * 8;
    const bool samp = m0 >= MP; const int ms0 = m0 - MP;
    const int t0 = samp ? (ms0 & (DSEQ - 1)) : (m0 & (SEQ - 1));
    const bf16* big = (const bf16*)(F.ws + WS_BIG) + (size_t)m0 * NBIG + c8;
    const bf16* att = (const bf16*)(F.ws + WS_ATT) + (size_t)m0 * D + c8; bf16* mo = (bf16*)(F.ws + WS_MERGED) + (size_t)m0 * D + c8;
    v4u cxw[6], bgw[4], gaw[4], atw[4];
#pragma unroll
    for (int r = 0; r < 4; ++r) { cxw[r + 2] = *(const v4u*)(big + (size_t)r * NBIG); bgw[r] = *(const v4u*)(big + (size_t)r * NBIG + 1024); gaw[r] = *(const v4u*)(big + (size_t)r * NBIG + 2048); atw[r] = *(const v4u*)(att + (size_t)r * D); }
    float v[6][8];
    if (t0 >= 2) { cxw[0] = *(const v4u*)(big - 2 * (size_t)NBIG); cxw[1] = *(const v4u*)(big - (size_t)NBIG); unpack8(cxw[0], v[0]); unpack8(cxw[1], v[1]); }
    else if (samp) { const float* sc0 = F.state_conv + (size_t)(ms0 >> 3) * 2 * D + c8;
#pragma unroll
        for (int e = 0; e < 8; ++e) { v[0][e] = sc0[e]; v[1][e] = sc0[D + e]; } }
    else {
#pragma unroll
        for (int e = 0; e < 8; ++e) { v[0][e] = 0.f; v[1][e] = 0.f; } }
    float w0[8], w1[8], w2[8];
#pragma unroll
    for (int e = 0; e < 8; ++e) { w0[e] = F.conv_w[c8 + e]; w1[e] = F.conv_w[D + c8 + e]; w2[e] = F.conv_w[2 * D + c8 + e]; }
#pragma unroll
    for (int r = 0; r < 4; ++r) unpack8(cxw[r + 2], v[r + 2]);
#pragma unroll
    for (int r = 0; r < 4; ++r) { float bg[8], ga[8], at[8], res[8]; unpack8(bgw[r], bg); unpack8(gaw[r], ga); unpack8(atw[r], at);
#pragma unroll
        for (int e = 0; e < 8; ++e) { const float z = w0[e] * v[r][e] + w1[e] * v[r + 1][e] + w2[e] * v[r + 2][e]; res[e] = ga[e] * at[e] + bg[e] * z; }
        v4u o; o.x = pg8::cvt_pk_bf16(res[0], res[1]); o.y = pg8::cvt_pk_bf16(res[2], res[3]); o.z = pg8::cvt_pk_bf16(res[4], res[5]); o.w = pg8::cvt_pk_bf16(res[6], res[7]);
        *(v4u*)(mo + (size_t)r * D) = o; }
}
__device__ __forceinline__ void sample_x1_row(Frame& F, int ms, const float* g1) {
    const float* xs = F.x_s + (size_t)ms * D; const float* p1 = (const float*)(F.ws + WS_P1) + (size_t)ms * D; float* x1 = (float*)(F.ws + WS_X1) + (size_t)(MP + ms) * D;
#pragma unroll
    for (int j = 0; j < 4; ++j) { const int c4 = F.lane + 64 * j;
        f32x4 a = *((const f32x4*)p1 + c4);
#pragma unroll
        for (int kc = 1; kc < 4; ++kc) a = a + *((const f32x4*)(p1 + (size_t)kc * MS * D) + c4);
        *((f32x4*)x1 + c4) = *((const f32x4*)xs + c4) + *((const f32x4*)g1 + c4) * a; }
    asm volatile("s_waitcnt vmcnt(0)" ::: "memory");
}
__device__ __forceinline__ void final_rows4(Frame& F, int m0) {
    float* y = F.out + O_Y + (size_t)m0 * D; f32x4 v[4][4]; float s[4];
    if (m0 < MP) {
#pragma unroll
        for (int r = 0; r < 4; ++r)
#pragma unroll
            for (int j = 0; j < 4; ++j) v[r][j] = *((const f32x4*)(y + (size_t)r * D) + F.lane + 64 * j);
    } else {
        const int ms0 = m0 - MP; const float* x1 = (const float*)(F.ws + WS_X1) + (size_t)m0 * D; const float* p2 = (const float*)(F.ws + WS_P2) + (size_t)ms0 * D;
        const float* g2 = (const float*)(F.ws + WS_MOD) + (size_t)seq_of_row(m0) * (6 * D) + 5 * D;
#pragma unroll
        for (int r = 0; r < 4; ++r)
#pragma unroll
            for (int j = 0; j < 4; ++j) { const int c4 = F.lane + 64 * j; f32x4 a = *((const f32x4*)(p2 + (size_t)r * D) + c4);
#pragma unroll
                for (int kc = 1; kc < 8; ++kc) a = a + *((const f32x4*)(p2 + ((size_t)kc * MS + r) * D) + c4);
                v[r][j] = *((const f32x4*)(x1 + (size_t)r * D) + c4) + *((const f32x4*)g2 + c4) * a; }
    }
#pragma unroll
    for (int r = 0; r < 4; ++r) { s[r] = 0.f;
#pragma unroll
        for (int j = 0; j < 4; ++j) s[r] += (v[r][j].x * v[r][j].x + v[r][j].y * v[r][j].y) + (v[r][j].z * v[r][j].z + v[r][j].w * v[r][j].w);
        s[r] = 1.f / sqrtf(wave_sum(s[r]) * (1.f / D) + EPS); }
#pragma unroll
    for (int j = 0; j < 4; ++j) { const f32x4 gf = *((const f32x4*)F.g_final + F.lane + 64 * j);
#pragma unroll
        for (int r = 0; r < 4; ++r) *((f32x4*)(y + (size_t)r * D) + F.lane + 64 * j) = (v[r][j] * s[r]) * gf; }
}
#define SBAR() __builtin_amdgcn_sched_barrier(0)
typedef short s16x4 __attribute__((ext_vector_type(4)));
typedef LAS s16x4* lds_s16x4p;
__device__ __forceinline__ unsigned cvtpk(float lo, float hi) { return pg8::cvt_pk_bf16(lo, hi); }
__device__ __forceinline__ bf16x8 ld_lds8(LAS unsigned char* p) { return *(const LAS bf16x8*)p; }
__device__ __forceinline__ s16x4 tr_rd(LAS unsigned char* p) { return __builtin_bit_cast(s16x4, __builtin_amdgcn_ds_read_tr16_b64_v4i16((LAS s16x4*)p)); }
__device__ __forceinline__ unsigned off_b(unsigned row, unsigned ch) { return 256u * row + 16u * (ch ^ (((row & 3) << 2) | ((row >> 2) & 3))); }
__device__ __forceinline__ unsigned off_r(unsigned row, unsigned ch) { return 128u * row + 16u * (ch ^ ((row >> 1) & 7)); }
__device__ __forceinline__ unsigned tr_addr(unsigned lane, unsigned rowbase, unsigned c, unsigned ks, unsigned t) {
    const unsigned h = lane >> 5, blk = (lane >> 4) & 1, q = (lane & 15) >> 2, p = lane & 3;
    return off_b(rowbase + 16 * ks + 8 * h + 4 * t + q, 4 * c + 2 * blk + (p >> 1)) + 8 * (p & 1);
}
constexpr float THR2 = 11.5f;
#define PK4(P, B_, OUT) do { unsigned a0 = cvtpk(P[B_+0], P[B_+1]), a1 = cvtpk(P[B_+2], P[B_+3]);                          \
        unsigned b0 = cvtpk(P[B_+4], P[B_+5]), b1 = cvtpk(P[B_+6], P[B_+7]);                                             \
        auto r0 = __builtin_amdgcn_permlane32_swap(a0, b0, false, false); auto r1 = __builtin_amdgcn_permlane32_swap(a1, b1, false, false); \
        v4u w = {r0[0], r1[0], r0[1], r1[1]}; OUT = __builtin_bit_cast(bf16x8, w); } while (0)
__device__ __forceinline__ float swap_max(float v) { auto rr = __builtin_amdgcn_permlane32_swap(__float_as_uint(v), __float_as_uint(v), false, false); return fmaxf(__uint_as_float(rr[0]), __uint_as_float(rr[1])); }
__device__ __forceinline__ float swap_sum(float v) { auto rr = __builtin_amdgcn_permlane32_swap(__float_as_uint(v), __float_as_uint(v), false, false); return __uint_as_float(rr[0]) + __uint_as_float(rr[1]); }
__device__ __forceinline__ void softmax64(f32x16& p0, f32x16& p1, float& m_reg, float& l_reg, float& alpha, bf16x8& pa0, bf16x8& pa1, bf16x8& pa2, bf16x8& pa3) {
    float pmax = p0[0];
#pragma unroll
    for (int r = 1; r < 16; ++r) pmax = fmaxf(pmax, p0[r]);
#pragma unroll
    for (int r = 0; r < 16; ++r) pmax = fmaxf(pmax, p1[r]);
    pmax = swap_max(pmax);
    float mn;
    if (__all(pmax - m_reg <= THR2)) { mn = m_reg; alpha = 1.f; } else { mn = fmaxf(m_reg, pmax); alpha = __builtin_amdgcn_exp2f(m_reg - mn); m_reg = mn; }
    float ps = 0.f;
#pragma unroll
    for (int r = 0; r < 16; ++r) { p0[r] = __builtin_amdgcn_exp2f(p0[r] - mn); ps += p0[r]; }
#pragma unroll
    for (int r = 0; r < 16; ++r) { p1[r] = __builtin_amdgcn_exp2f(p1[r] - mn); ps += p1[r]; }
    l_reg = l_reg * alpha + swap_sum(ps);
    PK4(p0, 0, pa0); PK4(p0, 8, pa1); PK4(p1, 0, pa2); PK4(p1, 8, pa3);
}
__device__ __forceinline__ void softmax32(f32x16& p0, float& m_reg, float& l_reg, float& alpha, bf16x8& pa0, bf16x8& pa1) {
    float pmax = p0[0];
#pragma unroll
    for (int r = 1; r < 16; ++r) pmax = fmaxf(pmax, p0[r]);
    pmax = swap_max(pmax);
    float mn;
    if (__all(pmax - m_reg <= THR2)) { mn = m_reg; alpha = 1.f; } else { mn = fmaxf(m_reg, pmax); alpha = __builtin_amdgcn_exp2f(m_reg - mn); m_reg = mn; }
    float ps = 0.f;
#pragma unroll
    for (int r = 0; r < 16; ++r) { p0[r] = __builtin_amdgcn_exp2f(p0[r] - mn); ps += p0[r]; }
    l_reg = l_reg * alpha + swap_sum(ps);
    PK4(p0, 0, pa0); PK4(p0, 8, pa1);
}
constexpr int PA_V = 0, PA_VB = 16384, PA_K = 2 * PA_VB, PA_KB = 24576, PA_SCR = PA_K + 2 * PA_KB;
__device__ __forceinline__ int pv_st(int k, int c) { const int kk = (k & ~0xC) | ((k & 4) << 1) | ((k & 8) >> 1); return ((kk >> 3) * 4 + (c >> 5)) * 512 + ((kk & 7) * 32 + (c & 31)) * 2; }
__device__ __forceinline__ int pv_rd_base(int lane) { return ((lane & 3) << 3) | (((lane >> 2) & 3) << 6) | (((lane >> 4) & 1) << 5) | (((lane >> 5) & 1) << 8); }
template <int VB> __device__ __forceinline__ void pa_pv_tile(f32x16* o, unsigned vb0, bf16x8 pa0, bf16x8 pa1, bf16x8 pa2, bf16x8 pa3) {
#define TRRD(dst, off) asm volatile("ds_read_b64_tr_b16 %0, %1 offset:%2" : "=&v"(dst) : "v"(vb0), "i"(off) : "memory")
#define PV_RD(i, S) do { constexpr int b_ = PA_V + VB * PA_VB + ((i) >> 1) * 512 + ((i) & 1) * 8192; TRRD(S[0], b_); TRRD(S[1], b_ + 2048); TRRD(S[2], b_ + 4096); TRRD(S[3], b_ + 6144); } while (0)
#define PV_MM(i, S) do { __builtin_amdgcn_s_setprio(1);   \
        o[(i) >> 1] = __builtin_amdgcn_mfma_f32_32x32x16_bf16(((i) & 1) ? pa2 : pa0, (bf16x8){S[0][0], S[0][1], S[0][2], S[0][3], S[1][0], S[1][1], S[1][2], S[1][3]}, o[(i) >> 1], 0, 0, 0);   \
        o[(i) >> 1] = __builtin_amdgcn_mfma_f32_32x32x16_bf16(((i) & 1) ? pa3 : pa1, (bf16x8){S[2][0], S[2][1], S[2][2], S[2][3], S[3][0], S[3][1], S[3][2], S[3][3]}, o[(i) >> 1], 0, 0, 0);   \
        __builtin_amdgcn_s_setprio(0); } while (0)
#define PV_STEP(i, S, T) do { PV_RD((i) + 1, T); asm volatile("s_waitcnt lgkmcnt(4)" ::: "memory"); SBAR(); PV_MM(i, S); SBAR(); } while (0)
    s16x4 A_[4], B_[4];
    PV_RD(0, A_);
    PV_STEP(0, A_, B_); PV_STEP(1, B_, A_); PV_STEP(2, A_, B_); PV_STEP(3, B_, A_); PV_STEP(4, A_, B_); PV_STEP(5, B_, A_); PV_STEP(6, A_, B_);
    asm volatile("s_waitcnt lgkmcnt(0)" ::: "memory"); SBAR(); PV_MM(7, B_); SBAR();
#undef PV_STEP
#undef PV_MM
#undef PV_RD
#undef TRRD
}
__device__ __forceinline__ void attn_prompt_block(Frame& F, int b, int h, int qb) {
    unsigned z_ = 0u; asm volatile("" : "+v"(z_)); const int lane = (int)__builtin_amdgcn_mbcnt_hi(~0u, __builtin_amdgcn_mbcnt_lo(~0u, z_));
    const int wid = F.wave, tid = wid * 64 + lane, r32 = lane & 31, hi = lane >> 5;
    LAS unsigned char* L = F.lds;
    const bf16* Kg = (const bf16*)(F.ws + WS_KP) + (size_t)(b * NH + h) * SEQ * 192;
    const bf16* Vg = (const bf16*)(F.ws + WS_VP) + (size_t)(b * NH + h) * SEQ * 128;
    const int row0 = b * SEQ + qb * 256 + wid * 32;
    const int qpos = qb * 256 + wid * 32 + r32;
    const int qlo = qb * 256 + wid * 32;
    const int NT = 4 * (qb + 1);
    bf16x8 qr[12];
    { const bf16* qp = (const bf16*)(F.ws + WS_QB) + (size_t)(row0 + r32) * NQ;
#pragma unroll
      for (int d0 = 0; d0 < 12; ++d0) qr[d0] = *(const bf16x8*)(qp + (d0 < 8 ? h * 128 + 16 * d0 + 8 * hi : 1024 + h * 64 + 16 * (d0 - 8) + 8 * hi)); }
    unsigned kso[3], vso[2];
#pragma unroll
    for (int i = 0; i < 3; ++i) { const unsigned p = (unsigned)(wid * 3 + i) * 64 + lane, row = p / 24, chp = p - row * 24, ch = chp ^ ((row >> 1) & 7); kso[i] = row * 192 + ch * 8; }
#pragma unroll
    for (int i = 0; i < 2; ++i) { const unsigned B_ = ((unsigned)(wid * 2 + i) * 64 + lane) * 16, st = B_ >> 9, wi = B_ & 511, kk = (st >> 2) * 8 + (wi >> 6), c = (st & 3) * 32 + ((wi & 63) >> 1);
        const unsigned k = (kk & ~0xCu) | ((kk & 4) << 1) | ((kk & 8) >> 1); vso[i] = k * 128 + c; }
#define PA_STAGE(t, bf) do { const bf16* kt = Kg + (size_t)(t) * 64 * 192; const bf16* vt = Vg + (size_t)(t) * 64 * 128;   \
        _Pragma("unroll") for (int i = 0; i < 3; ++i) __builtin_amdgcn_global_load_lds((const unsigned*)(kt + kso[i]), (LAS unsigned*)(L + PA_K + (bf) * PA_KB + (wid * 3 + i) * 1024), 16, 0, 0);   \
        _Pragma("unroll") for (int i = 0; i < 2; ++i) __builtin_amdgcn_global_load_lds((const unsigned*)(vt + vso[i]), (LAS unsigned*)(L + PA_V + (bf) * PA_VB + (wid * 2 + i) * 1024), 16, 0, 0); } while (0)
    LAS float* al_l = (LAS float*)(L + PA_SCR + wid * 256); LAS float* li_l = al_l + 32;
    const unsigned vb0 = (unsigned)pv_rd_base(lane);
    const int fx = (r32 >> 1) & 7;
    int kb4[4];
#pragma unroll
    for (int dd = 0; dd < 4; ++dd) kb4[dd] = r32 * 384 + (((2 * dd + hi) ^ fx) << 4);
    float m_reg = -1e30f, l_reg = 0.f; f32x16 o[4];
#pragma unroll
    for (int d = 0; d < 4; ++d)
#pragma unroll
        for (int r = 0; r < 16; ++r) o[d][r] = 0.f;
    PA_STAGE(0, 0); VM_WAIT();
    __syncthreads();
#define PA_LDK(KB, d, sl) do { LAS unsigned char* a = L + PA_K + (KB) * PA_KB + kb4[(d) & 3] + ((d) >> 2) * 128; kf[sl][0] = ld_lds8(a); kf[sl][1] = ld_lds8(a + 32 * 384); } while (0)
#define PA_STEP(t, KB) do {                                                                                                     \
        if ((t) + 1 < NT) PA_STAGE((t) + 1, (KB) ^ 1);                                                                          \
        f32x16 p0, p1;                                                                                                          \
        _Pragma("unroll") for (int r = 0; r < 16; ++r) { p0[r] = 0.f; p1[r] = 0.f; }                                            \
        { bf16x8 kf[2][2];                                      \
          PA_LDK(KB, 0, 0);                                                                                                     \
          _Pragma("unroll") for (int d0 = 0; d0 < 12; ++d0) {                                                                   \
            if (d0 + 1 < 12) PA_LDK(KB, d0 + 1, (d0 + 1) & 1);                                                                  \
            SBAR(); __builtin_amdgcn_s_setprio(1);                                                                              \
            p0 = __builtin_amdgcn_mfma_f32_32x32x16_bf16(kf[d0 & 1][0], qr[d0], p0, 0, 0, 0);                                    \
            p1 = __builtin_amdgcn_mfma_f32_32x32x16_bf16(kf[d0 & 1][1], qr[d0], p1, 0, 0, 0);                                    \
            __builtin_amdgcn_s_setprio(0); SBAR(); } }                                                                          \
        const int kb_ = (t) * 64;                                                                                               \
        if (kb_ + 63 > qlo) { const float NEG = -__builtin_inff();                                                              \
            _Pragma("unroll") for (int r = 0; r < 16; ++r) { const int key = kb_ + crow32(r, hi); if (key > qpos) p0[r] = NEG; if (key + 32 > qpos) p1[r] = NEG; } }   \
        float alpha; bf16x8 pa0, pa1, pa2, pa3;                                                                                 \
        softmax64(p0, p1, m_reg, l_reg, alpha, pa0, pa1, pa2, pa3);                                                             \
        if (__any(alpha < 1.f)) { if (hi == 0) al_l[r32] = alpha; LDS_WAIT();                                                    \
            _Pragma("unroll") for (int r = 0; r < 16; ++r) { const float a_ = al_l[crow32(r, hi)];                              \
                _Pragma("unroll") for (int d_ = 0; d_ < 4; ++d_) o[d_][r] *= a_; } }                                            \
        pa_pv_tile<KB>(o, vb0, pa0, pa1, pa2, pa3);                                                                             \
        VM_WAIT();                                                                                                              \
        __syncthreads(); } while (0)
    for (int t = 0; t < NT; t += 2) { PA_STEP(t, 0); PA_STEP(t + 1, 1); }
#undef PA_STEP
#undef PA_LDK
#undef PA_STAGE
    if (hi == 0) li_l[r32] = l_reg;
    LDS_WAIT();
    { unsigned eo = (unsigned)(4 * hi * D + r32);
      asm volatile("" : "+v"(eo));
      bf16* Ow = (bf16*)(F.ws + WS_ATT) + (size_t)row0 * D + h * 128;
#pragma unroll
      for (int r = 0; r < 16; ++r) { const int orow = crow32(r, hi); const float rl = __builtin_amdgcn_rcpf(li_l[orow]);
#pragma unroll
        for (int d0 = 0; d0 < 4; ++d0) { const float v = o[d0][r] * rl; const float vn = __shfl_xor(v, 1);
            if ((r32 & 1) == 0) *(unsigned*)(Ow + eo + ((r & 3) + 8 * (r >> 2)) * D + d0 * 32) = cvtpk(v, vn); } } }
    __syncthreads();
}
constexpr int DA_Q = 0, DA_IMG = 40960, DA_K = DA_IMG, DA_SCR = 3 * DA_IMG, DA_L1 = 16384, DA_R = 32768;
#define DA_BAR() do { asm volatile("s_waitcnt lgkmcnt(0)" ::: "memory"); __builtin_amdgcn_s_barrier(); asm volatile("" ::: "memory"); } while (0)
__device__ __forceinline__ void attn_decode_unit(Frame& F, int sb, int sp) {
    unsigned z_ = 0u; asm volatile("" : "+v"(z_)); const int lane = (int)__builtin_amdgcn_mbcnt_hi(~0u, __builtin_amdgcn_mbcnt_lo(~0u, z_));
    const int wid = F.wave, tid = wid * 64 + lane, r32 = lane & 31, hi = lane >> 5;
    LAS unsigned char* L = F.lds;
    const int* pt = F.page_table + sb * NPAGES + sp * 32;
    constexpr int NT = 64;
    { const bf16* ql = (const bf16*)(F.ws + WS_QL) + (size_t)sb * 64 * 320;
#pragma unroll
      for (int i = 0; i < 5; ++i) { const int id = tid + 512 * i, row = id / 40, ch = id - row * 40; const bf16x8 v = *(const bf16x8*)(ql + (size_t)row * 320 + ch * 8);
          const unsigned o_ = ch < 16 ? off_b(row, ch) : (ch < 32 ? DA_L1 + off_b(row, ch - 16) : DA_R + off_r(row, ch - 32));
          *(LAS bf16x8*)(L + DA_Q + o_) = v; } }
    __syncthreads();
    if (wid >= 4) {
        const unsigned lt = (unsigned)((wid - 4) * 64 + lane);
        const int ptv = pt[lane & 31];
        f32x4 cA[16], rA[4], cB[16], rB[4];
        const unsigned cvo = (lt >> 6) * 1024u + (lt & 63) * 16u, rvo = (lt >> 4) * 256u + (lt & 15) * 16u;
        unsigned wlo[4];
        { const unsigned c4 = lt & 63, row0 = lt >> 6, ch = (c4 & 31) >> 1;
#pragma unroll
          for (int v = 0; v < 4; ++v) wlo[v] = (c4 >> 5) * DA_L1 + 256u * row0 + 16u * (ch ^ (((row0 & 3) << 2) | (((row0 >> 2) + v) & 3))) + 8u * (c4 & 1); }
        const unsigned wro = DA_R + off_r(lt >> 4, (lt & 15) >> 1) + 8u * (lt & 1);
#define DA_LOAD(t, c_, r_) do { const size_t prow = (size_t)__builtin_amdgcn_readlane(ptv, (t) >> 1) * PAGE + ((t) & 1) * 64;     \
        const char* cb_ = (const char*)F.cache_ckv + prow * (KVL * 4); const char* rb_ = (const char*)F.cache_kr + prow * (ROPE * 4);   \
        _Pragma("unroll") for (int i = 0; i < 16; ++i) c_[i] = __builtin_nontemporal_load((const f32x4*)(cb_ + 4096 * i + cvo));     \
        _Pragma("unroll") for (int i = 0; i < 4; ++i) r_[i] = __builtin_nontemporal_load((const f32x4*)(rb_ + 4096 * i + rvo)); } while (0)
#define DA_WRITE(bf, c_, r_) do { LAS unsigned char* Kb = L + DA_K + (bf) * DA_IMG;                                             \
        _Pragma("unroll") for (int i = 0; i < 16; ++i) { v2u w; w.x = cvtpk(c_[i][0], c_[i][1]); w.y = cvtpk(c_[i][2], c_[i][3]); *(LAS v2u*)(Kb + wlo[i & 3] + 1024 * i) = w; }   \
        _Pragma("unroll") for (int i = 0; i < 4; ++i) { v2u w; w.x = cvtpk(r_[i][0], r_[i][1]); w.y = cvtpk(r_[i][2], r_[i][3]); *(LAS v2u*)(Kb + wro + 2048 * i) = w; } } while (0)
        DA_LOAD(0, cA, rA); DA_LOAD(1, cB, rB);
        for (int t = 0; t < NT; t += 2) {
            DA_WRITE(0, cA, rA);
            DA_LOAD(t + 2 < NT ? t + 2 : NT - 1, cA, rA);
            DA_BAR();
            DA_WRITE(1, cB, rB);
            DA_LOAD(t + 3 < NT ? t + 3 : NT - 1, cB, rB);
            DA_BAR();
        }
#undef DA_LOAD
#undef DA_WRITE
        if (sp == 1) {
            LAS unsigned char* Kb = L + DA_K; const bf16* kn = (const bf16*)(F.ws + WS_KNEW) + (size_t)sb * DSEQ * 320;
#pragma unroll
            for (int i = 0; i < 10; ++i) { const int id = lt + 256 * i, row = id / 40, ch = id - row * 40; bf16x8 v = {0, 0, 0, 0, 0, 0, 0, 0};
                if (row < DSEQ) v = *(const bf16x8*)(kn + (size_t)row * 320 + ch * 8);
                const unsigned o_ = ch < 16 ? off_b(row, ch) : (ch < 32 ? DA_L1 + off_b(row, ch - 16) : DA_R + off_r(row, ch - 32));
                *(LAS bf16x8*)(Kb + o_) = v; }
            DA_BAR();
        }
    } else {
        const int kh = wid & 1, qh = wid >> 1;
        LAS float* al_l = (LAS float*)(L + DA_SCR + wid * 256);
        const unsigned krow = 32 * kh + r32, qrow = 32 * qh + r32;
        float m_reg = -1e30f, l_reg = 0.f; f32x16 o[8];
#pragma unroll
        for (int d = 0; d < 8; ++d)
#pragma unroll
            for (int r = 0; r < 16; ++r) o[d][r] = 0.f;
#define DA_KADDR(s) ((s) < 16 ? ((s) >> 3) * DA_L1 + 256u * kr_ + 16u * ((2 * ((s) & 7) + hi) ^ xk) : DA_R + 128u * kr_ + 16u * ((2 * ((s) - 16) + hi) ^ fk))
#define DA_QADDR(s) ((s) < 16 ? ((s) >> 3) * DA_L1 + 256u * qr_ + 16u * ((2 * ((s) & 7) + hi) ^ xq) : DA_R + 128u * qr_ + 16u * ((2 * ((s) - 16) + hi) ^ fq))
#define DA_LDG(g, sl) do { kf[sl][0] = ld_lds8(Kb + DA_KADDR(2 * (g))); qf[sl][0] = ld_lds8(Qb + DA_QADDR(2 * (g))); kf[sl][1] = ld_lds8(Kb + DA_KADDR(2 * (g) + 1)); qf[sl][1] = ld_lds8(Qb + DA_QADDR(2 * (g) + 1)); } while (0)
#define DA_LDV(c, sl) do { LAS unsigned char* Vb_ = Kb + ((c) >> 2) * DA_L1;                                                     \
            va[sl][0] = tr_rd(Vb_ + tr_addr(ln_, 32 * kh, (c) & 3, 0, 0)); va[sl][1] = tr_rd(Vb_ + tr_addr(ln_, 32 * kh, (c) & 3, 0, 1));   \
            va[sl][2] = tr_rd(Vb_ + tr_addr(ln_, 32 * kh, (c) & 3, 1, 0)); va[sl][3] = tr_rd(Vb_ + tr_addr(ln_, 32 * kh, (c) & 3, 1, 1)); } while (0)
#define DA_COMPUTE(bf, MASKNEW) do { LAS unsigned char* Kb = L + DA_K + (bf) * DA_IMG; LAS unsigned char* Qb = L + DA_Q;         \
        unsigned kr_ = krow, qr_ = qrow, ln_ = lane; asm volatile("" : "+v"(kr_), "+v"(qr_), "+v"(ln_));     \
        const unsigned xk = ((kr_ & 3) << 2) | ((kr_ >> 2) & 3), xq = ((qr_ & 3) << 2) | ((qr_ >> 2) & 3), fk = (kr_ >> 1) & 7, fq = (qr_ >> 1) & 7;   \
        f32x16 p0;                                                                                                              \
        _Pragma("unroll") for (int r = 0; r < 16; ++r) p0[r] = 0.f;                                                             \
        { bf16x8 kf[2][2], qf[2][2];                           \
          DA_LDG(0, 0);                                                                                                         \
          _Pragma("unroll") for (int g_ = 0; g_ < 10; ++g_) {                                                                   \
            if (g_ + 1 < 10) DA_LDG(g_ + 1, (g_ + 1) & 1);                                                                      \
            SBAR();                                                                                                             \
            p0 = __builtin_amdgcn_mfma_f32_32x32x16_bf16(kf[g_ & 1][0], qf[g_ & 1][0], p0, 0, 0, 0);                             \
            p0 = __builtin_amdgcn_mfma_f32_32x32x16_bf16(kf[g_ & 1][1], qf[g_ & 1][1], p0, 0, 0, 0);                             \
            SBAR(); } }                                                                                                         \
        if (MASKNEW) { const float NEG = -__builtin_inff(); const int tq = (int)qrow >> 3;                                      \
            _Pragma("unroll") for (int r = 0; r < 16; ++r) { const int kk = crow32(r, hi); if (kk > tq) p0[r] = NEG; } }         \
        float alpha; bf16x8 pa0, pa1;                                                                                           \
        softmax32(p0, m_reg, l_reg, alpha, pa0, pa1);                                                                           \
        if (__any(alpha < 1.f)) { if (hi == 0) al_l[r32] = alpha; LDS_WAIT();                                                    \
            _Pragma("unroll") for (int r = 0; r < 16; ++r) { const float a_ = al_l[crow32(r, hi)];                              \
                _Pragma("unroll") for (int d_ = 0; d_ < 8; ++d_) o[d_][r] *= a_; } }                                            \
        { s16x4 va[2][4];                                                             \
          DA_LDV(0, 0);                                                                                                         \
          _Pragma("unroll") for (int c = 0; c < 8; ++c) {                                                                       \
            if (c + 1 < 8) DA_LDV(c + 1, (c + 1) & 1);                                                                          \
            SBAR();                                                                                                             \
            o[c] = __builtin_amdgcn_mfma_f32_32x32x16_bf16(pa0, (bf16x8){va[c & 1][0][0], va[c & 1][0][1], va[c & 1][0][2], va[c & 1][0][3], va[c & 1][1][0], va[c & 1][1][1], va[c & 1][1][2], va[c & 1][1][3]}, o[c], 0, 0, 0);   \
            o[c] = __builtin_amdgcn_mfma_f32_32x32x16_bf16(pa1, (bf16x8){va[c & 1][2][0], va[c & 1][2][1], va[c & 1][2][2], va[c & 1][2][3], va[c & 1][3][0], va[c & 1][3][1], va[c & 1][3][2], va[c & 1][3][3]}, o[c], 0, 0, 0);   \
            SBAR(); } } } while (0)
        for (int t = 0; t < NT; t += 2) {
            DA_BAR(); DA_COMPUTE(0, false);
            DA_BAR(); DA_COMPUTE(1, false);
        }
        if (sp == 1) { DA_BAR(); if (kh == 0) { DA_COMPUTE(0, true); } }
#undef DA_COMPUTE
#undef DA_LDG
#undef DA_LDV
#undef DA_KADDR
#undef DA_QADDR
        { unsigned l2 = (unsigned)lane; asm volatile("" : "+v"(l2));
          const unsigned e_r32 = l2 & 31, e_hi = l2 >> 5; const int pi = 2 * sp + kh;
          float* po = (float*)(F.ws + WS_PART) + ((size_t)(sb * 4 + pi) * 64 + 32 * qh) * 256;
          const unsigned eo = 4 * e_hi * 256 + e_r32;
#pragma unroll
          for (int r = 0; r < 16; ++r) {
#pragma unroll
            for (int c = 0; c < 8; ++c) po[eo + ((r & 3) + 8 * (r >> 2)) * 256 + 32 * c] = o[c][r]; }
          if (e_hi == 0) { float* ml = (float*)(F.ws + WS_ML) + ((size_t)(sb * 4 + pi) * 64 + 32 * qh + e_r32) * 2; ml[0] = m_reg; ml[1] = l_reg; } }
    }
    __syncthreads();
}
__device__ __forceinline__ void decode_combine_row(Frame& F, int row) {
    const int sb = row >> 6, q = row & 63, l = F.lane;
    const float* ml = (const float*)(F.ws + WS_ML); const float* po = (const float*)(F.ws + WS_PART);
    float mm[4], ll[4], M_ = -1e30f;
#pragma unroll
    for (int p = 0; p < 4; ++p) { const f32x2 v = *(const f32x2*)(ml + ((size_t)(sb * 4 + p) * 64 + q) * 2); mm[p] = v.x; ll[p] = v.y; M_ = fmaxf(M_, v.x); }
    float Lsum = 0.f; f32x4 acc = {0.f, 0.f, 0.f, 0.f};
#pragma unroll
    for (int p = 0; p < 4; ++p) { const float w = exp2f(mm[p] - M_); Lsum += w * ll[p]; acc = acc + *((const f32x4*)(po + ((size_t)(sb * 4 + p) * 64 + q) * 256) + l) * w; }
    store4bf((bf16*)(F.ws + WS_OLAT) + (size_t)row * 256 + 4 * l, acc * (1.f / Lsum));
}

struct Args { const void* in[22]; float* out; unsigned char* ws; int ph_lo, ph_hi; };
__global__ void __launch_bounds__(NWAVES * 64, 2) mk_fwd(Args args) {
    extern __shared__ __attribute__((aligned(16))) unsigned char lds[];
    Frame F;
    F.lds = (LAS unsigned char*)lds;
    F.MISC = (volatile LAS unsigned*)(F.lds + MISC_OFF);
    F.tid = threadIdx.x; F.lane = F.tid & 63; F.wave = __builtin_amdgcn_readfirstlane(F.tid >> 6);
    F.G = gridDim.x; F.gw = blockIdx.x * NWAVES + F.wave; F.NGW = F.G * NWAVES;
    F.ws = args.ws; F.out = args.out; F.ctl = (gu32*)(args.ws + WS_CTL);
    F.x_p = (const float*)args.in[0]; F.x_s = (const float*)args.in[1]; F.cache_ckv = (const float*)args.in[2]; F.cache_kr = (const float*)args.in[3]; F.state_conv = (const float*)args.in[4];
    F.page_table = (const int*)args.in[5]; F.c_p = (const float*)args.in[6]; F.c_s = (const float*)args.in[7]; F.w_ada = (const float*)args.in[8]; F.b_ada = (const float*)args.in[9];
    F.g_attn = (const float*)args.in[10]; F.w_in = (const float*)args.in[11]; F.g_q = (const float*)args.in[12]; F.w_q_b = (const float*)args.in[13]; F.g_kv = (const float*)args.in[14];
    F.w_kv_b = (const float*)args.in[15]; F.conv_w = (const float*)args.in[16]; F.w_o = (const float*)args.in[17]; F.g_mlp = (const float*)args.in[18]; F.w_1 = (const float*)args.in[19];
    F.w_2 = (const float*)args.in[20]; F.g_final = (const float*)args.in[21];
    for (int u = F.tid; u < (LDS_BYTES - LDSCTL_OFF) / 4; u += NWAVES * 64) ((LAS unsigned*)(F.lds + LDSCTL_OFF))[u] = 0u;
    __syncthreads();
    XcdBarrier bar; bar.bar = (unsigned*)(F.ctl + CW_BAR); bar.x = 0; bar.st = nullptr;
    if (!MK_PER_PHASE) bar = xcd_barrier_post((unsigned*)(F.ctl + CW_BAR), F.MISC + 8);
#define GRID_BAR() do { if (MK_PER_PHASE) { if (F.tid == 0) __hip_atomic_store(F.ctl + CW_TMO, 0xBADBA0u, RLX_AGENT); } else { xcd_barrier(bar); } } while (0)
    const int lo = args.ph_lo, hi = args.ph_hi;
#ifndef PH_MASK
#define PH_MASK 0xFFFFFFFFu
#endif
#define IN(k) (((PH_MASK >> (k)) & 1u) && lo <= (k) && (k) < hi)
#define BOTH(k) (IN(k) && IN((k) + 1))
#define RELANE() do { unsigned z_ = 0u; asm volatile("" : "+v"(z_)); int l_ = (int)__builtin_amdgcn_mbcnt_hi(~0u, __builtin_amdgcn_mbcnt_lo(~0u, z_)); F.lane = l_; F.tid = F.wave * 64 + l_; } while (0)
    const pg8::bf16_t* U = (const pg8::bf16_t*)(F.ws + WS_U);
    float* mod = (float*)(F.ws + WS_MOD);

    if (IN(0)) { RELANE(); p0_prologue(F); if (BOTH(0)) GRID_BAR(); }
    if (IN(1)) { RELANE(); for (int et = blockIdx.x; et < (6 * D) / 32; et += F.G) adaln_task(F, et); if (BOTH(1)) GRID_BAR(); }
    if (IN(2)) { RELANE();
        for (int m = F.gw * 4; m < M; m += F.NGW * 4) { const float* mr = mod + (size_t)seq_of_row(m) * (6 * D);
            norm_mod_rows4(F, m < MP ? F.x_p + (size_t)m * D : F.x_s + (size_t)(m - MP) * D, F.g_attn, mr + D, mr, (bf16*)(F.ws + WS_U) + (size_t)m * D); }
        if (BOTH(2)) GRID_BAR();
    }
    if (IN(3)) { RELANE();
        pg8::Gemm g{U, (const pg8::bf16_t*)(F.ws + WS_WIN), M, NIN, D, D, D, 0, 0, 0x7fffffff, 0}; pg8::StaticOrder S; S.init(M, NIN, F.G, (int)blockIdx.x);
        Epi<1> E{F.ws, F.x_p, F.x_s, F.out};
        pg8::gemm_phase<Epi<1>, pg8::StaticOrder, true, true>(F.lds + RING_OFF, g, S, E);
        if (BOTH(3)) GRID_BAR();
    }
    if (IN(4)) { RELANE(); for (int m = F.gw; m < M; m += F.NGW) small_row(F, m); if (BOTH(4)) GRID_BAR(); }
    if (IN(5)) { RELANE();
        { pg8::Gemm g{(const pg8::bf16_t*)(F.ws + WS_QA), (const pg8::bf16_t*)(F.ws + WS_WQB), M, NQ, QLORA, QLORA, QLORA, 0, 0, 0x7fffffff, 0}; pg8::StaticOrder S; S.init(M, NQ, F.G, (int)blockIdx.x);
          Epi<2> E{F.ws, F.x_p, F.x_s, F.out};
          pg8::gemm_phase<Epi<2>, pg8::StaticOrder, true, true>(F.lds + RING_OFF, g, S, E); }
        __syncthreads();
        { pg8::Gemm g{(const pg8::bf16_t*)(F.ws + WS_CKVN), (const pg8::bf16_t*)(F.ws + WS_WKVB), MP, 2048, KVL, KVL, KVL, 0, 0, 0x7fffffff, 0}; pg8::StaticOrder S; S.init(MP, 2048, F.G, (int)blockIdx.x);
          Epi<3> E{F.ws, F.x_p, F.x_s, F.out};
          pg8::gemm_phase<Epi<3>, pg8::StaticOrder, true, true>(F.lds + RING_OFF, g, S, E); }
        if (BOTH(5)) GRID_BAR();
    }
    if (IN(6)) { RELANE();
        pg8::Gemm g{(const pg8::bf16_t*)(F.ws + WS_QB) + (size_t)MP * NQ, (const pg8::bf16_t*)(F.ws + WS_WUK), MS, 2048, 256, NQ, 256, 128 * 2, 0, 0x7fffffff, 0}; pg8::StaticOrder S; S.init(MS, 2048, F.G, (int)blockIdx.x);
        Epi<4> E{F.ws, F.x_p, F.x_s, F.out};
        pg8::gemm_phase<Epi<4>, pg8::StaticOrder, true, true>(F.lds + RING_OFF, g, S, E);
        if (BOTH(6)) GRID_BAR();
    }
    if (IN(7)) { RELANE();
        const bool dec_first = ((blockIdx.x >> 3) & 1) != 0;
        if (dec_first) { for (int du = blockIdx.x; du < 2 * DB; du += F.G) attn_decode_unit(F, du >> 1, du & 1); }
        for (int it = blockIdx.x; it < NB * NH * 8; it += F.G) {
            const int xcd = it & 7, j = it >> 3, bh = (xcd * 4 + (j >> 3)) & 31, pr = j & 7, b = bh >> 3, h = bh & 7;
            for (int k = 0; k < 2; ++k) attn_prompt_block(F, b, h, k == 0 ? 15 - pr : pr);
        }
        if (!dec_first) { for (int du = blockIdx.x; du < 2 * DB; du += F.G) attn_decode_unit(F, du >> 1, du & 1); }
        if (BOTH(7)) GRID_BAR();
    }
    if (IN(8)) { RELANE(); for (int r = F.gw; r < MS * NH; r += F.NGW) decode_combine_row(F, r); if (BOTH(8)) GRID_BAR(); }
    if (IN(9)) { RELANE();
        pg8::Gemm g{(const pg8::bf16_t*)(F.ws + WS_OLAT), (const pg8::bf16_t*)(F.ws + WS_WKVB), MS, 2048, 256, 2048, 256, 256 * 2, 0, 0x7fffffff, 0}; pg8::StaticOrder S; S.init(MS, 2048, F.G, (int)blockIdx.x);
        Epi<5> E{F.ws, F.x_p, F.x_s, F.out};
        pg8::gemm_phase<Epi<5>, pg8::StaticOrder, true, true>(F.lds + RING_OFF, g, S, E);
        if (BOTH(9)) GRID_BAR();
    }
    if (IN(10)) { RELANE(); for (int tk = F.gw; tk < (M / 4) * 2; tk += F.NGW) merged_task(F, tk); if (BOTH(10)) GRID_BAR(); }
    if (IN(11)) { RELANE();
        { pg8::Gemm g{(const pg8::bf16_t*)(F.ws + WS_MERGED), (const pg8::bf16_t*)(F.ws + WS_WO), MP, D, D, D, D, 0, 0, 0x7fffffff, 0}; pg8::StaticOrder S; S.init(MP, D, F.G, (int)blockIdx.x);
          Epi<6> E{F.ws, F.x_p, F.x_s, F.out};
          pg8::gemm_phase<Epi<6>, pg8::StaticOrder, true, true>(F.lds + RING_OFF, g, S, E); }
        __syncthreads();
        { pg8::Gemm g{(const pg8::bf16_t*)(F.ws + WS_MERGED) + (size_t)MP * D, (const pg8::bf16_t*)(F.ws + WS_WO), MS, 4 * D, 256, D, D, 256 * 2, 2, 3, 256 * 2}; pg8::StaticOrder S; S.init(MS, 4 * D, F.G, (int)(F.G - 1 - blockIdx.x));
          Epi<9> E{F.ws, F.x_p, F.x_s, F.out};
          pg8::gemm_phase<Epi<9>, pg8::StaticOrder, true, true>(F.lds + RING_OFF, g, S, E); }
        if (BOTH(11)) GRID_BAR();
    }
    if (IN(12)) { RELANE();
        for (int m = F.gw * 4; m < M; m += F.NGW * 4) { const float* mr = mod + (size_t)seq_of_row(m) * (6 * D);
            if (m >= MP) { for (int r = 0; r < 4; ++r) sample_x1_row(F, m - MP + r, mr + 2 * D); }
            norm_mod_rows4(F, (const float*)(F.ws + WS_X1) + (size_t)m * D, F.g_mlp, mr + 4 * D, mr + 3 * D, (bf16*)(F.ws + WS_U) + (size_t)m * D); }
        if (BOTH(12)) GRID_BAR();
    }
    if (IN(13)) { RELANE();
        pg8::Gemm g{U, (const pg8::bf16_t*)(F.ws + WS_W1), M, FF, D, D, D, 0, 0, 0x7fffffff, 0}; pg8::StaticOrder S; S.init(M, FF, F.G, (int)blockIdx.x);
        Epi<7> E{F.ws, F.x_p, F.x_s, F.out};
        pg8::gemm_phase<Epi<7>, pg8::StaticOrder, true, true>(F.lds + RING_OFF, g, S, E);
        if (BOTH(13)) GRID_BAR();
    }
    if (IN(14)) { RELANE();
        { pg8::Gemm g{(const pg8::bf16_t*)(F.ws + WS_HDN), (const pg8::bf16_t*)(F.ws + WS_W2), MP, D, FF, FF, FF, 0, 0, 0x7fffffff, 0}; pg8::StaticOrder S; S.init(MP, D, F.G, (int)blockIdx.x);
          Epi<8> E{F.ws, F.x_p, F.x_s, F.out};
          pg8::gemm_phase<Epi<8>, pg8::StaticOrder, true, true>(F.lds + RING_OFF, g, S, E); }
        __syncthreads();
        { pg8::Gemm g{(const pg8::bf16_t*)(F.ws + WS_HDN) + (size_t)MP * FF, (const pg8::bf16_t*)(F.ws + WS_W2), MS, 8 * D, 512, FF, FF, 512 * 2, 2, 3, 512 * 2}; pg8::StaticOrder S; S.init(MS, 8 * D, F.G, (int)(F.G - 1 - blockIdx.x));
          Epi<10> E{F.ws, F.x_p, F.x_s, F.out};
          pg8::gemm_phase<Epi<10>, pg8::StaticOrder, true, true>(F.lds + RING_OFF, g, S, E); }
        if (BOTH(14)) GRID_BAR();
    }
    if (IN(15)) { RELANE(); for (int m = F.gw * 4; m < M; m += F.NGW * 4) final_rows4(F, m); }
#undef IN
#undef BOTH
}

extern "C" void kernel_launch(void* const* d_in, const int* in_sizes, int n_in, void* d_out, int out_size, void* d_ws, size_t ws_size, hipStream_t stream) {
    static int grid = 0;
    if (grid == 0) {
        if (n_in != 22 || out_size != (int)O_END || ws_size < WS_END) { fprintf(stderr, "kernel_launch: unexpected shapes (n_in %d, out %d, ws %zu); nothing launched\n", n_in, out_size, ws_size); grid = -1; return; }
        int dev = 0, cus = 0, per_cu = 0;
        if (hipGetDevice(&dev) != hipSuccess || hipDeviceGetAttribute(&cus, hipDeviceAttributeMultiprocessorCount, dev) != hipSuccess) { grid = -1; return; }
        if (hipFuncSetAttribute((const void*)mk_fwd, hipFuncAttributeMaxDynamicSharedMemorySize, LDS_BYTES) != hipSuccess) { fprintf(stderr, "kernel_launch: hipFuncSetAttribute failed\n"); grid = -1; return; }
        if (hipOccupancyMaxActiveBlocksPerMultiprocessor(&per_cu, (const void*)mk_fwd, NWAVES * 64, LDS_BYTES) != hipSuccess || per_cu < 1) fprintf(stderr, "kernel_launch: note: occupancy query says %d\n", per_cu);
        (void)hipGetLastError();
        grid = cus;
    }
    if (grid < 0) return;
    if (hipMemsetAsync((char*)d_ws + WS_CTL, 0, CTL_ZERO_BYTES, stream) != hipSuccess) return;
    Args a{};
    for (int i = 0; i < 22; ++i) a.in[i] = d_in[i];
    a.out = (float*)d_out; a.ws = (unsigned char*)d_ws;
#if MK_PER_PHASE
    for (int p = 0; p < N_PHASES; ++p) { a.ph_lo = p; a.ph_hi = p + 1; hipLaunchKernelGGL(mk_fwd, dim3(grid), dim3(NWAVES * 64), LDS_BYTES, stream, a); }
#else
    a.ph_lo = 0; a.ph_hi = N_PHASES; hipLaunchKernelGGL(mk_fwd, dim3(grid), dim3(NWAVES * 64), LDS_BYTES, stream, a);
#endif
}
```
